# Optimizing an MI355X kernel written in HIP

```python
import jax, jax.numpy as jnp
from jax import lax
import numpy as np

D_MODEL = 1024
BATCH = 32
SEQ = 2048
DEPTH = 2

RWKV_HEADS = 8
RWKV_HEAD_DIM = 64
RWKV_WIDTH = RWKV_HEADS * RWKV_HEAD_DIM
DECAY_LORA = 64
ICLR_LORA = 64
GATE_LORA = 128
RWKV_GN_EPS = 64e-5
GDN_HEADS = 4
GDN_HEAD_DIM = 128
GDN_WIDTH = GDN_HEADS * GDN_HEAD_DIM
CONV_WIDTH = 4
CHUNK = 64
D_FF = 2816
N_EXPERTS = 8
TOP_K = 2
NORM_EPS = 1e-6

RWKV_SPLITS = (RWKV_WIDTH, RWKV_WIDTH, RWKV_WIDTH, DECAY_LORA, ICLR_LORA, GATE_LORA)
RWKV_COLS = sum(RWKV_SPLITS)
GDN_SPLITS = (3 * GDN_WIDTH, GDN_HEADS, GDN_HEADS, GDN_WIDTH)
GDN_COLS = sum(GDN_SPLITS)
GATE_COLS = 2 * D_MODEL
IN_COLS = RWKV_COLS + GDN_COLS + GATE_COLS
N_DENSE = (DEPTH + 1) // 2
N_MOE = DEPTH // 2

kernel_name = 'hybrid_rwkv7_gdn_moe_trunk'


def _split(t, sizes):
    return jnp.split(t, np.cumsum(sizes)[:-1].tolist(), axis=-1)


def rms_norm(x, g, eps=NORM_EPS):
    xf = x.astype(jnp.float32)
    y = xf * lax.rsqrt(jnp.mean(xf * xf, axis=-1, keepdims=True) + eps)
    return (y * g.astype(jnp.float32)).astype(x.dtype)


def l2_normalize(x, eps=1e-6):
    return x * lax.rsqrt(jnp.sum(x * x, axis=-1, keepdims=True) + eps)


def causal_depthwise_conv(x, w):
    K, C = w.shape
    return lax.conv_general_dilated(x, w[:, None, :], window_strides=(1,), padding=[(K - 1, 0)],
                                    dimension_numbers=('NWC', 'WIO', 'NWC'), feature_group_count=C)


def swiglu(h, w_gate, w_up, w_down):
    return (jax.nn.silu(h @ w_gate) * (h @ w_up)) @ w_down


def rwkv7_recurrence(r, w, k, v, a, b):
    B, T, H, N = r.shape

    def step(S, inp):
        r_t, w_t, k_t, v_t, a_t, b_t = inp
        sa = jnp.einsum('bhvk,bhk->bhv', S, a_t)
        S = S * w_t[:, :, None, :] + sa[..., None] * b_t[:, :, None, :] + v_t[..., None] * k_t[:, :, None, :]
        return S, jnp.einsum('bhvk,bhk->bhv', S, r_t)

    xs = tuple(jnp.moveaxis(t, 1, 0) for t in (r, w, k, v, a, b))
    _, o = lax.scan(step, jnp.zeros((B, H, N, N), jnp.float32), xs)
    return jnp.moveaxis(o, 0, 1)


def chunked_gated_delta_rule(q, k, v, g_log, beta):
    B, T, H, dk = q.shape
    dv = v.shape[-1]
    C = CHUNK
    NC = T // C
    q = q * (dk ** -0.5)

    def to_chunks(t):
        return t.reshape(B, NC, C, H, -1).transpose(0, 3, 1, 2, 4)

    q, k, v = to_chunks(q), to_chunks(k), to_chunks(v)
    g_log = g_log.reshape(B, NC, C, H).transpose(0, 3, 1, 2)
    beta = beta.reshape(B, NC, C, H).transpose(0, 3, 1, 2)
    gc = jnp.cumsum(g_log, axis=-1)
    causal = jnp.tril(jnp.ones((C, C), dtype=bool))
    strict = jnp.tril(jnp.ones((C, C), dtype=bool), -1)
    decay = jnp.exp(jnp.where(causal, gc[..., :, None] - gc[..., None, :], -jnp.inf))
    k_beta = k * beta[..., None]
    v_beta = v * beta[..., None]
    A = jnp.where(strict, jnp.einsum('bhncd,bhnsd->bhncs', k_beta, k) * decay, 0.0)
    L = A + jnp.eye(C, dtype=A.dtype)
    rhs = jnp.concatenate([v_beta, k_beta * jnp.exp(gc)[..., None]], axis=-1)
    sol = lax.linalg.triangular_solve(L, rhs, left_side=True, lower=True, unit_diagonal=True)
    u, w = sol[..., :dv], sol[..., dv:]
    qk = jnp.einsum('bhncd,bhnsd->bhncs', q, k) * decay

    def step(S, inp):
        q_c, k_c, u_c, w_c, qk_c, gc_c = inp
        v_new = u_c - jnp.einsum('bhcd,bhde->bhce', w_c, S)
        o = (jnp.einsum('bhcd,bhde->bhce', q_c * jnp.exp(gc_c)[..., None], S)
             + jnp.einsum('bhcs,bhse->bhce', qk_c, v_new))
        g_last = gc_c[..., -1]
        S = (S * jnp.exp(g_last)[..., None, None]
             + jnp.einsum('bhcd,bhce->bhde', k_c * jnp.exp(g_last[..., None] - gc_c)[..., None], v_new))
        return S, o

    xs = tuple(jnp.moveaxis(t, 2, 0) for t in (q, k, u, w, qk, gc))
    _, o = lax.scan(step, jnp.zeros((B, H, dk, dv), jnp.float32), xs)
    return o.transpose(1, 0, 3, 2, 4).reshape(B, T, H, dv)


def rwkv7_branch(p, mu, w0, w_decay_up, a0, w_iclr_up, w_gate_up, k_k, k_a, r_k, lnx_g, lnx_b, w_pa):
    f32 = jnp.float32
    B, T, _ = p.shape
    prev = jnp.pad(p, ((0, 0), (1, 0), (0, 0)))[:, :T]
    p = p + (prev - p) * mu
    r, k, v, wl, al, gl = _split(p, RWKV_SPLITS)
    w_log = -jax.nn.softplus(-(w0 + jnp.tanh(wl) @ w_decay_up).astype(f32)) - 0.5
    decay = jnp.exp(-jnp.exp(w_log))
    a = jax.nn.sigmoid((a0 + al @ w_iclr_up).astype(f32))
    g = jax.nn.sigmoid(gl) @ w_gate_up

    def hd(t):
        return t.astype(f32).reshape(*t.shape[:-1], RWKV_HEADS, RWKV_HEAD_DIM)

    r, k, v, decay, a = hd(r), hd(k), hd(v), hd(decay), hd(a)
    kk = l2_normalize(k * hd(k_k))
    k = k * (1.0 + (a - 1.0) * hd(k_a))
    o = rwkv7_recurrence(r, decay, k, v, -kk, kk * a)
    mean = jnp.mean(o, axis=-1, keepdims=True)
    var = jnp.mean(jnp.square(o - mean), axis=-1, keepdims=True)
    o = (o - mean) * lax.rsqrt(var + RWKV_GN_EPS) * hd(lnx_g) + hd(lnx_b)
    o = o + jnp.sum(r * k * hd(r_k), axis=-1, keepdims=True) * v
    o = o.reshape(B, T, RWKV_WIDTH).astype(p.dtype) * g
    return o @ w_pa


def gated_deltanet_branch(p, conv_w, a_log, dt_bias, gdn_norm_g, w_pb):
    f32 = jnp.float32
    B, T, _ = p.shape
    qkv, a_in, b_in, z = _split(p, GDN_SPLITS)
    qkv = jax.nn.silu(causal_depthwise_conv(qkv, conv_w))
    q, k, v = [t.astype(f32).reshape(B, T, GDN_HEADS, GDN_HEAD_DIM) for t in jnp.split(qkv, 3, axis=-1)]
    q, k = l2_normalize(q), l2_normalize(k)
    beta = jax.nn.sigmoid(b_in.astype(f32))
    g_log = -jnp.exp(a_log.astype(f32)) * jax.nn.softplus(a_in.astype(f32) + dt_bias.astype(f32))
    o = chunked_gated_delta_rule(q, k, v, g_log, beta)
    o = o * lax.rsqrt(jnp.mean(o * o, axis=-1, keepdims=True) + NORM_EPS) * gdn_norm_g.astype(f32)
    o = o.reshape(B, T, GDN_WIDTH).astype(p.dtype) * jax.nn.silu(z)
    return o @ w_pb


def hybrid_mixer(h, w_in, mu, w0, w_decay_up, a0, w_iclr_up, w_gate_up, k_k, k_a, r_k, lnx_g, lnx_b,
                 w_pa, conv_w, a_log, dt_bias, gdn_norm_g, w_pb, w_out):
    proj = h @ w_in
    p_rwkv, p_gdn, p_gate = _split(proj, (RWKV_COLS, GDN_COLS, GATE_COLS))
    y_a = rwkv7_branch(p_rwkv, mu, w0, w_decay_up, a0, w_iclr_up, w_gate_up, k_k, k_a, r_k,
                       lnx_g, lnx_b, w_pa)
    y_b = gated_deltanet_branch(p_gdn, conv_w, a_log, dt_bias, gdn_norm_g, w_pb)
    g_a, g_b = jnp.split(p_gate, 2, axis=-1)
    y = jax.nn.sigmoid(g_a) * y_a + jax.nn.sigmoid(g_b) * y_b
    return y @ w_out


def moe_swiglu(h, router, w_gate, w_up, w_down):
    logits = (h @ router).astype(jnp.float32)
    top_v, top_i = lax.top_k(logits, TOP_K)
    gates = jax.nn.softmax(top_v, axis=-1)
    combine = jnp.sum(jax.nn.one_hot(top_i, N_EXPERTS, dtype=jnp.float32) * gates[..., None], axis=-2)
    combine = combine.astype(h.dtype)
    out = jnp.zeros_like(h)
    for e in range(N_EXPERTS):
        out = out + combine[..., e:e + 1] * swiglu(h, w_gate[e], w_up[e], w_down[e])
    return out


def setup_inputs(seed: int = 0) -> dict:
    key = jax.random.key(seed)
    ks = jax.random.split(key, 32)
    f32 = jnp.float32
    L, D = DEPTH, D_MODEL

    def nrm(k, shape, scale):
        return jax.random.normal(k, shape, f32) * scale

    dt = jnp.exp(jax.random.uniform(ks[17], (L, GDN_HEADS), f32, np.log(1e-3), np.log(1e-1)))
    return {
        'x': nrm(ks[0], (BATCH, SEQ, D), 1.0),
        'norm1_g': 1.0 + nrm(ks[1], (L, D), 0.02),
        'w_in': nrm(ks[2], (L, D, IN_COLS), D ** -0.5),
        'tshift_mu': jax.random.uniform(ks[3], (L, RWKV_COLS), f32),
        'w0': jax.random.uniform(ks[4], (L, RWKV_WIDTH), f32, -6.0, 1.0),
        'w_decay_up': nrm(ks[5], (L, DECAY_LORA, RWKV_WIDTH), 0.5 * DECAY_LORA ** -0.5),
        'a0': nrm(ks[6], (L, RWKV_WIDTH), 0.5),
        'w_iclr_up': nrm(ks[7], (L, ICLR_LORA, RWKV_WIDTH), ICLR_LORA ** -0.5),
        'w_gate_up': nrm(ks[8], (L, GATE_LORA, RWKV_WIDTH), GATE_LORA ** -0.5),
        'k_k': 1.0 + nrm(ks[9], (L, RWKV_WIDTH), 0.1),
        'k_a': 1.0 + nrm(ks[10], (L, RWKV_WIDTH), 0.1),
        'r_k': nrm(ks[11], (L, RWKV_WIDTH), 0.1),
        'lnx_g': 1.0 + nrm(ks[12], (L, RWKV_WIDTH), 0.02),
        'lnx_b': nrm(ks[13], (L, RWKV_WIDTH), 0.01),
        'w_pa': nrm(ks[14], (L, RWKV_WIDTH, D), RWKV_WIDTH ** -0.5),
        'conv_w': nrm(ks[15], (L, CONV_WIDTH, 3 * GDN_WIDTH), CONV_WIDTH ** -0.5),
        'a_log': jnp.log(jax.random.uniform(ks[16], (L, GDN_HEADS), f32, 1.0, 16.0)),
        'dt_bias': dt + jnp.log(-jnp.expm1(-dt)),
        'gdn_norm_g': 1.0 + nrm(ks[18], (L, GDN_HEAD_DIM), 0.02),
        'w_pb': nrm(ks[19], (L, GDN_WIDTH, D), GDN_WIDTH ** -0.5),
        'w_out': nrm(ks[20], (L, D, D), D ** -0.5),
        'norm2_g': 1.0 + nrm(ks[21], (L, D), 0.02),
        'ffn_w_gate': nrm(ks[22], (N_DENSE, D, D_FF), D ** -0.5),
        'ffn_w_up': nrm(ks[23], (N_DENSE, D, D_FF), D ** -0.5),
        'ffn_w_down': nrm(ks[24], (N_DENSE, D_FF, D), D_FF ** -0.5),
        'moe_router': nrm(ks[25], (N_MOE, D, N_EXPERTS), D ** -0.5),
        'moe_w_gate': nrm(ks[26], (N_MOE, N_EXPERTS, D, D_FF), D ** -0.5),
        'moe_w_up': nrm(ks[27], (N_MOE, N_EXPERTS, D, D_FF), D ** -0.5),
        'moe_w_down': nrm(ks[28], (N_MOE, N_EXPERTS, D_FF, D), D_FF ** -0.5),
        'final_g': 1.0 + nrm(ks[29], (D,), 0.02),
    }


def reference(x, norm1_g, w_in, tshift_mu, w0, w_decay_up, a0, w_iclr_up, w_gate_up, k_k, k_a, r_k,
              lnx_g, lnx_b, w_pa, conv_w, a_log, dt_bias, gdn_norm_g, w_pb, w_out, norm2_g,
              ffn_w_gate, ffn_w_up, ffn_w_down, moe_router, moe_w_gate, moe_w_up, moe_w_down, final_g):
    for layer in range(DEPTH):
        h = rms_norm(x, norm1_g[layer])
        x = x + hybrid_mixer(h, w_in[layer], tshift_mu[layer], w0[layer], w_decay_up[layer], a0[layer],
                             w_iclr_up[layer], w_gate_up[layer], k_k[layer], k_a[layer], r_k[layer],
                             lnx_g[layer], lnx_b[layer], w_pa[layer], conv_w[layer], a_log[layer],
                             dt_bias[layer], gdn_norm_g[layer], w_pb[layer], w_out[layer])
        h = rms_norm(x, norm2_g[layer])
        j = layer // 2
        if layer % 2 == 0:
            x = x + swiglu(h, ffn_w_gate[j], ffn_w_up[j], ffn_w_down[j])
        else:
            x = x + moe_swiglu(h, moe_router[j], moe_w_gate[j], moe_w_up[j], moe_w_down[j])
    return rms_norm(x, final_g)
```

```cpp
#include <hip/hip_runtime.h>
#include <cstdio>
#include <cstdint>
#pragma clang fp reassociate(on) contract(fast)

#ifndef MK_PER_PHASE
#define MK_PER_PHASE 0
#endif
#define PROBE_DUP -1
#define PADF (PROBE_DUP >= 0 ? A_.pad : 0)

#define GAS __attribute__((address_space(1)))
#define LAS __attribute__((address_space(3)))
typedef unsigned short bf16;
typedef unsigned v4u __attribute__((ext_vector_type(4)));
typedef unsigned v2u __attribute__((ext_vector_type(2)));
typedef float f32x4 __attribute__((ext_vector_type(4)));
typedef float f32x2 __attribute__((ext_vector_type(2)));
typedef short bf16x8 __attribute__((ext_vector_type(8)));
typedef GAS unsigned gu32;

constexpr int NWAVES = 8;
constexpr int BATCH = 32, T = 2048, D = 1024, M = BATCH * T;
constexpr int INC = 5896, NPROJ = 5888;
constexpr int C_R = 0, C_K = 512, C_V = 1024, C_WL = 1536, C_GQ = 1792, C_GK = 2304, C_GV = 2816, C_Z = 3328, C_GA = 3840, C_GB = 4864;
constexpr int SRC_AB = 3328;
constexpr int FF = 2816, NGU = 2 * FF, NE = 8;
constexpr int LISTCAP = 2 * M + 16 * 256;

constexpr size_t MiB = 1u << 20;
constexpr size_t WS_CTL = 0, CTL_ZERO_BYTES = 1 * MiB;
constexpr size_t WS_AB = 1 * MiB;
constexpr size_t WS_RE = 3 * MiB;
constexpr size_t WS_RG = WS_RE + (size_t)M * 4;
constexpr size_t WS_WGCNT = WS_RG + (size_t)M * 4;
constexpr size_t WS_GRP = WS_WGCNT + 256 * 16 * 4;
constexpr size_t WS_LIST = 4 * MiB;
constexpr size_t WS_GATEL = 5 * MiB;
constexpr size_t WS_W1 = 8 * MiB;
constexpr size_t WS_WS = 24 * MiB;
constexpr size_t WS_XN = 156 * MiB;
constexpr size_t WS_PROJ = 284 * MiB;
constexpr size_t WS_END = WS_PROJ + (size_t)M * NPROJ * 2;
static_assert(WS_END == 1020 * MiB, "ws map");
static_assert((size_t)LISTCAP * NGU <= (size_t)M * NPROJ * 2, "moe hidden fits in the PROJ region");
constexpr size_t MW_IN = 0, MW_PA = MW_IN + (size_t)NPROJ * D * 2, MW_PB = MW_PA + (size_t)D * 512 * 2, MW_OUT = MW_PB + (size_t)D * 512 * 2, MW_END = MW_OUT + (size_t)D * D * 2;
constexpr size_t FW_GU = MW_END, FW_DN = FW_GU + (size_t)NGU * D * 2, FW_END = FW_DN + (size_t)D * FF * 2;
constexpr size_t EW_GU = 56 * MiB, EW_DN = EW_GU + (size_t)NE * NGU * D;
static_assert(WS_W1 + MW_END <= WS_WS && FW_END <= EW_GU && WS_WS + EW_DN + (size_t)NE * D * FF <= WS_XN, "weight map");
constexpr int NE_EARLY = 3;
constexpr int CW_BAR = 4096;

constexpr int RING_BYTES = 131072;
constexpr int LDSCTL_OFF = RING_BYTES, MISC_OFF = LDSCTL_OFF + 320;
constexpr int LDS_BYTES = 147456;

#define RLX_AGENT __ATOMIC_RELAXED, __HIP_MEMORY_SCOPE_AGENT
#define LDS_WAIT() asm volatile("s_waitcnt lgkmcnt(0)" ::: "memory")
#define VM_WAIT() asm volatile("s_waitcnt vmcnt(0)" ::: "memory")
__device__ __forceinline__ unsigned f2bf(float f) { return (unsigned)__builtin_bit_cast(unsigned short, (__bf16)f); }
typedef __bf16 bf16v2_t __attribute__((ext_vector_type(2)));
__device__ __forceinline__ unsigned pk2(float lo, float hi) { const f32x2 v = {lo, hi}; return __builtin_bit_cast(unsigned, __builtin_convertvector(v, bf16v2_t)); }
__device__ __forceinline__ float bf_lo(unsigned w) { return __builtin_bit_cast(float, w << 16); }
__device__ __forceinline__ float bf_hi(unsigned w) { return __builtin_bit_cast(float, w & 0xffff0000u); }
__device__ __forceinline__ float bf2f(bf16 v) { return __builtin_bit_cast(float, (unsigned)v << 16); }
__device__ __forceinline__ float sigmoidf_(float x) { return __builtin_amdgcn_rcpf(1.0f + __expf(-x)); }
__device__ __forceinline__ float softplusf_(float x) { return x > 20.f ? x : log1pf(__expf(x)); }
__device__ __forceinline__ unsigned f8x4(float a, float b, float c, float d) {
    a = __builtin_amdgcn_fmed3f(a, -448.f, 448.f); b = __builtin_amdgcn_fmed3f(b, -448.f, 448.f); c = __builtin_amdgcn_fmed3f(c, -448.f, 448.f); d = __builtin_amdgcn_fmed3f(d, -448.f, 448.f);
    int w = __builtin_amdgcn_cvt_pk_fp8_f32(a, b, 0, false); w = __builtin_amdgcn_cvt_pk_fp8_f32(c, d, w, true); return (unsigned)w; }
constexpr float F8_SX = 8.f, F8_SW = 256.f, F8_SH = 8.f;

namespace pg8 {
constexpr int BM = 256, BK = 64, HALF = 128, HTB = HALF * BK * 2, STAGE_BYTES = 8 * HTB, NXCD = 8, WGM = 4;
__host__ __device__ __forceinline__ int lds_byte(int r, int c) { const int st = (r >> 4) * 2 + (c >> 5), rr = r & 15, cc = c & 31, ob = rr * 64 + cc * 2; return st * 1024 + (ob ^ (((ob >> 9) & 1) << 5)); }
__host__ __device__ __forceinline__ void stage_rc(int b, int& R, int& C) { const int st = b / 1024, sb = b % 1024, swz = sb ^ (((sb >> 9) & 1) << 5); R = (st >> 1) * 16 + swz / 64; C = (st & 1) * 32 + (swz % 64) / 2; }
__host__ __device__ __forceinline__ int perm32(int rho) { const int n = rho >> 4, i = rho & 15; return 8 * (i >> 2) + 4 * n + (i & 3); }

struct Unit { int pm, pn, pb; };
struct Gemm { const bf16* A; const bf16* Bt; int lda, ldb, K; const int* rows; };

struct StaticOrder {
    int nM, nN, nwg, G, c;
    __device__ void init(int nM_, int nN_, int G_, int c_) { nM = nM_; nN = nN_; nwg = nM * nN; G = G_; c = c_; }
    __device__ bool next(int i, Unit& u) const {
        const long L = (long)i * G + c; if (L >= nwg) return false;
        int wgid = (int)L; { const int q = nwg / NXCD, r = nwg % NXCD, xcd = wgid % NXCD, off = wgid / NXCD; wgid = (xcd < r ? xcd * (q + 1) : r * (q + 1) + (xcd - r) * q) + off; }
        const int nig = WGM * nN, gid = wgid / nig, fm = gid * WGM, gsz = (nM - fm) < WGM ? (nM - fm) : WGM;
        u.pm = fm + ((wgid % nig) % gsz); u.pn = (wgid % nig) / gsz; u.pb = u.pn; return true;
    }
};
struct MoeOrder {
    int nM, nN, nwg, G, c, p0; int gb[16];
    __device__ void init(const int* grp, int p0_, int nM_, int nN_, int G_, int c_) { p0 = p0_; nM = nM_; nN = nN_; nwg = nM * nN; G = G_; c = c_;
#pragma unroll
        for (int k = 0; k < 16; ++k) gb[k] = grp[k]; }
    __device__ bool next(int i, Unit& u) const {
        const long L = (long)i * G + c; if (L >= nwg) return false;
        int wgid = (int)L; { const int q = nwg / NXCD, r = nwg % NXCD, xcd = wgid % NXCD, off = wgid / NXCD; wgid = (xcd < r ? xcd * (q + 1) : r * (q + 1) + (xcd - r) * q) + off; }
        const int nig = WGM * nN, gid = wgid / nig, fm = gid * WGM, gsz = (nM - fm) < WGM ? (nM - fm) : WGM;
        u.pm = p0 + fm + ((wgid % nig) % gsz); u.pn = (wgid % nig) / gsz;
        const int rowpos = u.pm * BM; int g = 0;
#pragma unroll
        for (int k = 1; k < 16; ++k) g += (rowpos >= gb[k]) ? 1 : 0;
        u.pb = (g & 7) * nN + u.pn; return true;
    }
};

__device__ __forceinline__ unsigned cvt_pk_bf16(float lo, float hi) { unsigned r; asm volatile("v_cvt_pk_bf16_f32 %0, %1, %2" : "=v"(r) : "v"(lo), "v"(hi)); return r; }

struct EpiBf16Plain {
    static constexpr bool PERM = true;
    bf16* O; int ldc;
    __device__ __forceinline__ void operator()(const f32x4 (&acc)[2][2][4][2], const Unit& u, int wr, int wc, int fr, int fq) const {
        const int row0 = u.pm * BM + wr * 64 + fr, col0 = u.pn * BM + wc * 32 + 8 * fq;
#pragma unroll
        for (int ai = 0; ai < 2; ++ai)
#pragma unroll
            for (int m = 0; m < 4; ++m) { bf16* rowp = O + (size_t)(row0 + ai * HALF + m * 16) * ldc + col0;
#pragma unroll
                for (int bj = 0; bj < 2; ++bj) { const f32x4 v0 = acc[ai][bj][m][0], v1 = acc[ai][bj][m][1];
                    v4u w; w.x = cvt_pk_bf16(v0[0], v0[1]); w.y = cvt_pk_bf16(v0[2], v0[3]); w.z = cvt_pk_bf16(v1[0], v1[1]); w.w = cvt_pk_bf16(v1[2], v1[3]);
                    *(v4u*)(rowp + bj * HALF) = w; } }
    }
};
template <bool FIRST> struct EpiMerge {
    static constexpr bool PERM = true;
    bf16* Y; const bf16* Gt; int ldc;
    __device__ __forceinline__ void operator()(const f32x4 (&acc)[2][2][4][2], const Unit& u, int wr, int wc, int fr, int fq) const {
        const int row0 = u.pm * BM + wr * 64 + fr, col0 = u.pn * BM + wc * 32 + 8 * fq;
#pragma unroll
        for (int ai = 0; ai < 2; ++ai)
#pragma unroll
            for (int mp = 0; mp < 2; ++mp) {
                v4u gw[2][2], yw[2][2];
#pragma unroll
                for (int mm = 0; mm < 2; ++mm)
#pragma unroll
                    for (int bj = 0; bj < 2; ++bj) { const size_t ro = (size_t)(row0 + ai * HALF + (2 * mp + mm) * 16) * ldc + col0 + bj * HALF;
                        gw[mm][bj] = *(const v4u*)(Gt + ro); if (!FIRST) yw[mm][bj] = *(const v4u*)(Y + ro); }
#pragma unroll
                for (int mm = 0; mm < 2; ++mm)
#pragma unroll
                    for (int bj = 0; bj < 2; ++bj) { const int m = 2 * mp + mm; const size_t ro = (size_t)(row0 + ai * HALF + m * 16) * ldc + col0 + bj * HALF;
                        const f32x4 v0 = acc[ai][bj][m][0], v1 = acc[ai][bj][m][1]; const v4u g4 = gw[mm][bj];
                        auto mg2 = [](unsigned gw2, float a0, float a1) { const f32x2 t = (f32x2){bf_lo(gw2), bf_hi(gw2)} * (f32x2){-1.44269504089f, -1.44269504089f};
                            f32x2 e; e[0] = __builtin_amdgcn_exp2f(t[0]); e[1] = __builtin_amdgcn_exp2f(t[1]); const f32x2 d = e + (f32x2){1.0f, 1.0f};
                            f32x2 r; r[0] = __builtin_amdgcn_rcpf(d[0]); r[1] = __builtin_amdgcn_rcpf(d[1]); return r * (f32x2){a0, a1}; };
                        f32x2 o[4];
                        o[0] = mg2(g4.x, v0[0], v0[1]); o[1] = mg2(g4.y, v0[2], v0[3]); o[2] = mg2(g4.z, v1[0], v1[1]); o[3] = mg2(g4.w, v1[2], v1[3]);
                        if (!FIRST) { const v4u y4 = yw[mm][bj];
                            o[0] += (f32x2){bf_lo(y4.x), bf_hi(y4.x)}; o[1] += (f32x2){bf_lo(y4.y), bf_hi(y4.y)}; o[2] += (f32x2){bf_lo(y4.z), bf_hi(y4.z)}; o[3] += (f32x2){bf_lo(y4.w), bf_hi(y4.w)}; }
                        v4u w; w.x = cvt_pk_bf16(o[0][0], o[0][1]); w.y = cvt_pk_bf16(o[1][0], o[1][1]); w.z = cvt_pk_bf16(o[2][0], o[2][1]); w.w = cvt_pk_bf16(o[3][0], o[3][1]);
                        *(v4u*)(Y + ro) = w; }
            }
    }
};
struct EpiResid {
    static constexpr bool PERM = false;
    const float* base; float* out; int ldc;
    __device__ __forceinline__ void operator()(const f32x4 (&acc)[2][2][4][2], const Unit& u, int wr, int wc, int fr, int fq) const {
        const int row0 = u.pm * BM + wr * 64 + fr, col0 = u.pn * BM + wc * 32 + 4 * fq;
        f32x4 bs[2][2][2][2];
#define ER_LOAD(q, slot) do { _Pragma("unroll") for (int mm = 0; mm < 2; ++mm) _Pragma("unroll") for (int bj = 0; bj < 2; ++bj) _Pragma("unroll") for (int n = 0; n < 2; ++n) \
            bs[slot][mm][bj][n] = *(const f32x4*)(base + (size_t)(row0 + ((q) >> 1) * HALF + (2 * ((q) & 1) + mm) * 16) * ldc + col0 + bj * HALF + n * 16); } while (0)
#define ER_STORE(q, slot) do { _Pragma("unroll") for (int mm = 0; mm < 2; ++mm) _Pragma("unroll") for (int bj = 0; bj < 2; ++bj) _Pragma("unroll") for (int n = 0; n < 2; ++n) \
            *(f32x4*)(out + (size_t)(row0 + ((q) >> 1) * HALF + (2 * ((q) & 1) + mm) * 16) * ldc + col0 + bj * HALF + n * 16) = bs[slot][mm][bj][n] + acc[(q) >> 1][bj][2 * ((q) & 1) + mm][n]; } while (0)
        ER_LOAD(0, 0); ER_LOAD(1, 1); ER_STORE(0, 0); ER_LOAD(2, 0); ER_STORE(1, 1); ER_LOAD(3, 1); ER_STORE(2, 0); ER_STORE(3, 1);
#undef ER_LOAD
#undef ER_STORE
    }
};
__device__ __forceinline__ f32x2 silu_mul2(const f32x2 g, const f32x2 up, float c1, float lc, float kinv) {
    const f32x2 a = g * (f32x2){c1, c1} + (f32x2){lc, lc};
    f32x2 e; e[0] = __builtin_amdgcn_exp2f(a[0]); e[1] = __builtin_amdgcn_exp2f(a[1]);
    const f32x2 d = e + (f32x2){kinv, kinv};
    f32x2 r; r[0] = __builtin_amdgcn_rcpf(d[0]); r[1] = __builtin_amdgcn_rcpf(d[1]);
    return (g * up) * r;
}
struct EpiSwiglu {
    static constexpr bool PERM = true;
    bf16* H; int ldc;
    __device__ __forceinline__ void operator()(const f32x4 (&acc)[2][2][4][2], const Unit& u, int wr, int wc, int fr, int fq) const {
        const int row0 = u.pm * BM + wr * 64 + fr, col0 = u.pn * HALF + wc * 32 + 8 * fq;
#pragma unroll
        for (int ai = 0; ai < 2; ++ai)
#pragma unroll
            for (int m = 0; m < 4; ++m) { bf16* rowp = H + (size_t)(row0 + ai * HALF + m * 16) * ldc + col0;
                f32x2 o[4];
#pragma unroll
                for (int n = 0; n < 2; ++n)
#pragma unroll
                    for (int jp = 0; jp < 2; ++jp) { const f32x4 g4 = acc[ai][0][m][n], u4 = acc[ai][1][m][n];
                        o[n * 2 + jp] = silu_mul2((f32x2){g4[2 * jp], g4[2 * jp + 1]}, (f32x2){u4[2 * jp], u4[2 * jp + 1]}, -1.44269504089f, 0.f, 1.0f); }
                v4u w; w.x = cvt_pk_bf16(o[0][0], o[0][1]); w.y = cvt_pk_bf16(o[1][0], o[1][1]); w.z = cvt_pk_bf16(o[2][0], o[2][1]); w.w = cvt_pk_bf16(o[3][0], o[3][1]);
                *(v4u*)rowp = w; }
    }
};
struct EpiSwigluF8 {
    static constexpr bool PERM = true;
    unsigned char* H; int ldc; float insc, osc;
    __device__ __forceinline__ void operator()(const f32x4 (&acc)[2][2][4][2], const Unit& u, int wr, int wc, int fr, int fq) const {
        const int row0 = u.pm * BM + wr * 64 + fr, col0 = u.pn * HALF + wc * 32 + 8 * fq;
#pragma unroll
        for (int ai = 0; ai < 2; ++ai)
#pragma unroll
            for (int m = 0; m < 4; ++m) { unsigned char* rowp = H + (size_t)(row0 + ai * HALF + m * 16) * ldc + col0;
                const float c2 = insc * insc * osc, c1 = -1.44269504089f * insc, lc = -__builtin_log2f(c2), kinv = 1.0f / c2;
                f32x2 o[4];
#pragma unroll
                for (int n = 0; n < 2; ++n)
#pragma unroll
                    for (int jp = 0; jp < 2; ++jp) { const f32x4 g4 = acc[ai][0][m][n], u4 = acc[ai][1][m][n];
                        o[n * 2 + jp] = silu_mul2((f32x2){g4[2 * jp], g4[2 * jp + 1]}, (f32x2){u4[2 * jp], u4[2 * jp + 1]}, c1, lc, kinv); }
                v2u w; w.x = f8x4(o[0][0], o[0][1], o[1][0], o[1][1]); w.y = f8x4(o[2][0], o[2][1], o[3][0], o[3][1]);
                *(v2u*)rowp = w; }
    }
};
struct EpiMoeDown {
    static constexpr bool PERM = false;
    float* out; const int* list; const float* gatel; bf16* tmp; int split; float sc;
    __device__ __forceinline__ void operator()(const f32x4 (&acc)[2][2][4][2], const Unit& u, int wr, int wc, int fr, int fq) const {
        const int row0 = u.pm * BM + wr * 64 + fr, col0 = u.pn * BM + wc * 32 + 4 * fq;
        int tok[2][4]; float gt[2][4];
#pragma unroll
        for (int ai = 0; ai < 2; ++ai)
#pragma unroll
            for (int m = 0; m < 4; ++m) { const int p = row0 + ai * HALF + m * 16; tok[ai][m] = list[p]; gt[ai][m] = gatel[p] * sc; }
        if (u.pm * BM >= split) {
#pragma unroll
            for (int ai = 0; ai < 2; ++ai)
#pragma unroll
                for (int m = 0; m < 4; ++m) { const int tk = tok[ai][m]; const float g = gt[ai][m];
                    if (tk >= 0) { bf16* rowp = tmp + (size_t)tk * D + col0;
#pragma unroll
                        for (int bj = 0; bj < 2; ++bj)
#pragma unroll
                            for (int n = 0; n < 2; ++n) { const f32x4 o = acc[ai][bj][m][n] * g; v2u w; w.x = cvt_pk_bf16(o[0], o[1]); w.y = cvt_pk_bf16(o[2], o[3]); *(v2u*)(rowp + bj * HALF + n * 16) = w; } } }
            return;
        }
#pragma unroll
        for (int ai = 0; ai < 2; ++ai)
#pragma unroll
            for (int mp = 0; mp < 2; ++mp) {
                f32x4 bs[2][2][2];
#pragma unroll
                for (int mm = 0; mm < 2; ++mm) { const int tk = tok[ai][2 * mp + mm]; const float* rowp = out + (size_t)(tk < 0 ? 0 : tk) * D + col0;
#pragma unroll
                    for (int bj = 0; bj < 2; ++bj)
#pragma unroll
                        for (int n = 0; n < 2; ++n) bs[mm][bj][n] = *(const f32x4*)(rowp + bj * HALF + n * 16); }
#pragma unroll
                for (int mm = 0; mm < 2; ++mm) { const int tk = tok[ai][2 * mp + mm]; const float g = gt[ai][2 * mp + mm];
                    if (tk >= 0) { float* rowp = out + (size_t)tk * D + col0;
#pragma unroll
                        for (int bj = 0; bj < 2; ++bj)
#pragma unroll
                            for (int n = 0; n < 2; ++n) *(f32x4*)(rowp + bj * HALF + n * 16) = bs[mm][bj][n] + acc[ai][bj][2 * mp + mm][n] * g; } }
            }
    }
};

typedef int v4i_t __attribute__((ext_vector_type(4)));
typedef int v8i_t __attribute__((ext_vector_type(8)));
__device__ __forceinline__ v8i_t cat8(const bf16x8 a, const bf16x8 b) { return __builtin_shufflevector(__builtin_bit_cast(v4i_t, a), __builtin_bit_cast(v4i_t, b), 0, 1, 2, 3, 4, 5, 6, 7); }
template <class Epi, class Sched, bool ALIGN_EPI, bool SP2, bool GATHER, bool F8 = false>
__device__ __forceinline__ void gemm_phase(LAS unsigned char* lds, const Gemm g, const Sched& S, const Epi& E) {
    constexpr unsigned EB = F8 ? 1u : 2u;
    const int f8one = 0x7F7F7F7F;
    const int tid = threadIdx.x, wid = __builtin_amdgcn_readfirstlane(tid >> 6), lane = tid & 63, wr = wid >> 2, wc = wid & 3, fr = lane & 15, fq = lane >> 4;
    const int K = g.K, nt = K / (F8 ? 2 * BK : BK);
    unsigned voffA[2], voffB[2]; int stR[2], stC[2];
#pragma unroll
    for (int i = 0; i < 2; ++i) { int R, C; stage_rc(tid * 16 + i * 8192, R, C); const int Rb = Epi::PERM ? ((R & ~31) + perm32(R & 31)) : R;
        voffA[i] = (unsigned)(R * g.lda) * EB + (unsigned)C * 2u; voffB[i] = (unsigned)(Rb * g.ldb) * EB + (unsigned)C * 2u; stR[i] = R; stC[i] = C; }
    const size_t kstep = (size_t)(BK * 2);
    const size_t hstepA = (size_t)HALF * g.lda * EB, tstepA = 2 * hstepA, hstepB = (size_t)HALF * g.ldb * EB, tstepB = 2 * hstepB;
    const unsigned ldsw = (unsigned)wid * 1024u;
    const int aoff = lds_byte(wr * 64 + fr, fq * 8), boff = lds_byte(wc * 32 + fr, fq * 8);
    unsigned gAc[2][2], gAn[2][2];
#define PG8_SA(b, h) (((b) * 2 + (h)) * HTB)
#define PG8_SB(b, h) ((4 + (b) * 2 + (h)) * HTB)
#define PG8_GLDS(src, bufoff, i) __builtin_amdgcn_global_load_lds((const unsigned*)(src), (LAS unsigned*)(lds + (bufoff) + ldsw + (i) * 8192), 16, 0, 0)
#define PG8_STAGE_B(bufoff, gbase) do { _Pragma("unroll") for (int _i = 0; _i < 2; ++_i) PG8_GLDS((const char*)(gbase) + voffB[_i], bufoff, _i); } while (0)
#define PG8_STAGE_A(bufoff, h, NX, kb) do { \
        if constexpr (GATHER) { _Pragma("unroll") for (int _i = 0; _i < 2; ++_i) { const unsigned _o = (NX) ? gAn[h][_i] : gAc[h][_i]; PG8_GLDS((const char*)g.A + _o + (kb), bufoff, _i); } } \
        else { const char* _b = ((NX) ? nA : cA) + (h) * hstepA + (kb); _Pragma("unroll") for (int _i = 0; _i < 2; ++_i) PG8_GLDS(_b + voffA[_i], bufoff, _i); } } while (0)
#define PG8_LDA(dst, b, h) do { _Pragma("unroll") for (int m = 0; m < 4; ++m) _Pragma("unroll") for (int k = 0; k < 2; ++k) dst[m][k] = *(const LAS bf16x8*)(lds + PG8_SA(b, h) + aoff + m * 2048 + k * 1024); } while (0)
#define PG8_LDB(dst, b, h) do { _Pragma("unroll") for (int n = 0; n < 2; ++n) _Pragma("unroll") for (int k = 0; k < 2; ++k) dst[n][k] = *(const LAS bf16x8*)(lds + PG8_SB(b, h) + boff + n * 2048 + k * 1024); } while (0)
#define PG8_MMA(ai, bj, At, Bt) do { __builtin_amdgcn_s_setprio(1); _Pragma("unroll") for (int m = 0; m < 4; ++m) _Pragma("unroll") for (int n = 0; n < 2; ++n) { \
        if constexpr (F8) asm("v_mfma_scale_f32_16x16x128_f8f6f4 %0, %1, %2, %0, %3, %3 op_sel_hi:[0,0,0]" : "+v"(acc[ai][bj][m][n]) : "v"(cat8(Bt[n][0], Bt[n][1])), "v"(cat8(At[m][0], At[m][1])), "v"(f8one)); \
        else { _Pragma("unroll") for (int k = 0; k < 2; ++k) acc[ai][bj][m][n] = __builtin_amdgcn_mfma_f32_16x16x32_bf16(Bt[n][k], At[m][k], acc[ai][bj][m][n], 0, 0, 0); } } __builtin_amdgcn_s_setprio(0); } while (0)
#define PG8_WAIT_V(n) asm volatile("s_waitcnt vmcnt(" #n ")" ::: "memory")
#define PG8_WAIT_L(n) asm volatile("s_waitcnt lgkmcnt(" #n ")" ::: "memory")
#define PG8_BAR __builtin_amdgcn_s_barrier()
#define PG8_SCHED __builtin_amdgcn_sched_barrier(0)
#define PG8_GOFF(dst, unit) do { _Pragma("unroll") for (int _h = 0; _h < 2; ++_h) _Pragma("unroll") for (int _i = 0; _i < 2; ++_i) { int _t = g.rows[(unit).pm * BM + _h * HALF + stR[_i]]; _t = _t < 0 ? 0 : _t; \
        dst[_h][_i] = (unsigned)_t * ((unsigned)g.lda * EB) + (unsigned)(stC[_i] * 2); } } while (0)
    Unit cur, nxt; int ui = 0;
    if (!S.next(0, cur)) return;
    f32x4 acc[2][2][4][2];
#pragma unroll
    for (int a = 0; a < 2; ++a)
#pragma unroll
        for (int b = 0; b < 2; ++b)
#pragma unroll
            for (int m = 0; m < 4; ++m)
#pragma unroll
                for (int n = 0; n < 2; ++n) acc[a][b][m][n] = (f32x4){0.f, 0.f, 0.f, 0.f};
    bf16x8 At[4][2], B0[2][2], B1[2][2];
    const char* cA = (const char*)g.A + (size_t)cur.pm * tstepA; const char* cB = (const char*)g.Bt + (size_t)cur.pb * tstepB;
    const char* nA = cA;
    if constexpr (GATHER) { PG8_GOFF(gAc, cur); _Pragma("unroll") for (int _h = 0; _h < 2; ++_h) _Pragma("unroll") for (int _i = 0; _i < 2; ++_i) gAn[_h][_i] = gAc[_h][_i]; }
    if constexpr (SP2) {
        PG8_STAGE_B(PG8_SB(0, 0), cB); PG8_STAGE_B(PG8_SB(0, 1), cB + hstepB); PG8_STAGE_A(PG8_SA(0, 0), 0, false, 0); PG8_STAGE_A(PG8_SA(0, 1), 1, false, 0);
        if (wr == 1) PG8_BAR;
        PG8_WAIT_V(2); PG8_BAR;
        PG8_STAGE_B(PG8_SB(1, 0), cB + kstep); PG8_STAGE_A(PG8_SA(1, 0), 0, false, kstep); PG8_STAGE_B(PG8_SB(1, 1), cB + hstepB + kstep);
        PG8_WAIT_V(6); PG8_BAR;
    } else {
        PG8_STAGE_B(PG8_SB(0, 0), cB); PG8_STAGE_A(PG8_SA(0, 0), 0, false, 0); PG8_STAGE_B(PG8_SB(0, 1), cB + hstepB); PG8_STAGE_A(PG8_SA(0, 1), 1, false, 0);
        if (wr == 1) PG8_BAR;
        PG8_WAIT_V(4); PG8_BAR;
        PG8_STAGE_B(PG8_SB(1, 0), cB + kstep); PG8_STAGE_A(PG8_SA(1, 0), 0, false, kstep); PG8_STAGE_B(PG8_SB(1, 1), cB + hstepB + kstep);
        PG8_WAIT_V(6); PG8_BAR;
    }
    for (;;) {
        const bool has_next = S.next(ui + 1, nxt);
        nA = has_next ? (const char*)g.A + (size_t)nxt.pm * tstepA : cA; const char* nB = has_next ? (const char*)g.Bt + (size_t)nxt.pb * tstepB : cB;
        if constexpr (GATHER) { if (has_next) PG8_GOFF(gAn, nxt); }
        for (int t = 0; t < nt; t += 2) {
            const bool last = (t == nt - 2);
            const size_t k1 = (size_t)(t + 1) * kstep;
            const size_t k2 = last ? 0 : (size_t)(t + 2) * kstep, k3 = k2 + kstep;
            const char* b2 = last ? nB : cB + (size_t)(t + 2) * kstep; const char* b3 = b2 + kstep;
            if constexpr (SP2) {
            PG8_LDB(B0, 0, 0); PG8_LDB(B1, 0, 1); PG8_SCHED; PG8_LDA(At, 0, 0); PG8_STAGE_A(PG8_SA(1, 1), 1, false, k1);
            PG8_WAIT_V(8); PG8_WAIT_L(0); PG8_BAR; PG8_MMA(0, 0, At, B0); PG8_MMA(0, 1, At, B1); PG8_BAR; PG8_SCHED;
            PG8_LDA(At, 0, 1); PG8_STAGE_B(PG8_SB(0, 0), b2); PG8_STAGE_B(PG8_SB(0, 1), b2 + hstepB); PG8_STAGE_A(PG8_SA(0, 0), 0, last, k2);
            PG8_WAIT_V(8); PG8_WAIT_L(0); PG8_BAR; PG8_MMA(1, 0, At, B0); PG8_MMA(1, 1, At, B1); PG8_BAR; PG8_SCHED;
            PG8_LDB(B0, 1, 0); PG8_LDB(B1, 1, 1); PG8_SCHED; PG8_LDA(At, 1, 0); PG8_STAGE_A(PG8_SA(0, 1), 1, last, k2);
            PG8_WAIT_V(8); PG8_WAIT_L(0); PG8_BAR; PG8_MMA(0, 0, At, B0); PG8_MMA(0, 1, At, B1); PG8_BAR; PG8_SCHED;
            PG8_LDA(At, 1, 1); PG8_STAGE_B(PG8_SB(1, 0), b3); PG8_STAGE_B(PG8_SB(1, 1), b3 + hstepB); PG8_STAGE_A(PG8_SA(1, 0), 0, last, k3);
            PG8_WAIT_V(8); PG8_WAIT_L(0); PG8_BAR; PG8_MMA(1, 0, At, B0); PG8_MMA(1, 1, At, B1); PG8_BAR; PG8_SCHED;
            } else {
            PG8_LDB(B0, 0, 0); PG8_SCHED; PG8_LDA(At, 0, 0); PG8_STAGE_A(PG8_SA(1, 1), 1, false, k1);
            PG8_WAIT_L(8); PG8_BAR; PG8_WAIT_L(0); PG8_MMA(0, 0, At, B0); PG8_BAR; PG8_SCHED;
            PG8_LDB(B1, 0, 1); PG8_STAGE_B(PG8_SB(0, 0), b2);
            PG8_BAR; PG8_WAIT_L(0); PG8_MMA(0, 1, At, B1); PG8_BAR;
            PG8_LDA(At, 0, 1); PG8_STAGE_A(PG8_SA(0, 0), 0, last, k2);
            PG8_BAR; PG8_WAIT_L(0); PG8_MMA(1, 0, At, B0); PG8_BAR; PG8_SCHED;
            PG8_STAGE_B(PG8_SB(0, 1), b2 + hstepB);
            PG8_WAIT_V(6); PG8_BAR; PG8_MMA(1, 1, At, B1); PG8_BAR;
            PG8_LDB(B0, 1, 0); PG8_SCHED; PG8_LDA(At, 1, 0); PG8_STAGE_A(PG8_SA(0, 1), 1, last, k2);
            PG8_WAIT_L(8); PG8_BAR; PG8_WAIT_L(0); PG8_MMA(0, 0, At, B0); PG8_BAR; PG8_SCHED;
            PG8_LDB(B1, 1, 1); PG8_STAGE_B(PG8_SB(1, 0), b3);
            PG8_BAR; PG8_WAIT_L(0); PG8_MMA(0, 1, At, B1); PG8_BAR;
            PG8_LDA(At, 1, 1); PG8_STAGE_A(PG8_SA(1, 0), 0, last, k3);
            PG8_BAR; PG8_WAIT_L(0); PG8_MMA(1, 0, At, B0); PG8_BAR; PG8_SCHED;
            PG8_STAGE_B(PG8_SB(1, 1), b3 + hstepB);
            PG8_WAIT_V(6); PG8_BAR; PG8_MMA(1, 1, At, B1); PG8_BAR;
            }
        }
        if constexpr (F8) { asm volatile("s_nop 15\n\ts_nop 15" ::: "memory"); PG8_SCHED; }
        if constexpr (ALIGN_EPI) { if (wr == 0) PG8_BAR; }
        E(acc, cur, wr, wc, fr, fq);
        if (!has_next) break;
#pragma unroll
        for (int a = 0; a < 2; ++a)
#pragma unroll
            for (int b = 0; b < 2; ++b)
#pragma unroll
                for (int m = 0; m < 4; ++m)
#pragma unroll
                    for (int n = 0; n < 2; ++n) acc[a][b][m][n] = (f32x4){0.f, 0.f, 0.f, 0.f};
        cur = nxt; cA = nA; cB = nB; ++ui;
        if constexpr (GATHER) { _Pragma("unroll") for (int _h = 0; _h < 2; ++_h) _Pragma("unroll") for (int _i = 0; _i < 2; ++_i) gAc[_h][_i] = gAn[_h][_i]; }
        if constexpr (ALIGN_EPI) { if (wr == 1) PG8_BAR; }
    }
    PG8_WAIT_V(0);
    if constexpr (!ALIGN_EPI) { if (wr == 0) PG8_BAR; }
    PG8_BAR;
#undef PG8_SA
#undef PG8_SB
#undef PG8_GLDS
#undef PG8_STAGE_A
#undef PG8_STAGE_B
#undef PG8_LDA
#undef PG8_LDB
#undef PG8_MMA
#undef PG8_WAIT_V
#undef PG8_WAIT_L
#undef PG8_BAR
#undef PG8_SCHED
#undef PG8_GOFF
}
}

#define XB_TMO      128
#define XB_XCNT(j)  (256  + 64 * (j))
#define XB_XSUB(j)  (1280 + 64 * (j))
#define XB_XGEN(j)  (2304 + 64 * (j))
#define XB_TOP      3328
#define XB_TOPGEN   3392
#define XCD_BAR_WORDS 3456
#define XB_SPIN_CAP (1u << 18)
__device__ __forceinline__ unsigned xb_ld(unsigned* p)              { return __hip_atomic_load(p, __ATOMIC_RELAXED, __HIP_MEMORY_SCOPE_AGENT); }
__device__ __forceinline__ unsigned xb_add(unsigned* p, unsigned v) { return __hip_atomic_fetch_add(p, v, __ATOMIC_RELAXED, __HIP_MEMORY_SCOPE_AGENT); }
__device__ __forceinline__ unsigned xb_xcc_id() { return (unsigned)__builtin_amdgcn_s_getreg((3 << 11) | 20) & 0xFu; }
#define XB_SPIN(cond, bar) do { unsigned _sp = 0; while (cond) { __builtin_amdgcn_s_sleep(1); \
    if ((++_sp & 255u) == 0u) { if (xb_ld(&(bar)[XB_TMO])) break; if (_sp > XB_SPIN_CAP) { atomicAdd(&(bar)[XB_TMO], 1u); break; } } } } while (0)
struct XcdBarrier { unsigned* bar; unsigned x; volatile LAS unsigned* st; };
__device__ __forceinline__ XcdBarrier xcd_barrier_post(unsigned* bar, volatile LAS unsigned* st) {
    XcdBarrier b; b.bar = bar; b.x = xb_xcc_id(); b.st = st;
    if (threadIdx.x == 0) (void)xb_add(&bar[XB_XCNT(b.x)], 1u);
    return b;
}
__device__ __forceinline__ void xcd_barrier_complete(unsigned* bar, unsigned x, unsigned& nloc, unsigned& nx) {
    const unsigned G = gridDim.x * gridDim.y * gridDim.z;
    unsigned sum, cnt, mine, sp = 0u;
    for (;;) {
        sum = 0u; cnt = 0u; mine = 0u;
#pragma unroll
        for (unsigned j = 0; j < 16; ++j) { const unsigned c = xb_ld(&bar[XB_XCNT(j)]); sum += c; cnt += (c > 0u) ? 1u : 0u; mine = (j == x) ? c : mine; }
        if (sum == G) break;
        __builtin_amdgcn_s_sleep(1);
        if ((++sp & 255u) == 0u) { if (xb_ld(&bar[XB_TMO])) break; if (sp > XB_SPIN_CAP) { atomicAdd(&bar[XB_TMO], 1u); break; } }
    }
    nloc = mine > 0u ? mine : 1u; nx = cnt > 0u ? cnt : 1u;
}
__device__ __forceinline__ void xcd_barrier(const XcdBarrier& b) {
    asm volatile("s_waitcnt vmcnt(0)" ::: "memory");
    __syncthreads();
    if (threadIdx.x == 0) {
        unsigned* bar = b.bar;
        __builtin_amdgcn_s_waitcnt(0);
        unsigned nloc = b.st[0], nx = b.st[1];
        if (nloc == 0u) { xcd_barrier_complete(bar, b.x, nloc, nx); b.st[0] = nloc; b.st[1] = nx; }
        const unsigned old = xb_add(&bar[XB_XSUB(b.x)], 1u);
        const unsigned gen = old / nloc;
        if (old + 1u == (gen + 1u) * nloc) {
            __builtin_amdgcn_fence(__ATOMIC_RELEASE, "agent");
            asm volatile("s_waitcnt vmcnt(0)" ::: "memory");
            const unsigned og = xb_add(&bar[XB_TOP], 1u);
            const unsigned tg = og / nx;
            if (og + 1u == (tg + 1u) * nx) xb_add(&bar[XB_TOPGEN], 1u);
            else XB_SPIN(xb_ld(&bar[XB_TOPGEN]) == tg, bar);
            __builtin_amdgcn_fence(__ATOMIC_ACQUIRE, "agent");
            xb_add(&bar[XB_XGEN(b.x)], 1u);
            asm volatile("s_waitcnt vmcnt(0)" ::: "memory");
        } else {
            XB_SPIN(xb_ld(&bar[XB_XGEN(b.x)]) == gen, bar);
            __builtin_amdgcn_fence(__ATOMIC_ACQUIRE, "agent");
            asm volatile("s_waitcnt vmcnt(0)" ::: "memory");
        }
    }
    __syncthreads();
}

struct Frame {
    LAS unsigned char* lds;
    int tid, lane, wave, vcu, G;
    float* out; unsigned char* ws;
};
struct Args { const float* in[30]; float* out; unsigned char* ws; int ph_lo, ph_hi, li, pad; };
template <int CTRL> __device__ __forceinline__ float dpp_mov(float v) { return __builtin_bit_cast(float, __builtin_amdgcn_update_dpp(0, __builtin_bit_cast(int, v), CTRL, 0xf, 0xf, true)); }
__device__ __forceinline__ float sum8(float v) { v += dpp_mov<0xB1>(v); v += dpp_mov<0x4E>(v); v += dpp_mov<0x141>(v); return v; }
__device__ __forceinline__ float sum16(float v) { v = sum8(v); v += dpp_mov<0x140>(v); return v; }
__device__ __forceinline__ float wave_sum(float v) {
    v = sum16(v);
    const int iv = __builtin_bit_cast(int, v);
    return (__builtin_bit_cast(float, __builtin_amdgcn_readlane(iv, 0)) + __builtin_bit_cast(float, __builtin_amdgcn_readlane(iv, 16))) +
           (__builtin_bit_cast(float, __builtin_amdgcn_readlane(iv, 32)) + __builtin_bit_cast(float, __builtin_amdgcn_readlane(iv, 48)));
}

__device__ __forceinline__ float reduce8(const float (&a)[8], int lane) {
    const bool b0 = lane & 1, b1 = lane & 2, b2 = lane & 4;
    float b[4], c[2];
#pragma unroll
    for (int m = 0; m < 4; ++m) { const float keep = b0 ? a[2 * m + 1] : a[2 * m], send = b0 ? a[2 * m] : a[2 * m + 1]; b[m] = keep + dpp_mov<0xB1>(send); }
#pragma unroll
    for (int m = 0; m < 2; ++m) { const float keep = b1 ? b[2 * m + 1] : b[2 * m], send = b1 ? b[2 * m] : b[2 * m + 1]; c[m] = keep + dpp_mov<0x4E>(send); }
    float d;
    { const float keep = b2 ? c[1] : c[0], send = b2 ? c[0] : c[1]; d = keep + dpp_mov<0x124>(send); }
    d += dpp_mov<0x128>(d);
    { const unsigned u = __builtin_bit_cast(unsigned, d); const auto r = __builtin_amdgcn_permlane16_swap(u, u, false, false); d = __builtin_bit_cast(float, (unsigned)r[0]) + __builtin_bit_cast(float, (unsigned)r[1]); }
    { const unsigned u = __builtin_bit_cast(unsigned, d); const auto r = __builtin_amdgcn_permlane32_swap(u, u, false, false); d = __builtin_bit_cast(float, (unsigned)r[0]) + __builtin_bit_cast(float, (unsigned)r[1]); }
    return d;
}

__device__ __forceinline__ void tr_item(const float* W, int ldw, int k0, int srccol0, bf16* WT, int K, int dstrow0, LAS float* scr, int lane) {
    (void)scr;
    const int kr = lane >> 3, nq = lane & 7;
    const float* src = W + (size_t)(k0 + 8 * kr) * ldw + srccol0 + 4 * nq;
    f32x4 x[8];
#pragma unroll
    for (int b = 0; b < 8; ++b) x[b] = *(const GAS f32x4*)(src + (size_t)b * ldw);
    bf16* dst = WT + (size_t)(dstrow0 + 4 * nq) * K + k0 + 8 * kr;
#pragma unroll
    for (int q = 0; q < 4; ++q) { v4u o; o.x = pk2(x[0][q], x[1][q]); o.y = pk2(x[2][q], x[3][q]); o.z = pk2(x[4][q], x[5][q]); o.w = pk2(x[6][q], x[7][q]);
        *(GAS v4u*)(dst + (size_t)q * K) = o; }
}
__device__ __forceinline__ void tr_item_f8(const float* W, int ldw, int k0, int srccol0, unsigned char* WT, int K, int dstrow0, int lane, float sc) {
    const int kr = lane >> 3, nq = lane & 7;
    const float* src = W + (size_t)(k0 + 4 * kr) * ldw + srccol0 + 4 * nq;
    f32x4 x[4][4];
#pragma unroll
    for (int a = 0; a < 4; ++a)
#pragma unroll
        for (int b = 0; b < 4; ++b) x[a][b] = *(const GAS f32x4*)(src + (size_t)(32 * a + b) * ldw);
    unsigned char* dst = WT + (size_t)(dstrow0 + 4 * nq) * K + k0 + 4 * kr;
#pragma unroll
    for (int a = 0; a < 4; ++a)
#pragma unroll
        for (int q = 0; q < 4; ++q)
            *(GAS unsigned*)(dst + (size_t)q * K + 32 * a) = f8x4(x[a][0][q] * sc, x[a][1][q] * sc, x[a][2][q] * sc, x[a][3][q] * sc);
}
__device__ __forceinline__ void conv_mixer_item(Frame& F, const Args& A_, int l, unsigned char* dst, int r, LAS float* scr) {
    constexpr int I_IN = 16 * (NPROJ / 32), I_P = 8 * 32, I_O = 16 * 32;
    if (r < I_IN) { const int kb = r / (NPROJ / 32), nb = r % (NPROJ / 32); tr_item(A_.in[2] + (size_t)l * D * INC, INC, kb * 64, nb * 32 + (nb >= 104 ? 8 : 0), (bf16*)(dst + MW_IN), D, nb * 32, scr, F.lane); return; } r -= I_IN;
    if (r < I_P) { const int kb = r / 32, nb = r % 32; tr_item(A_.in[14] + (size_t)l * 512 * D, D, kb * 64, nb * 32, (bf16*)(dst + MW_PA), 512, nb * 32, scr, F.lane); return; } r -= I_P;
    if (r < I_P) { const int kb = r / 32, nb = r % 32; tr_item(A_.in[19] + (size_t)l * 512 * D, D, kb * 64, nb * 32, (bf16*)(dst + MW_PB), 512, nb * 32, scr, F.lane); return; } r -= I_P;
    { const int kb = r / 32, nb = r % 32; tr_item(A_.in[20] + (size_t)l * D * D, D, kb * 64, nb * 32, (bf16*)(dst + MW_OUT), D, nb * 32, scr, F.lane); }
}
constexpr int MIXER_ITEMS = 16 * (NPROJ / 32) + 2 * 8 * 32 + 16 * 32;
constexpr int FFN_ITEMS = 3 * 16 * (FF / 32);
__device__ __forceinline__ void conv_ffn_item(Frame& F, const float* wg, const float* wu, const float* wd, bf16* gu, bf16* dn, int r, LAS float* scr) {
    constexpr int I_G = 16 * (FF / 32);
    if (r < I_G) { const int kb = r / (FF / 32), nb = r % (FF / 32), n0 = nb * 32; tr_item(wg, FF, kb * 64, n0, gu, D, (n0 / 128) * 256 + (n0 % 128), scr, F.lane); return; } r -= I_G;
    if (r < I_G) { const int kb = r / (FF / 32), nb = r % (FF / 32), n0 = nb * 32; tr_item(wu, FF, kb * 64, n0, gu, D, (n0 / 128) * 256 + 128 + (n0 % 128), scr, F.lane); return; } r -= I_G;
    { const int kb = r / 32, nb = r % 32; tr_item(wd, D, kb * 64, nb * 32, dn, FF, nb * 32, scr, F.lane); }
}

constexpr int FFN_ITEMS8 = 3 * 8 * (FF / 32);
__device__ __forceinline__ void conv_ffn_item_f8(Frame& F, const float* wg, const float* wu, const float* wd, unsigned char* gu, unsigned char* dn, int r) {
    constexpr int I_G = 8 * (FF / 32);
    static_assert((FF / 128) * (D / 32) == I_G, "down items");
    if (r < I_G) { const int kb = r / (FF / 32), nb = r % (FF / 32), n0 = nb * 32; tr_item_f8(wg, FF, kb * 128, n0, gu, D, (n0 / 128) * 256 + (n0 % 128), F.lane, F8_SW); return; } r -= I_G;
    if (r < I_G) { const int kb = r / (FF / 32), nb = r % (FF / 32), n0 = nb * 32; tr_item_f8(wu, FF, kb * 128, n0, gu, D, (n0 / 128) * 256 + 128 + (n0 % 128), F.lane, F8_SW); return; } r -= I_G;
    { const int kb = r / 32, nb = r % 32; tr_item_f8(wd, D, kb * 128, nb * 32, dn, FF, nb * 32, F.lane, F8_SW); }
}

template <int MODE>
__device__ __forceinline__ void norm_phase(Frame& F, const float* xin, const float* gain, const float* w8src, int w8ld) {
    bf16* XN = (bf16*)(F.ws + WS_XN);
    f32x4 gv[4];
#pragma unroll
    for (int j = 0; j < 4; ++j) { gv[j] = *(const f32x4*)(gain + 4 * F.lane + 256 * j); if constexpr (MODE == 2) gv[j] = gv[j] * F8_SX; }
    float w8[4][4][8];
    if constexpr (MODE == 0 || MODE == 2) {
#pragma unroll
        for (int j = 0; j < 4; ++j)
#pragma unroll
            for (int q = 0; q < 4; ++q) { const float* s = w8src + (size_t)(4 * F.lane + 256 * j + q) * w8ld; const f32x4 a = *(const f32x4*)s, b = *(const f32x4*)(s + 4);
                w8[j][q][0] = a[0]; w8[j][q][1] = a[1]; w8[j][q][2] = a[2]; w8[j][q][3] = a[3]; w8[j][q][4] = b[0]; w8[j][q][5] = b[1]; w8[j][q][6] = b[2]; w8[j][q][7] = b[3]; }
    }
    LAS int* cnt = (LAS int*)(F.lds);
    for (int p = F.vcu; p < M / 256; p += F.G) {
        if constexpr (MODE == 2) { if (F.tid < 16) cnt[F.tid] = 0; __syncthreads(); }
        f32x4 nx[4][4];
#pragma unroll
        for (int r = 0; r < 4; ++r) { const GAS f32x4* xr = (const GAS f32x4*)(xin + (size_t)(p * 256 + r * 8 + F.wave) * D) + F.lane;
#pragma unroll
            for (int j = 0; j < 4; ++j) nx[r][j] = __builtin_nontemporal_load(&xr[64 * j]); }
#pragma unroll 4
        for (int i = 0; i < 32; ++i) {
            const int m = p * 256 + i * 8 + F.wave;
            f32x4 v[4]; float s = 0.f;
            if constexpr (MODE == 3) {
                const GAS v2u* tr = (const GAS v2u*)(XN + (size_t)m * D) + F.lane;
#pragma unroll
                for (int j = 0; j < 4; ++j) { const v2u t2 = __builtin_nontemporal_load(&tr[64 * j]); nx[i & 3][j] += (f32x4){bf_lo(t2.x), bf_hi(t2.x), bf_lo(t2.y), bf_hi(t2.y)}; } }
#pragma unroll
            for (int j = 0; j < 4; ++j) { v[j] = nx[i & 3][j]; s += (v[j].x * v[j].x + v[j].y * v[j].y) + (v[j].z * v[j].z + v[j].w * v[j].w); }
            if (i + 4 < 32) { const GAS f32x4* xr = (const GAS f32x4*)(xin + (size_t)(m + 32) * D) + F.lane;
#pragma unroll
                for (int j = 0; j < 4; ++j) nx[i & 3][j] = __builtin_nontemporal_load(&xr[64 * j]); }
            const float rstd = 1.0f / sqrtf(wave_sum(s) * (1.f / D) + 1e-6f);
#pragma unroll
            for (int j = 0; j < 4; ++j) v[j] = v[j] * rstd * gv[j];
            if constexpr (MODE == 3) { GAS f32x4* o = (GAS f32x4*)(F.out + (size_t)m * D) + F.lane;
#pragma unroll
                for (int j = 0; j < 4; ++j) __builtin_nontemporal_store(v[j], &o[64 * j]);
            } else if constexpr (MODE == 2) { GAS unsigned* o4 = (GAS unsigned*)((unsigned char*)XN + (size_t)m * D) + F.lane;
#pragma unroll
                for (int j = 0; j < 4; ++j) o4[64 * j] = f8x4(v[j].x, v[j].y, v[j].z, v[j].w);
            } else { GAS v2u* o8 = (GAS v2u*)(XN + (size_t)m * D) + F.lane;
#pragma unroll
                for (int j = 0; j < 4; ++j) { v2u w; w.x = pk2(v[j].x, v[j].y); w.y = pk2(v[j].z, v[j].w); o8[64 * j] = w; } }
            if constexpr (MODE == 0 || MODE == 2) {
                f32x2 pa2[4];
#pragma unroll
                for (int e2 = 0; e2 < 4; ++e2) pa2[e2] = (f32x2){0.f, 0.f};
#pragma unroll
                for (int j = 0; j < 4; ++j)
#pragma unroll
                    for (int q = 0; q < 4; ++q) { const float vv = v[j][q]; const f32x2 v2 = {vv, vv};
#pragma unroll
                        for (int e2 = 0; e2 < 4; ++e2) pa2[e2] += v2 * (f32x2){w8[j][q][2 * e2], w8[j][q][2 * e2 + 1]}; }
                const float pa[8] = {pa2[0][0], pa2[0][1], pa2[1][0], pa2[1][1], pa2[2][0], pa2[2][1], pa2[3][0], pa2[3][1]};
                const float tot = reduce8(pa, F.lane);
                if constexpr (MODE == 0) { if (F.lane < 8) ((float*)(F.ws + WS_AB))[(size_t)m * 8 + F.lane] = tot; }
                else {
                    float pr[8];
#pragma unroll
                    for (int e = 0; e < 8; ++e) pr[e] = __builtin_bit_cast(float, __builtin_amdgcn_readlane(__builtin_bit_cast(int, tot), e)) * (1.0f / F8_SX);
                    float b1 = pr[0]; int e1 = 0;
#pragma unroll
                    for (int e = 1; e < 8; ++e) if (pr[e] > b1) { b1 = pr[e]; e1 = e; }
                    float b2 = -3.0e38f; int e2 = 0;
#pragma unroll
                    for (int e = 0; e < 8; ++e) if (e != e1 && pr[e] > b2) { b2 = pr[e]; e2 = e; }
                    const float g1 = 1.0f / (1.0f + __expf(b2 - b1));
                    if (F.lane == 0) { ((int*)(F.ws + WS_RE))[m] = e1 | (e2 << 4); ((float*)(F.ws + WS_RG))[m] = g1; __hip_atomic_fetch_add(&cnt[e1], 1, __ATOMIC_RELAXED, __HIP_MEMORY_SCOPE_WORKGROUP); __hip_atomic_fetch_add(&cnt[8 + e2], 1, __ATOMIC_RELAXED, __HIP_MEMORY_SCOPE_WORKGROUP); }
                }
            }
        }
        if constexpr (MODE == 2) { __syncthreads(); if (F.tid < 16) ((int*)(F.ws + WS_WGCNT))[p * 16 + F.tid] = cnt[F.tid]; __syncthreads(); }
    }
}

__device__ __forceinline__ void route_scatter(Frame& F) {
    LAS int* sh = (LAS int*)F.lds;
    const int* wgcnt = (const int*)(F.ws + WS_WGCNT);
    int* list = (int*)(F.ws + WS_LIST); float* gatel = (float*)(F.ws + WS_GATEL); int* grp = (int*)(F.ws + WS_GRP);
    const int* re = (const int*)(F.ws + WS_RE); const float* rg = (const float*)(F.ws + WS_RG);
    for (int p = F.vcu; p < M / 256; p += F.G) {
        __syncthreads();
        { const int g = F.tid & 15, part = F.tid >> 4; int tot = 0, pre = 0;
#pragma unroll
          for (int j = 0; j < 8; ++j) { const int q = part * 8 + j; const int c = wgcnt[q * 16 + g]; pre += (q < p) ? c : 0; tot += c; }
          sh[128 + part * 16 + g] = tot; sh[128 + 512 + part * 16 + g] = pre; }
        __syncthreads();
        if (F.tid < 16) { int tot = 0, pre = 0; for (int q = 0; q < 32; ++q) { tot += sh[128 + q * 16 + F.tid]; pre += sh[128 + 512 + q * 16 + F.tid]; } sh[F.tid] = tot; sh[16 + F.tid] = pre; }
        __syncthreads();
        if (F.tid == 0) { int b = 0; for (int g = 0; g < 16; ++g) { sh[32 + g] = b; b += (sh[g] + 255) & ~255; } sh[48] = b; }
        __syncthreads();
        if (p == 0) {
            if (F.tid <= 16) grp[F.tid] = sh[32 + F.tid];
            if (F.tid < 16) grp[17 + F.tid] = sh[F.tid];
            for (int g = 0; g < 16; ++g) { const int lo = sh[32 + g] + sh[g], hi = sh[32 + g + 1]; for (int q = lo + F.tid; q < hi; q += NWAVES * 64) { list[q] = -1; gatel[q] = 0.f; } }
        }
        int e1 = 0, e2 = 0; float g1 = 0.f; int r1 = 0, r2 = 0;
        if (F.tid < 256) {
            const int m = p * 256 + F.tid; const int ee = re[m]; e1 = ee & 15; e2 = ee >> 4; g1 = rg[m];
#pragma unroll
            for (int e = 0; e < 8; ++e) {
                const unsigned long long m1 = __ballot(e1 == e), m2 = __ballot(e2 == e); const unsigned long long lt = (1ull << F.lane) - 1ull;
                if (e1 == e) r1 = __popcll(m1 & lt); if (e2 == e) r2 = __popcll(m2 & lt);
                if (F.lane == 0) { sh[64 + F.wave * 16 + e] = __popcll(m1); sh[64 + F.wave * 16 + 8 + e] = __popcll(m2); }
            }
        }
        __syncthreads();
        if (F.tid < 256) {
            const int m = p * 256 + F.tid; int o1 = sh[32 + e1] + sh[16 + e1] + r1, o2 = sh[32 + 8 + e2] + sh[16 + 8 + e2] + r2;
            for (int w = 0; w < F.wave; ++w) { o1 += sh[64 + w * 16 + e1]; o2 += sh[64 + w * 16 + 8 + e2]; }
            list[o1] = m; gatel[o1] = g1; list[o2] = m; gatel[o2] = 1.0f - g1;
        }
    }
}

constexpr int CH = 16, NCH = T / CH;
constexpr int RW_BYTES = 60736;
static_assert(2 * RW_BYTES <= RING_BYTES, "rwkv lds");
constexpr int XA_PITCH = 528;

typedef short bf16x4 __attribute__((ext_vector_type(4)));
#define MFMA32(a, b, c) __builtin_amdgcn_mfma_f32_16x16x32_bf16(a, b, c, 0, 0, 0)
#define MFMA16(a, b, c) __builtin_amdgcn_mfma_f32_16x16x16bf16_1k(a, b, c, 0, 0, 0)
__device__ __forceinline__ unsigned cvt2(float a, float b) { const f32x2 v = {a, b}; const bf16v2_t r = __builtin_convertvector(v, bf16v2_t); return __builtin_bit_cast(unsigned, r); }
__device__ __forceinline__ bf16x4 pack4(float a, float b, float c, float d) { v2u w; w.x = cvt2(a, b); w.y = cvt2(c, d); return __builtin_bit_cast(bf16x4, w); }
__device__ __forceinline__ bf16x8 pack8(const f32x4 a, const f32x4 b) { v4u w; w.x = cvt2(a[0], a[1]); w.y = cvt2(a[2], a[3]); w.z = cvt2(b[0], b[1]); w.w = cvt2(b[2], b[3]); return __builtin_bit_cast(bf16x8, w); }
#define WAVE_LDS_FENCE() asm volatile("s_waitcnt lgkmcnt(0)" ::: "memory")
constexpr int G2_KI = 0, G2_QI = 17408, G2_KT = 34816, G2_VT = 53248, G2_GR = 71680, G2_BE = 71936, G2_GC = 72192, G2_NM = 72448, G2_TI = 76544, G2_O = 79104, G2_CW = G2_O + 64 * 528, G2_BYTES = G2_CW + 4 * 384 * 4;
constexpr int G2_IP = 272, G2_TP = 144, G2_TIP = 40, G2_OP = 132;
static_assert(G2_BYTES <= RING_BYTES, "gdn lds");
constexpr int GB = 64, NGB = T / GB;

__device__ __forceinline__ void gdn_unit2(Frame& F, const Args& A_, int layer, int u) {
    const int b = u >> 2, h = u & 3, tid = F.tid, lane = F.lane, w = F.wave, c = lane & 15, g = lane >> 4;
    LAS unsigned char* L = F.lds;
    LAS float* GR = (LAS float*)(L + G2_GR); LAS float* BE = (LAS float*)(L + G2_BE); LAS float* GC = (LAS float*)(L + G2_GC); LAS float* NM = (LAS float*)(L + G2_NM); LAS float* Om = (LAS float*)(L + G2_O);
    const bf16* PROJ = (const bf16*)(F.ws + WS_PROJ);
    bf16* OUT = (bf16*)(F.ws + WS_XN);
    const float* AB = (const float*)(F.ws + WS_AB);
    const int part = g, cg = c;
    const int colbase = (part == 0 ? C_GQ : (part == 1 ? C_GK : C_GV)) + h * 128 + 8 * cg;
    LAS float* CW = (LAS float*)(L + G2_CW);
    for (int idx = tid; idx < 4 * 384; idx += NWAVES * 64) { const int j = idx / 384, cc = idx % 384; CW[idx] = A_.in[15][(size_t)layer * 4 * 1536 + j * 1536 + (cc >> 7) * 512 + h * 128 + (cc & 127)]; }
    const int cwoff = (part < 3 ? part : 0) * 128 + 8 * cg;
    __syncthreads();
    const float nexpa = -__expf(A_.in[16][layer * 4 + h]), dtb = A_.in[17][layer * 4 + h];
    const int d0 = (8 * cg) & 31, pc0 = (8 * cg & ~31) + 8 * ((d0 >> 2) & 3) + 4 * (d0 >> 4);
    const int ptok = tid >> 3, pch = (tid & 7) * 16;
    f32x4 S[8];
#pragma unroll
    for (int m = 0; m < 8; ++m) S[m] = (f32x4){0.f, 0.f, 0.f, 0.f};
    v4u pre[11]; v4u zpre[2]; float abpre[2];
    auto prefetch = [&](int bt) {
        const int tb = bt * GB;
#pragma unroll
        for (int i = 0; i < 11; ++i) { const int tok = tb + 8 * w - 3 + i; pre[i] = (v4u){0u, 0u, 0u, 0u};
            if (part < 3 && tok >= 0) pre[i] = *(const GAS v4u*)(PROJ + (size_t)(b * T + tok) * NPROJ + colbase); }
        abpre[0] = 0.f; abpre[1] = 0.f;
        if (part == 3 && cg < 8) { const float* ab = AB + (size_t)(b * T + tb + 8 * w + cg) * 8; abpre[0] = ab[h]; abpre[1] = ab[4 + h]; }
    };
    prefetch(0);
    for (int bt = 0; bt < NGB; ++bt) {
        const int tb = bt * GB;
        if (!(PADF & 4)) {
            unsigned ktp[8][4];
            float xr[4][8];
#pragma unroll
            for (int i = 0; i < 3; ++i) { xr[i][0] = bf_lo(pre[i].x); xr[i][1] = bf_hi(pre[i].x); xr[i][2] = bf_lo(pre[i].y); xr[i][3] = bf_hi(pre[i].y); xr[i][4] = bf_lo(pre[i].z); xr[i][5] = bf_hi(pre[i].z); xr[i][6] = bf_lo(pre[i].w); xr[i][7] = bf_hi(pre[i].w); }
            float yprev[8];
#pragma unroll
            for (int tk = 0; tk < 8; ++tk) {
                const v4u pw = pre[tk + 3];
                xr[3][0] = bf_lo(pw.x); xr[3][1] = bf_hi(pw.x); xr[3][2] = bf_lo(pw.y); xr[3][3] = bf_hi(pw.y); xr[3][4] = bf_lo(pw.z); xr[3][5] = bf_hi(pw.z); xr[3][6] = bf_lo(pw.w); xr[3][7] = bf_hi(pw.w);
                float y[8]; float ss = 0.f;
#pragma unroll
                for (int e = 0; e < 8; ++e) y[e] = 0.f;
#pragma unroll
                for (int j = 0; j < 4; ++j) { const f32x4 wa = *(const LAS f32x4*)(CW + j * 384 + cwoff), wb = *(const LAS f32x4*)(CW + j * 384 + cwoff + 4);
#pragma unroll
                    for (int e = 0; e < 4; ++e) { y[e] += wa[e] * xr[j][e]; y[4 + e] += wb[e] * xr[j][4 + e]; } }
#pragma unroll
                for (int e = 0; e < 8; ++e) { const float a = y[e]; y[e] = a * sigmoidf_(a); ss += y[e] * y[e]; }
                ss = sum16(ss);
                const float sc = part == 2 ? 1.0f : (__builtin_amdgcn_rsqf(ss + 1e-6f)) * (part == 0 ? 0.08838834764831845f : 1.0f);
#pragma unroll
                for (int e = 0; e < 8; ++e) y[e] *= sc;
                const int trow = 8 * w + tk;
                if (part < 2) { LAS unsigned char* img = L + (part == 0 ? G2_QI : G2_KI) + trow * G2_IP;
                    v2u a0; a0.x = pg8::cvt_pk_bf16(y[0], y[1]); a0.y = pg8::cvt_pk_bf16(y[2], y[3]); v2u a1; a1.x = pg8::cvt_pk_bf16(y[4], y[5]); a1.y = pg8::cvt_pk_bf16(y[6], y[7]);
                    *(LAS v2u*)(img + pc0 * 2) = a0; *(LAS v2u*)(img + (pc0 + 8) * 2) = a1; }
                if (tk & 1) {
#pragma unroll
                    for (int e = 0; e < 8; ++e) ktp[e][tk >> 1] = pg8::cvt_pk_bf16(yprev[e], y[e]); }
#pragma unroll
                for (int e = 0; e < 8; ++e) yprev[e] = y[e];
#pragma unroll
                for (int e = 0; e < 8; ++e) { xr[0][e] = xr[1][e]; xr[1][e] = xr[2][e]; xr[2][e] = xr[3][e]; }
            }
            if (part == 1 || part == 2) { LAS unsigned char* timg = L + (part == 1 ? G2_KT : G2_VT);
#pragma unroll
                for (int e = 0; e < 8; ++e) { v4u o; o.x = ktp[e][0]; o.y = ktp[e][1]; o.z = ktp[e][2]; o.w = ktp[e][3]; *(LAS v4u*)(timg + (8 * cg + e) * G2_TP + (8 * w) * 2) = o; } }
            if (part == 3 && cg < 8) { GR[8 * w + cg] = nexpa * softplusf_(abpre[0] + dtb); BE[8 * w + cg] = sigmoidf_(abpre[1]); }
        }
        __syncthreads();
        if (bt + 1 < NGB) prefetch(bt + 1);
        { const bf16* zp = PROJ + (size_t)(b * T + tb + ptok) * NPROJ + C_Z + h * 128 + pch; zpre[0] = *(const GAS v4u*)zp; zpre[1] = *(const GAS v4u*)(zp + 8); }
        if (w < 4 && !(PADF & 8)) {
            const int i = w;
            float gv = GR[16 * i + c];
#pragma unroll
            for (int o = 1; o < 16; o <<= 1) { const float t_ = __shfl_up(gv, o, 16); if (c >= o) gv += t_; }
            if (g == 0) GC[16 * i + c] = gv;
            f32x4 acc = (f32x4){0.f, 0.f, 0.f, 0.f};
            const LAS unsigned char* rowK = L + G2_KI + (16 * i + c) * G2_IP + g * 16;
#pragma unroll
            for (int s = 0; s < 4; ++s) { const bf16x8 f = *(const LAS bf16x8*)(rowK + 64 * s); acc = MFMA32(f, f, acc); }
            WAVE_LDS_FENCE();
            const f32x4 gct = *(const LAS f32x4*)(GC + 16 * i + 4 * g), bet = *(const LAS f32x4*)(BE + 16 * i + 4 * g);
#pragma unroll
            for (int r = 0; r < 4; ++r) { const int t_ = 4 * g + r; NM[i * 256 + t_ * 16 + c] = (c < t_) ? -bet[r] * acc[r] * __expf(fminf(gct[r] - gv, 0.f)) : 0.f; }
            WAVE_LDS_FENCE();
            float Tc[16];
#pragma unroll
            for (int t_ = 0; t_ < 16; ++t_) { float a = (t_ == c) ? 1.f : 0.f;
#pragma unroll
                for (int q4 = 0; q4 * 4 < t_; ++q4) { const f32x4 n4 = *(const LAS f32x4*)(NM + i * 256 + t_ * 16 + 4 * q4);
#pragma unroll
                    for (int e = 0; e < 4; ++e) if (4 * q4 + e < t_) a += n4[e] * Tc[4 * q4 + e]; }
                Tc[t_] = a; }
            if (g == 0) {
#pragma unroll
                for (int t_ = 0; t_ < 16; ++t_) *(LAS bf16*)(L + G2_TI + i * (16 * G2_TIP) + t_ * G2_TIP + c * 2) = (bf16)f2bf(Tc[t_]); }
        }
        __syncthreads();
#pragma unroll 1
        for (int i = (PADF & 16) ? 4 : 0; i < 4; ++i) {
            const LAS unsigned char* rowK = L + G2_KI + (16 * i + c) * G2_IP + g * 16; const LAS unsigned char* rowQ = L + G2_QI + (16 * i + c) * G2_IP + g * 16;
            bf16x8 kf[4], qf[4];
#pragma unroll
            for (int s = 0; s < 4; ++s) { kf[s] = *(const LAS bf16x8*)(rowK + 64 * s); qf[s] = *(const LAS bf16x8*)(rowQ + 64 * s); }
            const float gcc = GC[16 * i + c], gl = GC[16 * i + 15];
            const f32x4 gcr = *(const LAS f32x4*)(GC + 16 * i + 4 * g), ber = *(const LAS f32x4*)(BE + 16 * i + 4 * g);
            const v2u vw = *(const LAS v2u*)(L + G2_VT + (16 * w + c) * G2_TP + (16 * i + 4 * g) * 2);
            const bf16x4 tf = *(const LAS bf16x4*)(L + G2_TI + i * (16 * G2_TIP) + c * G2_TIP + g * 8);
            f32x4 dq = (f32x4){0.f, 0.f, 0.f, 0.f};
#pragma unroll
            for (int s = 0; s < 4; ++s) dq = MFMA32(kf[s], qf[s], dq);
            bf16x8 Sb[4];
#pragma unroll
            for (int s = 0; s < 4; ++s) Sb[s] = pack8(S[2 * s], S[2 * s + 1]);
            f32x4 y = (f32x4){0.f, 0.f, 0.f, 0.f}, qs = y;
#pragma unroll
            for (int s = 0; s < 4; ++s) y = MFMA32(kf[s], Sb[s], y);
#pragma unroll
            for (int s = 0; s < 4; ++s) qs = MFMA32(qf[s], Sb[s], qs);
            float qa[4], egr[4], xv[4];
            const float vv[4] = {bf_lo(vw.x), bf_hi(vw.x), bf_lo(vw.y), bf_hi(vw.y)};
#pragma unroll
            for (int r = 0; r < 4; ++r) { qa[r] = (4 * g + r <= c) ? dq[r] * __expf(fminf(gcc - gcr[r], 0.f)) : 0.f; egr[r] = __expf(gcr[r]); xv[r] = ber[r] * (vv[r] - egr[r] * y[r]); qs[r] *= egr[r]; }
            const f32x4 vn = MFMA16(tf, pack4(xv[0], xv[1], xv[2], xv[3]), ((f32x4){0.f, 0.f, 0.f, 0.f}));
            const f32x4 o = MFMA16(pack4(qa[0], qa[1], qa[2], qa[3]), pack4(vn[0], vn[1], vn[2], vn[3]), qs);
#pragma unroll
            for (int r = 0; r < 4; ++r) Om[(16 * i + 4 * g + r) * G2_OP + 16 * w + c] = o[r];
            const float egl = __expf(gl);
            const bf16x4 vsb = pack4(vn[0] * __expf(gl - gcr[0]), vn[1] * __expf(gl - gcr[1]), vn[2] * __expf(gl - gcr[2]), vn[3] * __expf(gl - gcr[3]));
#pragma unroll
            for (int m = 0; m < 8; ++m) { const bf16x4 kt = *(const LAS bf16x4*)(L + G2_KT + (16 * m + c) * G2_TP + (16 * i + 4 * g) * 2); S[m] = MFMA16(kt, vsb, S[m] * egl); }
        }
        __syncthreads();
        if (!(PADF & 32)) {
            f32x4 o4[4]; float ss = 0.f;
#pragma unroll
            for (int q = 0; q < 4; ++q) { o4[q] = *(const LAS f32x4*)(Om + ptok * G2_OP + pch + 4 * q); ss += (o4[q][0] * o4[q][0] + o4[q][1] * o4[q][1]) + (o4[q][2] * o4[q][2] + o4[q][3] * o4[q][3]); }
            ss = sum8(ss);
            const float rs = __builtin_amdgcn_rsqf(ss * (1.f / 128.f) + 1e-6f);
            const float* gp = A_.in[18] + layer * 128 + pch;
            const unsigned zz[8] = {zpre[0].x, zpre[0].y, zpre[0].z, zpre[0].w, zpre[1].x, zpre[1].y, zpre[1].z, zpre[1].w};
            unsigned ow[8];
#pragma unroll
            for (int q = 0; q < 4; ++q) { const f32x4 gq = *(const f32x4*)(gp + 4 * q);
                const float za = bf_lo(zz[2 * q]), zb = bf_hi(zz[2 * q]), zc = bf_lo(zz[2 * q + 1]), zd = bf_hi(zz[2 * q + 1]);
                ow[2 * q] = pk2(o4[q][0] * rs * gq[0] * za * sigmoidf_(za), o4[q][1] * rs * gq[1] * zb * sigmoidf_(zb));
                ow[2 * q + 1] = pk2(o4[q][2] * rs * gq[2] * zc * sigmoidf_(zc), o4[q][3] * rs * gq[3] * zd * sigmoidf_(zd)); }
            bf16* op = OUT + (size_t)(b * T + tb + ptok) * D + 512 + h * 128 + pch;
            *(GAS v4u*)op = (v4u){ow[0], ow[1], ow[2], ow[3]}; *(GAS v4u*)(op + 8) = (v4u){ow[4], ow[5], ow[6], ow[7]};
        }
    }
    __syncthreads();
}

constexpr int R2_AI = 0, R2_BI = 2304, R2_KI = 4608, R2_RI = 6912, R2_VI = 9216, R2_W15 = 16896;
constexpr int R2_IP = 144, R2_TP = 40;
constexpr int R3_XA = 0, R3_R = 8448, R3_KM = 12544, R3_V = 16640, R3_LW = 20736, R3_AV = 24832, R3_G = 28928, R3_O = 33024, R3_BON = 37120, R3_MU = 37184, R3_IMG = 38976;
static_assert(R3_IMG + R2_W15 + 256 <= RW_BYTES && R3_R + 32768 <= RW_BYTES, "rwkv lds map");
__device__ __forceinline__ float fast_tanh(float x) { const float e = __expf(2.0f * x); return 1.0f - 2.0f * __builtin_amdgcn_rcpf(e + 1.0f); }
__device__ __forceinline__ float fast_softplus(float x) { return x > 20.f ? x : __logf(1.0f + __expf(x)); }
__device__ __forceinline__ bf16x4 pack4v(const f32x4 v) { return pack4(v[0], v[1], v[2], v[3]); }

__device__ __forceinline__ void rwkv_pair2(Frame& F, const Args& A_, int layer, int pairidx) {
    const int half = F.wave >> 2, wq = F.wave & 3, ht = F.tid & 255, lane = F.lane, c = lane & 15, g = lane >> 4;
    const int h = 2 * (pairidx & 3) + half, b = pairidx >> 2;
    LAS unsigned char* L = F.lds + half * RW_BYTES;
    LAS float* Rm = (LAS float*)(L + R3_R); LAS float* KM = (LAS float*)(L + R3_KM); LAS float* Vm = (LAS float*)(L + R3_V); LAS float* LW = (LAS float*)(L + R3_LW);
    LAS float* AV = (LAS float*)(L + R3_AV); LAS float* Gm = (LAS float*)(L + R3_G);
    LAS float* Om = (LAS float*)(L + R3_O); LAS float* BON = (LAS float*)(L + R3_BON); LAS float* MU = (LAS float*)(L + R3_MU);
    LAS unsigned char* IM = L + R3_IMG;
    const bf16* PROJ = (const bf16*)(F.ws + WS_PROJ);
    bf16* OUT = (bf16*)(F.ws + WS_XN);
    const int jc = 16 * wq + c, kg = g, hj = h * 64 + jc;
    bf16x8 bd[2], bi[2], bg[4];
    {
        const float* Wd = A_.in[5] + (size_t)layer * 64 * 512 + h * 64; const float* Wi = A_.in[7] + (size_t)layer * 64 * 512 + h * 64; const float* Wg = A_.in[8] + (size_t)layer * 128 * 512 + h * 64;
        LAS bf16* WT = (LAS bf16*)(L + R3_R);
#pragma unroll 1
        for (int idx = ht; idx < 4096; idx += 256) { const int k = idx >> 6, j = idx & 63; WT[j * 64 + k] = (bf16)f2bf(Wd[(size_t)k * 512 + j]); WT[4096 + j * 64 + k] = (bf16)f2bf(Wi[(size_t)k * 512 + j]); }
#pragma unroll 1
        for (int idx = ht; idx < 8192; idx += 256) { const int k = idx >> 6, j = idx & 63; WT[8192 + j * 128 + k] = (bf16)f2bf(Wg[(size_t)k * 512 + j]); }
        __syncthreads();
#pragma unroll
        for (int s = 0; s < 2; ++s) { bd[s] = *(const LAS bf16x8*)(WT + jc * 64 + 32 * s + 8 * kg); bi[s] = *(const LAS bf16x8*)(WT + 4096 + jc * 64 + 32 * s + 8 * kg); }
#pragma unroll
        for (int s = 0; s < 4; ++s) bg[s] = *(const LAS bf16x8*)(WT + 8192 + jc * 128 + 32 * s + 8 * kg);
        __syncthreads();
    }
    const float w0c = A_.in[4][layer * 512 + hj], a0c = A_.in[6][layer * 512 + hj];
    const int tid = F.tid;
    const int atok = tid >> 5, apc = tid & 31;
    int bun[2], btok[2], bpc[2]; bool bval[2];
#pragma unroll
    for (int j = 0; j < 2; ++j) { const int idx = tid + 512 * j; bval[j] = idx < 768; const int ii = bval[j] ? idx : 0; bun[j] = ii / 384; const int rem = ii - 384 * bun[j]; btok[j] = rem / 24; bpc[j] = rem - 24 * btok[j]; }
    f32x4 amu[2], bmu[2][2];
    { const float* mup = A_.in[3] + layer * 1792;
      amu[0] = *(const f32x4*)(mup + C_WL + 8 * apc); amu[1] = *(const f32x4*)(mup + C_WL + 8 * apc + 4);
#pragma unroll
      for (int j = 0; j < 2; ++j) { const int hh = 2 * (pairidx & 3) + bun[j]; const int col = (bpc[j] < 8 ? C_R : (bpc[j] < 16 ? C_K : C_V)) + hh * 64 + 8 * (bpc[j] & 7);
          bmu[j][0] = *(const f32x4*)(mup + col); bmu[j][1] = *(const f32x4*)(mup + col + 4); } }
    const bool a_th = apc < 8, a_id = apc >= 8 && apc < 16;
    constexpr size_t CHB = (size_t)CH * NPROJ * 2;
    const size_t aoff = ((size_t)(b * T + atok) * NPROJ + C_WL + 8 * apc) * 2;
    size_t boff[2]; unsigned bdst[2];
#pragma unroll
    for (int j = 0; j < 2; ++j) { const int hh = 2 * (pairidx & 3) + bun[j]; const int col = (bpc[j] < 8 ? C_R : (bpc[j] < 16 ? C_K : C_V)) + hh * 64 + 8 * (bpc[j] & 7);
        boff[j] = ((size_t)(b * T + btok[j]) * NPROJ + col) * 2;
        bdst[j] = (unsigned)(bun[j] * RW_BYTES + (bpc[j] < 8 ? R3_R : (bpc[j] < 16 ? R3_KM : R3_V)) + (btok[j] * 64 + 8 * (bpc[j] & 7)) * 4); }
    const unsigned adst = (unsigned)(R3_XA + atok * XA_PITCH + apc * 16);
    const int tt = ht >> 4, jq = (ht & 15) * 4;
    const f32x4 kkv = *(const f32x4*)(A_.in[9] + layer * 512 + h * 64 + jq), kav = *(const f32x4*)(A_.in[10] + layer * 512 + h * 64 + jq), rkv = *(const f32x4*)(A_.in[11] + layer * 512 + h * 64 + jq);
    const f32x4 lgv = *(const f32x4*)(A_.in[12] + layer * 512 + h * 64 + jq), lbv = *(const f32x4*)(A_.in[13] + layer * 512 + h * 64 + jq);
    const int pimg = (jq & ~31) + 8 * (((jq & 31) >> 2) & 3) + 4 * ((jq & 31) >> 4);
    bf16x4 ltri;
#pragma unroll
    for (int j = 0; j < 4; ++j) ltri[j] = (4 * g + j <= c) ? (short)0x3F80 : (short)0;
    f32x4 P[4];
#pragma unroll
    for (int m = 0; m < 4; ++m) P[m] = (f32x4){0.f, 0.f, 0.f, 0.f};
    struct PF { v4u acur, aprv, bcur[2], bprv[2]; };
    PF pf0, pf1;
    auto prefetch = [&](int ch, PF& q_) {
        const char* base = (const char*)PROJ + (size_t)ch * CHB;
        { const bool first = (ch == 0 && atok == 0); const char* p = base + aoff; q_.acur = *(const GAS v4u*)p; q_.aprv = *(const GAS v4u*)(first ? p : p - NPROJ * 2); }
#pragma unroll
        for (int j = 0; j < 2; ++j) { const bool first = (ch == 0 && btok[j] == 0); const char* p = base + boff[j]; q_.bcur[j] = *(const GAS v4u*)p; q_.bprv[j] = *(const GAS v4u*)(first ? p : p - NPROJ * 2); }
    };
    prefetch(0, pf0); prefetch(1, pf1);
    auto do_chunk = [&](const int ch, PF& q_) __attribute__((always_inline)) {
        const int t0 = ch * CH;
        v4u acur = q_.acur, aprv = q_.aprv, bcur[2] = {q_.bcur[0], q_.bcur[1]}, bprv[2] = {q_.bprv[0], q_.bprv[1]};
        if (ch == 0) {
            if (atok == 0) aprv = (v4u){0u, 0u, 0u, 0u};
#pragma unroll
            for (int j = 0; j < 2; ++j) if (btok[j] == 0) bprv[j] = (v4u){0u, 0u, 0u, 0u};
        }
        if (!(PADF & 64)) {
#define RW_UNPACK(W_, X_) const float X_[8] = {bf_lo((W_)[0]), bf_hi((W_)[0]), bf_lo((W_)[1]), bf_hi((W_)[1]), bf_lo((W_)[2]), bf_hi((W_)[2]), bf_lo((W_)[3]), bf_hi((W_)[3])}
            { RW_UNPACK(acur, xc); RW_UNPACK(aprv, xp);
              const float be = a_th ? 2.f : 1.f, ga = a_th ? -1.f : 0.f;
              float y[8];
#pragma unroll
              for (int e = 0; e < 8; ++e) { const float val = xc[e] + (xp[e] - xc[e]) * (e < 4 ? amu[0][e] : amu[1][e - 4]); const float sg = __builtin_amdgcn_rcpf(1.0f + __expf(-be * val)); y[e] = a_id ? val : be * sg + ga; }
              v4u o; o.x = pk2(y[0], y[1]); o.y = pk2(y[2], y[3]); o.z = pk2(y[4], y[5]); o.w = pk2(y[6], y[7]);
              *(LAS v4u*)(F.lds + adst) = o; }
#pragma unroll
            for (int j = 0; j < 2; ++j) if (bval[j]) { RW_UNPACK(bcur[j], xc); RW_UNPACK(bprv[j], xp);
                float val[8];
#pragma unroll
                for (int e = 0; e < 8; ++e) val[e] = xc[e] + (xp[e] - xc[e]) * (e < 4 ? bmu[j][0][e] : bmu[j][1][e - 4]);
                LAS float* dst = (LAS float*)(F.lds + bdst[j]);
                *(LAS f32x4*)dst = (f32x4){val[0], val[1], val[2], val[3]}; *(LAS f32x4*)(dst + 4) = (f32x4){val[4], val[5], val[6], val[7]}; }
#undef RW_UNPACK
        }
        if (ch + 2 < NCH) prefetch(ch + 2, q_);
        __syncthreads();
        if (!(PADF & 128)) {
            f32x4 ad = (f32x4){0.f, 0.f, 0.f, 0.f}, aa = ad, ag = ad;
            const LAS unsigned char* xa = F.lds + R3_XA + c * XA_PITCH + kg * 16;
#pragma unroll
            for (int s = 0; s < 2; ++s) ad = MFMA32(*(const LAS bf16x8*)(xa + s * 64), bd[s], ad);
#pragma unroll
            for (int s = 0; s < 2; ++s) aa = MFMA32(*(const LAS bf16x8*)(xa + 128 + s * 64), bi[s], aa);
#pragma unroll
            for (int s = 0; s < 4; ++s) ag = MFMA32(*(const LAS bf16x8*)(xa + 256 + s * 64), bg[s], ag);
            f32x4 lwv;
#pragma unroll
            for (int r = 0; r < 4; ++r) { const int t = 4 * kg + r;
                lwv[r] = -0.60653065971f * sigmoidf_(w0c + ad[r]);
                AV[t * 64 + jc] = sigmoidf_(a0c + aa[r]); Gm[t * 64 + jc] = ag[r]; }
            { const bf16x4 hi = pack4v(lwv); const v2u hw = __builtin_bit_cast(v2u, hi);
              const f32x4 lo = lwv - (f32x4){bf_lo(hw.x), bf_hi(hw.x), bf_lo(hw.y), bf_hi(hw.y)};
              f32x4 cs = MFMA16(ltri, hi, ((f32x4){0.f, 0.f, 0.f, 0.f})); cs = MFMA16(ltri, pack4v(lo), cs);
#pragma unroll
              for (int r = 0; r < 4; ++r) LW[(4 * kg + r) * 64 + jc] = cs[r]; }
        }
        __syncthreads();
        if (!(PADF & 256)) {
            const f32x4 k4 = *(const LAS f32x4*)(KM + tt * 64 + jq), a4 = *(const LAS f32x4*)(AV + tt * 64 + jq), r4 = *(const LAS f32x4*)(Rm + tt * 64 + jq), v4 = *(const LAS f32x4*)(Vm + tt * 64 + jq);
            const f32x4 cl = *(const LAS f32x4*)(LW + tt * 64 + jq);
            f32x4 clp = *(const LAS f32x4*)(LW + (tt > 0 ? tt - 1 : 0) * 64 + jq); if (tt == 0) clp = (f32x4){0.f, 0.f, 0.f, 0.f};
            const f32x4 kr = k4 * kkv; float ss = (kr[0] * kr[0] + kr[1] * kr[1]) + (kr[2] * kr[2] + kr[3] * kr[3]);
            ss = sum16(ss);
            const float inv = __builtin_amdgcn_rsqf(ss + 1e-6f);
            const f32x4 kk = kr * inv; const f32x4 km = k4 * (1.0f + (a4 - 1.0f) * kav);
            float bo = (r4[0] * km[0] * rkv[0] + r4[1] * km[1] * rkv[1]) + (r4[2] * km[2] * rkv[2] + r4[3] * km[3] * rkv[3]);
            bo = sum16(bo);
            if ((ht & 15) == 0) BON[tt] = bo;
            f32x4 wt, wi, wp;
#pragma unroll
            for (int e = 0; e < 4; ++e) { wt[e] = __expf(cl[e]); wi[e] = __expf(-cl[e]); wp[e] = __expf(clp[e]); }
            const f32x4 at = -kk * wp, bt = kk * a4 * wi, kt = km * wi, rt = r4 * wt;
            LAS unsigned char* irow = IM + tt * R2_IP + pimg * 2;
            { v2u w; w.x = pk2(at[0], at[1]); w.y = pk2(at[2], at[3]); *(LAS v2u*)(irow + R2_AI) = w; }
            { v2u w; w.x = pk2(bt[0], bt[1]); w.y = pk2(bt[2], bt[3]); *(LAS v2u*)(irow + R2_BI) = w; }
            { v2u w; w.x = pk2(kt[0], kt[1]); w.y = pk2(kt[2], kt[3]); *(LAS v2u*)(irow + R2_KI) = w; }
            { v2u w; w.x = pk2(rt[0], rt[1]); w.y = pk2(rt[2], rt[3]); *(LAS v2u*)(irow + R2_RI) = w; }
            { v2u w; w.x = pk2(v4[0], v4[1]); w.y = pk2(v4[2], v4[3]); *(LAS v2u*)(IM + R2_VI + tt * R2_IP + jq * 2) = w; }
            if (tt == 15) *(LAS f32x4*)(IM + R2_W15 + jq * 4) = wt;
        }
        __syncthreads();
        if (!(PADF & 512)) {
            bf16x8 af[2], bf_[2], kf[2], rf[2];
#pragma unroll
            for (int s = 0; s < 2; ++s) { const LAS unsigned char* p = IM + c * R2_IP + 64 * s + 16 * g;
                af[s] = *(const LAS bf16x8*)(p + R2_AI); bf_[s] = *(const LAS bf16x8*)(p + R2_BI); kf[s] = *(const LAS bf16x8*)(p + R2_KI); rf[s] = *(const LAS bf16x8*)(p + R2_RI); }
            const unsigned trb = (unsigned)(size_t)IM + (unsigned)((4 * g + ((lane >> 2) & 3)) * R2_IP + 16 * (lane & 3));
            const unsigned trv = (unsigned)(size_t)IM + (unsigned)(R2_VI + (4 * g + ((lane >> 2) & 3)) * R2_IP + 8 * (lane & 3) + 32 * wq);
            bf16x4 vt, btm[4], ktm[4];
            asm volatile("ds_read_b64_tr_b16 %0, %9\n\tds_read_b64_tr_b16 %1, %10 offset:%11\n\tds_read_b64_tr_b16 %2, %10 offset:%12\n\tds_read_b64_tr_b16 %3, %10 offset:%13\n\tds_read_b64_tr_b16 %4, %10 offset:%14\n\t"
                         "ds_read_b64_tr_b16 %5, %10 offset:%15\n\tds_read_b64_tr_b16 %6, %10 offset:%16\n\tds_read_b64_tr_b16 %7, %10 offset:%17\n\tds_read_b64_tr_b16 %8, %10 offset:%18\n\ts_waitcnt lgkmcnt(0)"
                         : "=&v"(vt), "=&v"(btm[0]), "=&v"(btm[1]), "=&v"(btm[2]), "=&v"(btm[3]), "=&v"(ktm[0]), "=&v"(ktm[1]), "=&v"(ktm[2]), "=&v"(ktm[3])
                         : "v"(trv), "v"(trb), "i"(R2_BI + 0), "i"(R2_BI + 8), "i"(R2_BI + 64), "i"(R2_BI + 72), "i"(R2_KI + 0), "i"(R2_KI + 8), "i"(R2_KI + 64), "i"(R2_KI + 72) : "memory");
            __builtin_amdgcn_sched_barrier(0);
            const f32x4 zero = (f32x4){0.f, 0.f, 0.f, 0.f};
            f32x4 X0 = zero, Y0 = zero, Dka = zero, Dbr = zero, Dkr = zero;
#pragma unroll
            for (int s = 0; s < 2; ++s) { X0 = MFMA32(af[s], bf_[s], X0); Y0 = MFMA32(bf_[s], af[s], Y0); Dka = MFMA32(kf[s], af[s], Dka); Dbr = MFMA32(bf_[s], rf[s], Dbr); Dkr = MFMA32(kf[s], rf[s], Dkr); }
            f32x4 idn;
#pragma unroll
            for (int r = 0; r < 4; ++r) { const int row = 4 * g + r; idn[r] = (row == c) ? 1.f : 0.f;
                X0[r] = (c < row) ? X0[r] : 0.f;
                Y0[r] = (row < c) ? Y0[r] : 0.f;
                Dka[r] = (row < c) ? Dka[r] : 0.f;
                Dbr[r] = (row <= c) ? Dbr[r] : 0.f; Dkr[r] = (row <= c) ? Dkr[r] : 0.f; }
            const bf16x4 x0b = pack4v(X0), y0b = pack4v(Y0);
            const f32x4 X1 = MFMA16(y0b, x0b, zero), Y1 = MFMA16(x0b, y0b, zero);
            const bf16x4 x1b = pack4v(X1), y1b = pack4v(Y1);
            const f32x4 X2 = MFMA16(y1b, x1b, zero), Y2 = MFMA16(x1b, y1b, zero);
            const bf16x4 x2b = pack4v(X2), y2b = pack4v(Y2);
            const f32x4 X3 = MFMA16(y2b, x2b, zero);
            f32x4 U = Y0 + idn;
            U = MFMA16(pack4v(X1 + idn), pack4v(U), zero);
            U = MFMA16(pack4v(X2 + idn), pack4v(U), zero);
            U = MFMA16(pack4v(X3 + idn), pack4v(U), zero);
            bf16x8 Pb[2];
#pragma unroll
            for (int s = 0; s < 2; ++s) Pb[s] = pack8(P[2 * s], P[2 * s + 1]);
            f32x4 X = zero, O = zero;
#pragma unroll
            for (int s = 0; s < 2; ++s) { X = MFMA32(af[s], Pb[s], X); O = MFMA32(rf[s], Pb[s], O); }
            X = MFMA16(pack4v(Dka), vt, X);
            const f32x4 Z = MFMA16(pack4v(U), pack4v(X), zero);
            const bf16x4 zb = pack4v(Z);
            O = MFMA16(pack4v(Dbr), zb, O);
            O = MFMA16(pack4v(Dkr), vt, O);
#pragma unroll
            for (int r = 0; r < 4; ++r) Om[(4 * g + r) * 64 + 16 * wq + c] = O[r];
#pragma unroll
            for (int m = 0; m < 4; ++m) {
                const f32x4 w15 = *(const LAS f32x4*)(IM + R2_W15 + (16 * m + 4 * g) * 4);
                f32x4 pm = MFMA16(btm[m], zb, P[m]); pm = MFMA16(ktm[m], vt, pm); P[m] = pm * w15; }
        }
        __syncthreads();
        if (!(PADF & 1024)) {
            const f32x4 o4 = *(const LAS f32x4*)(Om + tt * 64 + jq);
            float s1 = sum16((o4[0] + o4[1]) + (o4[2] + o4[3]));
            const float mean = s1 * (1.f / 64.f); const f32x4 d4 = o4 - mean;
            float s2 = sum16((d4[0] * d4[0] + d4[1] * d4[1]) + (d4[2] * d4[2] + d4[3] * d4[3]));
            const float rs = __builtin_amdgcn_rsqf(s2 * (1.f / 64.f) + 64e-5f);
            f32x4 v4;
            { const v2u vw = *(const LAS v2u*)(IM + R2_VI + tt * R2_IP + jq * 2); v4 = (f32x4){bf_lo(vw.x), bf_hi(vw.x), bf_lo(vw.y), bf_hi(vw.y)}; }
            const f32x4 g4 = *(const LAS f32x4*)(Gm + tt * 64 + jq);
            const f32x4 y = ((d4 * rs) * lgv + lbv + v4 * BON[tt]) * g4;
            v2u w; w.x = pk2(y[0], y[1]); w.y = pk2(y[2], y[3]);
            *(GAS v2u*)(OUT + (size_t)(b * T + t0 + tt) * D + h * 64 + jq) = w;
        }
    };
    for (int ch = 0; ch < NCH; ch += 2) { do_chunk(ch, pf0); do_chunk(ch + 1, pf1); }
    __syncthreads();
}

constexpr int NPHASE = 19;
#ifndef PH_ONLY
#define PH_ONLY -1
#endif
#define PROBE_SCAN 0
#ifndef SCAN_SEL
#define SCAN_SEL 0
#endif
#define PH_ON(k) (PH_ONLY < 0 || PH_ONLY == (k))

template <int LAYER>
__device__ __forceinline__ void layer_phases(Frame& F, const Args& A_, const XcdBarrier& bar, const int lo, const int hi) {
#define IN(k) (PH_ON(k) && lo <= (k) && (k) < hi)
#define SEAM(k) do { if (lo <= (k) && (k) + 1 < hi) xcd_barrier(bar); } while (0)
    bf16* XN = (bf16*)(F.ws + WS_XN); bf16* PROJ = (bf16*)(F.ws + WS_PROJ);
    const int gw = F.vcu * NWAVES + F.wave, NGW = F.G * NWAVES;
    constexpr int pb = 1 + LAYER * 8;
    unsigned char* wmix = LAYER == 0 ? F.ws + WS_WS : F.ws + WS_W1;
    const float* xres = LAYER == 0 ? A_.in[0] : F.out;
    if (IN(pb)) {
        pg8::Gemm g{XN, (const bf16*)(wmix + MW_IN), D, D, D, nullptr}; pg8::StaticOrder S; S.init(M / 256, NPROJ / 256, F.G, (int)blockIdx.x);
        pg8::EpiBf16Plain E{PROJ, NPROJ};
        pg8::gemm_phase<pg8::EpiBf16Plain, pg8::StaticOrder, true, true, false>(F.lds, g, S, E);
    }
    SEAM(pb);
    if (IN(pb + 1)) {
        { const int job = F.vcu; if (job < 128) { if (SCAN_SEL != 2 && !(PADF & 2)) gdn_unit2(F, A_, LAYER, job); } else if (job < 256) { if (SCAN_SEL != 1 && !(PADF & 1)) rwkv_pair2(F, A_, LAYER, job - 128); } }
        if (F.vcu < 128 && !PADF) {
            __syncthreads();
            LAS float* scr = (LAS float*)(F.lds + F.wave * 16384);
            const int cw = F.vcu * NWAVES + F.wave, NCW = 128 * NWAVES;
            if constexpr (LAYER == 0) {
                for (int it = cw; it < MIXER_ITEMS + FFN_ITEMS; it += NCW) {
                    if (it < MIXER_ITEMS) conv_mixer_item(F, A_, 1, F.ws + WS_W1, it, scr);
                    else conv_ffn_item(F, A_.in[22], A_.in[23], A_.in[24], (bf16*)(F.ws + WS_WS + FW_GU), (bf16*)(F.ws + WS_WS + FW_DN), it - MIXER_ITEMS, scr); }
                for (int it = cw; it < NE_EARLY * FFN_ITEMS8; it += NCW) { const int e = it / FFN_ITEMS8, r = it % FFN_ITEMS8;
                    conv_ffn_item_f8(F, A_.in[26] + (size_t)e * D * FF, A_.in[27] + (size_t)e * D * FF, A_.in[28] + (size_t)e * FF * D,
                                     F.ws + WS_WS + EW_GU + (size_t)e * NGU * D, F.ws + WS_WS + EW_DN + (size_t)e * D * FF, r); }
            } else {
                for (int it = cw + NE_EARLY * FFN_ITEMS8; it < NE * FFN_ITEMS8; it += NCW) { const int e = it / FFN_ITEMS8, r = it % FFN_ITEMS8;
                    conv_ffn_item_f8(F, A_.in[26] + (size_t)e * D * FF, A_.in[27] + (size_t)e * D * FF, A_.in[28] + (size_t)e * FF * D,
                                     F.ws + WS_WS + EW_GU + (size_t)e * NGU * D, F.ws + WS_WS + EW_DN + (size_t)e * D * FF, r); }
            }
        }
    }
    SEAM(pb + 1);
    if (IN(pb + 2)) {
        pg8::StaticOrder S; S.init(M / 256, D / 256, F.G, (int)blockIdx.x);
        { pg8::Gemm g{XN, (const bf16*)(wmix + MW_PA), D, 512, 512, nullptr}; pg8::EpiMerge<true> E{PROJ, PROJ + C_GA, NPROJ};
          pg8::gemm_phase<pg8::EpiMerge<true>, pg8::StaticOrder, true, true, false>(F.lds, g, S, E); }
        { pg8::Gemm g{XN + 512, (const bf16*)(wmix + MW_PB), D, 512, 512, nullptr}; pg8::EpiMerge<false> E{PROJ, PROJ + C_GB, NPROJ};
          pg8::gemm_phase<pg8::EpiMerge<false>, pg8::StaticOrder, true, true, false>(F.lds, g, S, E); }
    }
    SEAM(pb + 2);
    if (IN(pb + 3)) {
        pg8::Gemm g{PROJ, (const bf16*)(wmix + MW_OUT), NPROJ, D, D, nullptr}; pg8::StaticOrder S; S.init(M / 256, D / 256, F.G, (int)blockIdx.x);
        pg8::EpiResid E{xres, F.out, D};
        pg8::gemm_phase<pg8::EpiResid, pg8::StaticOrder, true, true, false>(F.lds, g, S, E);
    }
    SEAM(pb + 3);
    if constexpr (LAYER == 0) {
        if (IN(5)) norm_phase<1>(F, F.out, A_.in[21], nullptr, 0);
        SEAM(5);
        if (IN(6)) {
            pg8::Gemm g{XN, (const bf16*)(F.ws + WS_WS + FW_GU), D, D, D, nullptr}; pg8::StaticOrder S; S.init(M / 256, NGU / 256, F.G, (int)blockIdx.x);
            pg8::EpiSwiglu E{PROJ, FF};
            pg8::gemm_phase<pg8::EpiSwiglu, pg8::StaticOrder, true, true, false>(F.lds, g, S, E);
        }
        SEAM(6);
        if (IN(7)) {
            pg8::Gemm g{PROJ, (const bf16*)(F.ws + WS_WS + FW_DN), FF, FF, FF, nullptr}; pg8::StaticOrder S; S.init(M / 256, D / 256, F.G, (int)blockIdx.x);
            pg8::EpiResid E{F.out, F.out, D};
            pg8::gemm_phase<pg8::EpiResid, pg8::StaticOrder, true, true, false>(F.lds, g, S, E);
        }
        SEAM(7);
        if (IN(8)) norm_phase<0>(F, F.out, A_.in[1] + D, A_.in[2] + (size_t)D * INC + SRC_AB, INC);
        SEAM(8);
    } else {
        if (IN(13)) {
            norm_phase<2>(F, F.out, A_.in[21] + D, A_.in[25], 8);
        }
        SEAM(13);
        if (IN(14)) route_scatter(F);
        SEAM(14);
        const int* grp = (const int*)(F.ws + WS_GRP);
        if (IN(15)) {
            const int np = grp[16] / 256;
            pg8::Gemm g{XN, (const bf16*)(F.ws + WS_WS + EW_GU), D, D, D, (const int*)(F.ws + WS_LIST)}; pg8::MoeOrder S; S.init(grp, 0, np, NGU / 256, F.G, (int)blockIdx.x);
            pg8::EpiSwigluF8 E{(unsigned char*)PROJ, FF, 1.0f / (F8_SX * F8_SW), F8_SH};
            pg8::gemm_phase<pg8::EpiSwigluF8, pg8::MoeOrder, true, true, true, true>(F.lds, g, S, E);
        }
        SEAM(15);
        if (IN(16)) {
            const int np = grp[16] / 256;
            pg8::Gemm g{PROJ, (const bf16*)(F.ws + WS_WS + EW_DN), FF, FF, FF, nullptr}; pg8::MoeOrder S; S.init(grp, 0, np, D / 256, F.G, (int)blockIdx.x);
            pg8::EpiMoeDown E{F.out, (const int*)(F.ws + WS_LIST), (const float*)(F.ws + WS_GATEL), XN, grp[8], 1.0f / (F8_SH * F8_SW)};
            pg8::gemm_phase<pg8::EpiMoeDown, pg8::MoeOrder, true, true, false, true>(F.lds, g, S, E);
        }
        SEAM(16);
        if (IN(18)) norm_phase<3>(F, F.out, A_.in[29], nullptr, 0);
    }
}

__global__ void __launch_bounds__(NWAVES * 64, 2) trunk_fwd(Args A_) {
    extern __shared__ __attribute__((aligned(16))) unsigned char lds[];
    Frame F;
    F.lds = (LAS unsigned char*)lds;
    F.tid = threadIdx.x; F.lane = F.tid & 63; F.wave = __builtin_amdgcn_readfirstlane(F.tid >> 6);
    F.G = gridDim.x; { const int bx = blockIdx.x; F.vcu = (F.G % 8 == 0) ? (bx % 8) * (F.G / 8) + bx / 8 : bx; }
    F.out = A_.out; F.ws = A_.ws;
    unsigned* ctl = (unsigned*)(F.ws + WS_CTL);
    for (int u = F.tid; u < (LDS_BYTES - LDSCTL_OFF) / 4; u += NWAVES * 64) ((LAS unsigned*)(F.lds + LDSCTL_OFF))[u] = 0u;
    __syncthreads();
    XcdBarrier bar; bar.bar = ctl + CW_BAR + A_.li * XCD_BAR_WORDS; bar.x = 0; bar.st = nullptr;
    if (!MK_PER_PHASE) bar = xcd_barrier_post(ctl + CW_BAR + A_.li * XCD_BAR_WORDS, (volatile LAS unsigned*)(F.lds + MISC_OFF) + 8);
    const int lo = A_.ph_lo, hi = A_.ph_hi;
    if (IN(0)) {
        const int gw = F.vcu * NWAVES + F.wave, NGW = F.G * NWAVES;
        LAS float* scr = (LAS float*)(F.lds + F.wave * 16384);
        for (int it = gw; it < MIXER_ITEMS; it += NGW) conv_mixer_item(F, A_, 0, F.ws + WS_WS, it, scr);
        __syncthreads();
        norm_phase<0>(F, A_.in[0], A_.in[1], A_.in[2] + SRC_AB, INC);
    }
    SEAM(0);
    layer_phases<0>(F, A_, bar, lo, hi);
    layer_phases<1>(F, A_, bar, lo, hi);
#undef IN
#undef SEAM
}

extern "C" void kernel_launch(void* const* d_in, const int* in_sizes, int n_in, void* d_out, int out_size, void* d_ws, size_t ws_size, hipStream_t stream) {
    static int grid = 0;
    if (grid == 0) {
        if (n_in != 30 || in_sizes[0] != M * D || out_size != M * D || ws_size < WS_END) { fprintf(stderr, "kernel_launch: unexpected shapes / workspace (n_in %d, ws %zu, need %zu)\n", n_in, ws_size, (size_t)WS_END); grid = -1; return; }
        int dev = 0, cus = 0, per_cu = 0;
        if (hipGetDevice(&dev) != hipSuccess || hipDeviceGetAttribute(&cus, hipDeviceAttributeMultiprocessorCount, dev) != hipSuccess) { grid = -1; return; }
        if (hipFuncSetAttribute((const void*)trunk_fwd, hipFuncAttributeMaxDynamicSharedMemorySize, LDS_BYTES) != hipSuccess) { grid = -1; return; }
        if (hipOccupancyMaxActiveBlocksPerMultiprocessor(&per_cu, (const void*)trunk_fwd, NWAVES * 64, LDS_BYTES) != hipSuccess || per_cu < 1) { fprintf(stderr, "kernel_launch: occupancy query says %d\n", per_cu); }
        (void)hipGetLastError();
        grid = cus;
    }
    if (grid < 0) return;
    if (hipMemsetAsync((char*)d_ws + WS_CTL, 0, CTL_ZERO_BYTES, stream) != hipSuccess) return;
    Args a{};
    for (int i = 0; i < 30; ++i) a.in[i] = (const float*)d_in[i];
    a.out = (float*)d_out; a.ws = (unsigned char*)d_ws;
#if MK_PER_PHASE
    for (int p = 0; p < NPHASE; ++p) { a.ph_lo = p; a.ph_hi = p + 1; a.li = 0; hipLaunchKernelGGL(trunk_fwd, dim3(grid), dim3(NWAVES * 64), LDS_BYTES, stream, a); }
#elif PROBE_DUP >= 0
    a.ph_lo = 0; a.ph_hi = PROBE_DUP; a.li = 0; a.pad = 0; hipLaunchKernelGGL(trunk_fwd, dim3(grid), dim3(NWAVES * 64), LDS_BYTES, stream, a);
    a.ph_lo = PROBE_DUP; a.ph_hi = PROBE_DUP + 1; a.li = 1; a.pad = PROBE_SCAN; hipLaunchKernelGGL(trunk_fwd, dim3(grid), dim3(NWAVES * 64), LDS_BYTES, stream, a);
    a.ph_lo = PROBE_DUP; a.ph_hi = NPHASE; a.li = 2; a.pad = 0; hipLaunchKernelGGL(trunk_fwd, dim3(grid), dim3(NWAVES * 64), LDS_BYTES, stream, a);
#else
    a.ph_lo = 0; a.ph_hi = NPHASE; a.li = 0;
    hipLaunchKernelGGL(trunk_fwd, dim3(grid), dim3(NWAVES * 64), LDS_BYTES, stream, a);
#endif
}
```

```cpp
#include <hip/hip_runtime.h>
#include <cstdio>
#include <cstdint>
#pragma clang fp reassociate(on) contract(fast)

#ifndef MK_PER_PHASE
#define MK_PER_PHASE 0
#endif
#define PROBE_DUP -1
#define PADF (PROBE_DUP >= 0 ? A_.pad : 0)

#define GAS __attribute__((address_space(1)))
#define LAS __attribute__((address_space(3)))
typedef unsigned short bf16;
typedef unsigned v4u __attribute__((ext_vector_type(4)));
typedef unsigned v2u __attribute__((ext_vector_type(2)));
typedef float f32x4 __attribute__((ext_vector_type(4)));
typedef float f32x2 __attribute__((ext_vector_type(2)));
typedef short bf16x8 __attribute__((ext_vector_type(8)));
typedef GAS unsigned gu32;

constexpr int NWAVES = 8;
constexpr int BATCH = 32, T = 2048, D = 1024, M = BATCH * T;
constexpr int INC = 5896, NPROJ = 5888;
constexpr int C_R = 0, C_K = 512, C_V = 1024, C_WL = 1536, C_GQ = 1792, C_GK = 2304, C_GV = 2816, C_Z = 3328, C_GA = 3840, C_GB = 4864;
constexpr int SRC_AB = 3328;
constexpr int FF = 2816, NGU = 2 * FF, NE = 8;
constexpr int LISTCAP = 2 * M + 16 * 256;

constexpr size_t MiB = 1u << 20;
constexpr size_t WS_CTL = 0, CTL_ZERO_BYTES = 1 * MiB;
constexpr size_t WS_AB = 1 * MiB;
constexpr size_t WS_RE = 3 * MiB;
constexpr size_t WS_RG = WS_RE + (size_t)M * 4;
constexpr size_t WS_WGCNT = WS_RG + (size_t)M * 4;
constexpr size_t WS_GRP = WS_WGCNT + 256 * 16 * 4;
constexpr size_t WS_LIST = 4 * MiB;
constexpr size_t WS_GATEL = 5 * MiB;
constexpr size_t WS_W1 = 8 * MiB;
constexpr size_t WS_WS = 24 * MiB;
constexpr size_t WS_XN = 156 * MiB;
constexpr size_t WS_PROJ = 284 * MiB;
constexpr size_t WS_END = WS_PROJ + (size_t)M * NPROJ * 2;
static_assert(WS_END == 1020 * MiB, "ws map");
static_assert((size_t)LISTCAP * NGU <= (size_t)M * NPROJ * 2, "moe hidden fits in the PROJ region");
constexpr size_t MW_IN = 0, MW_PA = MW_IN + (size_t)NPROJ * D * 2, MW_PB = MW_PA + (size_t)D * 512 * 2, MW_OUT = MW_PB + (size_t)D * 512 * 2, MW_END = MW_OUT + (size_t)D * D * 2;
constexpr size_t FW_GU = MW_END, FW_DN = FW_GU + (size_t)NGU * D * 2, FW_END = FW_DN + (size_t)D * FF * 2;
constexpr size_t EW_GU = 56 * MiB, EW_DN = EW_GU + (size_t)NE * NGU * D;
static_assert(WS_W1 + MW_END <= WS_WS && FW_END <= EW_GU && WS_WS + EW_DN + (size_t)NE * D * FF <= WS_XN, "weight map");
constexpr int NE_EARLY = 3;
constexpr int CW_BAR = 4096;

constexpr int RING_BYTES = 131072;
constexpr int LDSCTL_OFF = RING_BYTES, MISC_OFF = LDSCTL_OFF + 320;
constexpr int LDS_BYTES = 147456;

#define RLX_AGENT __ATOMIC_RELAXED, __HIP_MEMORY_SCOPE_AGENT
#define LDS_WAIT() asm volatile("s_waitcnt lgkmcnt(0)" ::: "memory")
#define VM_WAIT() asm volatile("s_waitcnt vmcnt(0)" ::: "memory")
__device__ __forceinline__ unsigned f2bf(float f) { return (unsigned)__builtin_bit_cast(unsigned short, (__bf16)f); }
typedef __bf16 bf16v2_t __attribute__((ext_vector_type(2)));
__device__ __forceinline__ unsigned pk2(float lo, float hi) { const f32x2 v = {lo, hi}; return __builtin_bit_cast(unsigned, __builtin_convertvector(v, bf16v2_t)); }
__device__ __forceinline__ float bf_lo(unsigned w) { return __builtin_bit_cast(float, w << 16); }
__device__ __forceinline__ float bf_hi(unsigned w) { return __builtin_bit_cast(float, w & 0xffff0000u); }
__device__ __forceinline__ float bf2f(bf16 v) { return __builtin_bit_cast(float, (unsigned)v << 16); }
__device__ __forceinline__ float sigmoidf_(float x) { return __builtin_amdgcn_rcpf(1.0f + __expf(-x)); }
__device__ __forceinline__ float softplusf_(float x) { return x > 20.f ? x : log1pf(__expf(x)); }
__device__ __forceinline__ unsigned f8x4(float a, float b, float c, float d) {
    a = __builtin_amdgcn_fmed3f(a, -448.f, 448.f); b = __builtin_amdgcn_fmed3f(b, -448.f, 448.f); c = __builtin_amdgcn_fmed3f(c, -448.f, 448.f); d = __builtin_amdgcn_fmed3f(d, -448.f, 448.f);
    int w = __builtin_amdgcn_cvt_pk_fp8_f32(a, b, 0, false); w = __builtin_amdgcn_cvt_pk_fp8_f32(c, d, w, true); return (unsigned)w; }
constexpr float F8_SX = 8.f, F8_SW = 256.f, F8_SH = 8.f;

namespace pg8 {
constexpr int BM = 256, BK = 64, HALF = 128, HTB = HALF * BK * 2, STAGE_BYTES = 8 * HTB, NXCD = 8, WGM = 4;
__host__ __device__ __forceinline__ int lds_byte(int r, int c) { const int st = (r >> 4) * 2 + (c >> 5), rr = r & 15, cc = c & 31, ob = rr * 64 + cc * 2; return st * 1024 + (ob ^ (((ob >> 9) & 1) << 5)); }
__host__ __device__ __forceinline__ void stage_rc(int b, int& R, int& C) { const int st = b / 1024, sb = b % 1024, swz = sb ^ (((sb >> 9) & 1) << 5); R = (st >> 1) * 16 + swz / 64; C = (st & 1) * 32 + (swz % 64) / 2; }
__host__ __device__ __forceinline__ int perm32(int rho) { const int n = rho >> 4, i = rho & 15; return 8 * (i >> 2) + 4 * n + (i & 3); }

struct Unit { int pm, pn, pb; };
struct Gemm { const bf16* A; const bf16* Bt; int lda, ldb, K; const int* rows; };

struct StaticOrder {
    int nM, nN, nwg, G, c;
    __device__ void init(int nM_, int nN_, int G_, int c_) { nM = nM_; nN = nN_; nwg = nM * nN; G = G_; c = c_; }
    __device__ bool next(int i, Unit& u) const {
        const long L = (long)i * G + c; if (L >= nwg) return false;
        int wgid = (int)L; { const int q = nwg / NXCD, r = nwg % NXCD, xcd = wgid % NXCD, off = wgid / NXCD; wgid = (xcd < r ? xcd * (q + 1) : r * (q + 1) + (xcd - r) * q) + off; }
        const int nig = WGM * nN, gid = wgid / nig, fm = gid * WGM, gsz = (nM - fm) < WGM ? (nM - fm) : WGM;
        u.pm = fm + ((wgid % nig) % gsz); u.pn = (wgid % nig) / gsz; u.pb = u.pn; return true;
    }
};
struct MoeOrder {
    int nM, nN, nwg, G, c, p0; int gb[16];
    __device__ void init(const int* grp, int p0_, int nM_, int nN_, int G_, int c_) { p0 = p0_; nM = nM_; nN = nN_; nwg = nM * nN; G = G_; c = c_;
#pragma unroll
        for (int k = 0; k < 16; ++k) gb[k] = grp[k]; }
    __device__ bool next(int i, Unit& u) const {
        const long L = (long)i * G + c; if (L >= nwg) return false;
        int wgid = (int)L; { const int q = nwg / NXCD, r = nwg % NXCD, xcd = wgid % NXCD, off = wgid / NXCD; wgid = (xcd < r ? xcd * (q + 1) : r * (q + 1) + (xcd - r) * q) + off; }
        const int nig = WGM * nN, gid = wgid / nig, fm = gid * WGM, gsz = (nM - fm) < WGM ? (nM - fm) : WGM;
        u.pm = p0 + fm + ((wgid % nig) % gsz); u.pn = (wgid % nig) / gsz;
        const int rowpos = u.pm * BM; int g = 0;
#pragma unroll
        for (int k = 1; k < 16; ++k) g += (rowpos >= gb[k]) ? 1 : 0;
        u.pb = (g & 7) * nN + u.pn; return true;
    }
};

__device__ __forceinline__ unsigned cvt_pk_bf16(float lo, float hi) { unsigned r; asm volatile("v_cvt_pk_bf16_f32 %0, %1, %2" : "=v"(r) : "v"(lo), "v"(hi)); return r; }

struct EpiBf16Plain {
    static constexpr bool PERM = true;
    bf16* O; int ldc;
    __device__ __forceinline__ void operator()(const f32x4 (&acc)[2][2][4][2], const Unit& u, int wr, int wc, int fr, int fq) const {
        const int row0 = u.pm * BM + wr * 64 + fr, col0 = u.pn * BM + wc * 32 + 8 * fq;
#pragma unroll
        for (int ai = 0; ai < 2; ++ai)
#pragma unroll
            for (int m = 0; m < 4; ++m) { bf16* rowp = O + (size_t)(row0 + ai * HALF + m * 16) * ldc + col0;
#pragma unroll
                for (int bj = 0; bj < 2; ++bj) { const f32x4 v0 = acc[ai][bj][m][0], v1 = acc[ai][bj][m][1];
                    v4u w; w.x = cvt_pk_bf16(v0[0], v0[1]); w.y = cvt_pk_bf16(v0[2], v0[3]); w.z = cvt_pk_bf16(v1[0], v1[1]); w.w = cvt_pk_bf16(v1[2], v1[3]);
                    *(v4u*)(rowp + bj * HALF) = w; } }
    }
};
template <bool FIRST> struct EpiMerge {
    static constexpr bool PERM = true;
    bf16* Y; const bf16* Gt; int ldc;
    __device__ __forceinline__ void operator()(const f32x4 (&acc)[2][2][4][2], const Unit& u, int wr, int wc, int fr, int fq) const {
        const int row0 = u.pm * BM + wr * 64 + fr, col0 = u.pn * BM + wc * 32 + 8 * fq;
#pragma unroll
        for (int ai = 0; ai < 2; ++ai)
#pragma unroll
            for (int mp = 0; mp < 2; ++mp) {
                v4u gw[2][2], yw[2][2];
#pragma unroll
                for (int mm = 0; mm < 2; ++mm)
#pragma unroll
                    for (int bj = 0; bj < 2; ++bj) { const size_t ro = (size_t)(row0 + ai * HALF + (2 * mp + mm) * 16) * ldc + col0 + bj * HALF;
                        gw[mm][bj] = *(const v4u*)(Gt + ro); if (!FIRST) yw[mm][bj] = *(const v4u*)(Y + ro); }
#pragma unroll
                for (int mm = 0; mm < 2; ++mm)
#pragma unroll
                    for (int bj = 0; bj < 2; ++bj) { const int m = 2 * mp + mm; const size_t ro = (size_t)(row0 + ai * HALF + m * 16) * ldc + col0 + bj * HALF;
                        const f32x4 v0 = acc[ai][bj][m][0], v1 = acc[ai][bj][m][1]; const v4u g4 = gw[mm][bj];
                        auto mg2 = [](unsigned gw2, float a0, float a1) { const f32x2 t = (f32x2){bf_lo(gw2), bf_hi(gw2)} * (f32x2){-1.44269504089f, -1.44269504089f};
                            f32x2 e; e[0] = __builtin_amdgcn_exp2f(t[0]); e[1] = __builtin_amdgcn_exp2f(t[1]); const f32x2 d = e + (f32x2){1.0f, 1.0f};
                            f32x2 r; r[0] = __builtin_amdgcn_rcpf(d[0]); r[1] = __builtin_amdgcn_rcpf(d[1]); return r * (f32x2){a0, a1}; };
                        f32x2 o[4];
                        o[0] = mg2(g4.x, v0[0], v0[1]); o[1] = mg2(g4.y, v0[2], v0[3]); o[2] = mg2(g4.z, v1[0], v1[1]); o[3] = mg2(g4.w, v1[2], v1[3]);
                        if (!FIRST) { const v4u y4 = yw[mm][bj];
                            o[0] += (f32x2){bf_lo(y4.x), bf_hi(y4.x)}; o[1] += (f32x2){bf_lo(y4.y), bf_hi(y4.y)}; o[2] += (f32x2){bf_lo(y4.z), bf_hi(y4.z)}; o[3] += (f32x2){bf_lo(y4.w), bf_hi(y4.w)}; }
                        v4u w; w.x = cvt_pk_bf16(o[0][0], o[0][1]); w.y = cvt_pk_bf16(o[1][0], o[1][1]); w.z = cvt_pk_bf16(o[2][0], o[2][1]); w.w = cvt_pk_bf16(o[3][0], o[3][1]);
                        *(v4u*)(Y + ro) = w; }
            }
    }
};
struct EpiResid {
    static constexpr bool PERM = false;
    const float* base; float* out; int ldc;
    __device__ __forceinline__ void operator()(const f32x4 (&acc)[2][2][4][2], const Unit& u, int wr, int wc, int fr, int fq) const {
        const int row0 = u.pm * BM + wr * 64 + fr, col0 = u.pn * BM + wc * 32 + 4 * fq;
        f32x4 bs[2][2][2][2];
#define ER_LOAD(q, slot) do { _Pragma("unroll") for (int mm = 0; mm < 2; ++mm) _Pragma("unroll") for (int bj = 0; bj < 2; ++bj) _Pragma("unroll") for (int n = 0; n < 2; ++n) \
            bs[slot][mm][bj][n] = *(const f32x4*)(base + (size_t)(row0 + ((q) >> 1) * HALF + (2 * ((q) & 1) + mm) * 16) * ldc + col0 + bj * HALF + n * 16); } while (0)
#define ER_STORE(q, slot) do { _Pragma("unroll") for (int mm = 0; mm < 2; ++mm) _Pragma("unroll") for (int bj = 0; bj < 2; ++bj) _Pragma("unroll") for (int n = 0; n < 2; ++n) \
            *(f32x4*)(out + (size_t)(row0 + ((q) >> 1) * HALF + (2 * ((q) & 1) + mm) * 16) * ldc + col0 + bj * HALF + n * 16) = bs[slot][mm][bj][n] + acc[(q) >> 1][bj][2 * ((q) & 1) + mm][n]; } while (0)
        ER_LOAD(0, 0); ER_LOAD(1, 1); ER_STORE(0, 0); ER_LOAD(2, 0); ER_STORE(1, 1); ER_LOAD(3, 1); ER_STORE(2, 0); ER_STORE(3, 1);
#undef ER_LOAD
#undef ER_STORE
    }
};
__device__ __forceinline__ f32x2 silu_mul2(const f32x2 g, const f32x2 up, float c1, float lc, float kinv) {
    const f32x2 a = g * (f32x2){c1, c1} + (f32x2){lc, lc};
    f32x2 e; e[0] = __builtin_amdgcn_exp2f(a[0]); e[1] = __builtin_amdgcn_exp2f(a[1]);
    const f32x2 d = e + (f32x2){kinv, kinv};
    f32x2 r; r[0] = __builtin_amdgcn_rcpf(d[0]); r[1] = __builtin_amdgcn_rcpf(d[1]);
    return (g * up) * r;
}
struct EpiSwiglu {
    static constexpr bool PERM = true;
    bf16* H; int ldc;
    __device__ __forceinline__ void operator()(const f32x4 (&acc)[2][2][4][2], const Unit& u, int wr, int wc, int fr, int fq) const {
        const int row0 = u.pm * BM + wr * 64 + fr, col0 = u.pn * HALF + wc * 32 + 8 * fq;
#pragma unroll
        for (int ai = 0; ai < 2; ++ai)
#pragma unroll
            for (int m = 0; m < 4; ++m) { bf16* rowp = H + (size_t)(row0 + ai * HALF + m * 16) * ldc + col0;
                f32x2 o[4];
#pragma unroll
                for (int n = 0; n < 2; ++n)
#pragma unroll
                    for (int jp = 0; jp < 2; ++jp) { const f32x4 g4 = acc[ai][0][m][n], u4 = acc[ai][1][m][n];
                        o[n * 2 + jp] = silu_mul2((f32x2){g4[2 * jp], g4[2 * jp + 1]}, (f32x2){u4[2 * jp], u4[2 * jp + 1]}, -1.44269504089f, 0.f, 1.0f); }
                v4u w; w.x = cvt_pk_bf16(o[0][0], o[0][1]); w.y = cvt_pk_bf16(o[1][0], o[1][1]); w.z = cvt_pk_bf16(o[2][0], o[2][1]); w.w = cvt_pk_bf16(o[3][0], o[3][1]);
                *(v4u*)rowp = w; }
    }
};
struct EpiSwigluF8 {
    static constexpr bool PERM = true;
    unsigned char* H; int ldc; float insc, osc;
    __device__ __forceinline__ void operator()(const f32x4 (&acc)[2][2][4][2], const Unit& u, int wr, int wc, int fr, int fq) const {
        const int row0 = u.pm * BM + wr * 64 + fr, col0 = u.pn * HALF + wc * 32 + 8 * fq;
#pragma unroll
        for (int ai = 0; ai < 2; ++ai)
#pragma unroll
            for (int m = 0; m < 4; ++m) { unsigned char* rowp = H + (size_t)(row0 + ai * HALF + m * 16) * ldc + col0;
                const float c2 = insc * insc * osc, c1 = -1.44269504089f * insc, lc = -__builtin_log2f(c2), kinv = 1.0f / c2;
                f32x2 o[4];
#pragma unroll
                for (int n = 0; n < 2; ++n)
#pragma unroll
                    for (int jp = 0; jp < 2; ++jp) { const f32x4 g4 = acc[ai][0][m][n], u4 = acc[ai][1][m][n];
                        o[n * 2 + jp] = silu_mul2((f32x2){g4[2 * jp], g4[2 * jp + 1]}, (f32x2){u4[2 * jp], u4[2 * jp + 1]}, c1, lc, kinv); }
                v2u w; w.x = f8x4(o[0][0], o[0][1], o[1][0], o[1][1]); w.y = f8x4(o[2][0], o[2][1], o[3][0], o[3][1]);
                *(v2u*)rowp = w; }
    }
};
struct EpiMoeDown {
    static constexpr bool PERM = false;
    float* out; const int* list; const float* gatel; bf16* tmp; int split; float sc;
    __device__ __forceinline__ void operator()(const f32x4 (&acc)[2][2][4][2], const Unit& u, int wr, int wc, int fr, int fq) const {
        const int row0 = u.pm * BM + wr * 64 + fr, col0 = u.pn * BM + wc * 32 + 4 * fq;
        int tok[2][4]; float gt[2][4];
#pragma unroll
        for (int ai = 0; ai < 2; ++ai)
#pragma unroll
            for (int m = 0; m < 4; ++m) { const int p = row0 + ai * HALF + m * 16; tok[ai][m] = list[p]; gt[ai][m] = gatel[p] * sc; }
        if (u.pm * BM >= split) {
#pragma unroll
            for (int ai = 0; ai < 2; ++ai)
#pragma unroll
                for (int m = 0; m < 4; ++m) { const int tk = tok[ai][m]; const float g = gt[ai][m];
                    if (tk >= 0) { bf16* rowp = tmp + (size_t)tk * D + col0;
#pragma unroll
                        for (int bj = 0; bj < 2; ++bj)
#pragma unroll
                            for (int n = 0; n < 2; ++n) { const f32x4 o = acc[ai][bj][m][n] * g; v2u w; w.x = cvt_pk_bf16(o[0], o[1]); w.y = cvt_pk_bf16(o[2], o[3]); *(v2u*)(rowp + bj * HALF + n * 16) = w; } } }
            return;
        }
#pragma unroll
        for (int ai = 0; ai < 2; ++ai)
#pragma unroll
            for (int mp = 0; mp < 2; ++mp) {
                f32x4 bs[2][2][2];
#pragma unroll
                for (int mm = 0; mm < 2; ++mm) { const int tk = tok[ai][2 * mp + mm]; const float* rowp = out + (size_t)(tk < 0 ? 0 : tk) * D + col0;
#pragma unroll
                    for (int bj = 0; bj < 2; ++bj)
#pragma unroll
                        for (int n = 0; n < 2; ++n) bs[mm][bj][n] = *(const f32x4*)(rowp + bj * HALF + n * 16); }
#pragma unroll
                for (int mm = 0; mm < 2; ++mm) { const int tk = tok[ai][2 * mp + mm]; const float g = gt[ai][2 * mp + mm];
                    if (tk >= 0) { float* rowp = out + (size_t)tk * D + col0;
#pragma unroll
                        for (int bj = 0; bj < 2; ++bj)
#pragma unroll
                            for (int n = 0; n < 2; ++n) *(f32x4*)(rowp + bj * HALF + n * 16) = bs[mm][bj][n] + acc[ai][bj][2 * mp + mm][n] * g; } }
            }
    }
};

typedef int v4i_t __attribute__((ext_vector_type(4)));
typedef int v8i_t __attribute__((ext_vector_type(8)));
__device__ __forceinline__ v8i_t cat8(const bf16x8 a, const bf16x8 b) { return __builtin_shufflevector(__builtin_bit_cast(v4i_t, a), __builtin_bit_cast(v4i_t, b), 0, 1, 2, 3, 4, 5, 6, 7); }
template <class Epi, class Sched, bool ALIGN_EPI, bool SP2, bool GATHER, bool F8 = false>
__device__ __forceinline__ void gemm_phase(LAS unsigned char* lds, const Gemm g, const Sched& S, const Epi& E) {
    constexpr unsigned EB = F8 ? 1u : 2u;
    const int tid = threadIdx.x, wid = __builtin_amdgcn_readfirstlane(tid >> 6), lane = tid & 63, wr = wid >> 2, wc = wid & 3, fr = lane & 15, fq = lane >> 4;
    const int K = g.K, nt = K / (F8 ? 2 * BK : BK);
    unsigned voffA[2], voffB[2]; int stR[2], stC[2];
#pragma unroll
    for (int i = 0; i < 2; ++i) { int R, C; stage_rc(tid * 16 + i * 8192, R, C); const int Rb = Epi::PERM ? ((R & ~31) + perm32(R & 31)) : R;
        voffA[i] = (unsigned)(R * g.lda) * EB + (unsigned)C * 2u; voffB[i] = (unsigned)(Rb * g.ldb) * EB + (unsigned)C * 2u; stR[i] = R; stC[i] = C; }
    const size_t kstep = (size_t)(BK * 2);
    const size_t hstepA = (size_t)HALF * g.lda * EB, tstepA = 2 * hstepA, hstepB = (size_t)HALF * g.ldb * EB, tstepB = 2 * hstepB;
    const unsigned ldsw = (unsigned)wid * 1024u;
    const int aoff = lds_byte(wr * 64 + fr, fq * 8), boff = lds_byte(wc * 32 + fr, fq * 8);
    unsigned gAc[2][2], gAn[2][2];
#define PG8_SA(b, h) (((b) * 2 + (h)) * HTB)
#define PG8_SB(b, h) ((4 + (b) * 2 + (h)) * HTB)
#define PG8_GLDS(src, bufoff, i) __builtin_amdgcn_global_load_lds((const unsigned*)(src), (LAS unsigned*)(lds + (bufoff) + ldsw + (i) * 8192), 16, 0, 0)
#define PG8_STAGE_B(bufoff, gbase) do { _Pragma("unroll") for (int _i = 0; _i < 2; ++_i) PG8_GLDS((const char*)(gbase) + voffB[_i], bufoff, _i); } while (0)
#define PG8_STAGE_A(bufoff, h, NX, kb) do { \
        if constexpr (GATHER) { _Pragma("unroll") for (int _i = 0; _i < 2; ++_i) { const unsigned _o = (NX) ? gAn[h][_i] : gAc[h][_i]; PG8_GLDS((const char*)g.A + _o + (kb), bufoff, _i); } } \
        else { const char* _b = ((NX) ? nA : cA) + (h) * hstepA + (kb); _Pragma("unroll") for (int _i = 0; _i < 2; ++_i) PG8_GLDS(_b + voffA[_i], bufoff, _i); } } while (0)
#define PG8_LDA(dst, b, h) do { _Pragma("unroll") for (int m = 0; m < 4; ++m) _Pragma("unroll") for (int k = 0; k < 2; ++k) dst[m][k] = *(const LAS bf16x8*)(lds + PG8_SA(b, h) + aoff + m * 2048 + k * 1024); } while (0)
#define PG8_LDB(dst, b, h) do { _Pragma("unroll") for (int n = 0; n < 2; ++n) _Pragma("unroll") for (int k = 0; k < 2; ++k) dst[n][k] = *(const LAS bf16x8*)(lds + PG8_SB(b, h) + boff + n * 2048 + k * 1024); } while (0)
#define PG8_MMA(ai, bj, At, Bt) do { __builtin_amdgcn_s_setprio(1); _Pragma("unroll") for (int m = 0; m < 4; ++m) _Pragma("unroll") for (int n = 0; n < 2; ++n) { \
        if constexpr (F8) asm("v_mfma_f32_16x16x128_f8f6f4 %0, %1, %2, %0" : "+v"(acc[ai][bj][m][n]) : "v"(cat8(Bt[n][0], Bt[n][1])), "v"(cat8(At[m][0], At[m][1]))); \
        else { _Pragma("unroll") for (int k = 0; k < 2; ++k) acc[ai][bj][m][n] = __builtin_amdgcn_mfma_f32_16x16x32_bf16(Bt[n][k], At[m][k], acc[ai][bj][m][n], 0, 0, 0); } } __builtin_amdgcn_s_setprio(0); } while (0)
#define PG8_WAIT_V(n) asm volatile("s_waitcnt vmcnt(" #n ")" ::: "memory")
#define PG8_WAIT_L(n) asm volatile("s_waitcnt lgkmcnt(" #n ")" ::: "memory")
#define PG8_BAR __builtin_amdgcn_s_barrier()
#define PG8_SCHED __builtin_amdgcn_sched_barrier(0)
#define PG8_GOFF(dst, unit) do { _Pragma("unroll") for (int _h = 0; _h < 2; ++_h) _Pragma("unroll") for (int _i = 0; _i < 2; ++_i) { int _t = g.rows[(unit).pm * BM + _h * HALF + stR[_i]]; _t = _t < 0 ? 0 : _t; \
        dst[_h][_i] = (unsigned)_t * ((unsigned)g.lda * EB) + (unsigned)(stC[_i] * 2); } } while (0)
    Unit cur, nxt; int ui = 0;
    if (!S.next(0, cur)) return;
    f32x4 acc[2][2][4][2];
#pragma unroll
    for (int a = 0; a < 2; ++a)
#pragma unroll
        for (int b = 0; b < 2; ++b)
#pragma unroll
            for (int m = 0; m < 4; ++m)
#pragma unroll
                for (int n = 0; n < 2; ++n) acc[a][b][m][n] = (f32x4){0.f, 0.f, 0.f, 0.f};
    bf16x8 At[4][2], B0[2][2], B1[2][2];
    const char* cA = (const char*)g.A + (size_t)cur.pm * tstepA; const char* cB = (const char*)g.Bt + (size_t)cur.pb * tstepB;
    const char* nA = cA;
    if constexpr (GATHER) { PG8_GOFF(gAc, cur); _Pragma("unroll") for (int _h = 0; _h < 2; ++_h) _Pragma("unroll") for (int _i = 0; _i < 2; ++_i) gAn[_h][_i] = gAc[_h][_i]; }
    if constexpr (SP2) {
        PG8_STAGE_B(PG8_SB(0, 0), cB); PG8_STAGE_B(PG8_SB(0, 1), cB + hstepB); PG8_STAGE_A(PG8_SA(0, 0), 0, false, 0); PG8_STAGE_A(PG8_SA(0, 1), 1, false, 0);
        if (wr == 1) PG8_BAR;
        PG8_WAIT_V(2); PG8_BAR;
        PG8_STAGE_B(PG8_SB(1, 0), cB + kstep); PG8_STAGE_A(PG8_SA(1, 0), 0, false, kstep); PG8_STAGE_B(PG8_SB(1, 1), cB + hstepB + kstep);
        PG8_WAIT_V(6); PG8_BAR;
    } else {
        PG8_STAGE_B(PG8_SB(0, 0), cB); PG8_STAGE_A(PG8_SA(0, 0), 0, false, 0); PG8_STAGE_B(PG8_SB(0, 1), cB + hstepB); PG8_STAGE_A(PG8_SA(0, 1), 1, false, 0);
        if (wr == 1) PG8_BAR;
        PG8_WAIT_V(4); PG8_BAR;
        PG8_STAGE_B(PG8_SB(1, 0), cB + kstep); PG8_STAGE_A(PG8_SA(1, 0), 0, false, kstep); PG8_STAGE_B(PG8_SB(1, 1), cB + hstepB + kstep);
        PG8_WAIT_V(6); PG8_BAR;
    }
    for (;;) {
        const bool has_next = S.next(ui + 1, nxt);
        nA = has_next ? (const char*)g.A + (size_t)nxt.pm * tstepA : cA; const char* nB = has_next ? (const char*)g.Bt + (size_t)nxt.pb * tstepB : cB;
        if constexpr (GATHER) { if (has_next) PG8_GOFF(gAn, nxt); }
        for (int t = 0; t < nt; t += 2) {
            const bool last = (t == nt - 2);
            const size_t k1 = (size_t)(t + 1) * kstep;
            const size_t k2 = last ? 0 : (size_t)(t + 2) * kstep, k3 = k2 + kstep;
            const char* b2 = last ? nB : cB + (size_t)(t + 2) * kstep; const char* b3 = b2 + kstep;
            if constexpr (SP2) {
            PG8_LDB(B0, 0, 0); PG8_LDB(B1, 0, 1); PG8_SCHED; PG8_LDA(At, 0, 0); PG8_STAGE_A(PG8_SA(1, 1), 1, false, k1);
            PG8_WAIT_V(8); PG8_WAIT_L(0); PG8_BAR; PG8_MMA(0, 0, At, B0); PG8_MMA(0, 1, At, B1); PG8_BAR; PG8_SCHED;
            PG8_LDA(At, 0, 1); PG8_STAGE_B(PG8_SB(0, 0), b2); PG8_STAGE_B(PG8_SB(0, 1), b2 + hstepB); PG8_STAGE_A(PG8_SA(0, 0), 0, last, k2);
            PG8_WAIT_V(8); PG8_WAIT_L(0); PG8_BAR; PG8_MMA(1, 0, At, B0); PG8_MMA(1, 1, At, B1); PG8_BAR; PG8_SCHED;
            PG8_LDB(B0, 1, 0); PG8_LDB(B1, 1, 1); PG8_SCHED; PG8_LDA(At, 1, 0); PG8_STAGE_A(PG8_SA(0, 1), 1, last, k2);
            PG8_WAIT_V(8); PG8_WAIT_L(0); PG8_BAR; PG8_MMA(0, 0, At, B0); PG8_MMA(0, 1, At, B1); PG8_BAR; PG8_SCHED;
            PG8_LDA(At, 1, 1); PG8_STAGE_B(PG8_SB(1, 0), b3); PG8_STAGE_B(PG8_SB(1, 1), b3 + hstepB); PG8_STAGE_A(PG8_SA(1, 0), 0, last, k3);
            PG8_WAIT_V(8); PG8_WAIT_L(0); PG8_BAR; PG8_MMA(1, 0, At, B0); PG8_MMA(1, 1, At, B1); PG8_BAR; PG8_SCHED;
            } else {
            PG8_LDB(B0, 0, 0); PG8_SCHED; PG8_LDA(At, 0, 0); PG8_STAGE_A(PG8_SA(1, 1), 1, false, k1);
            PG8_WAIT_L(8); PG8_BAR; PG8_WAIT_L(0); PG8_MMA(0, 0, At, B0); PG8_BAR; PG8_SCHED;
            PG8_LDB(B1, 0, 1); PG8_STAGE_B(PG8_SB(0, 0), b2);
            PG8_BAR; PG8_WAIT_L(0); PG8_MMA(0, 1, At, B1); PG8_BAR;
            PG8_LDA(At, 0, 1); PG8_STAGE_A(PG8_SA(0, 0), 0, last, k2);
            PG8_BAR; PG8_WAIT_L(0); PG8_MMA(1, 0, At, B0); PG8_BAR; PG8_SCHED;
            PG8_STAGE_B(PG8_SB(0, 1), b2 + hstepB);
            PG8_WAIT_V(6); PG8_BAR; PG8_MMA(1, 1, At, B1); PG8_BAR;
            PG8_LDB(B0, 1, 0); PG8_SCHED; PG8_LDA(At, 1, 0); PG8_STAGE_A(PG8_SA(0, 1), 1, last, k2);
            PG8_WAIT_L(8); PG8_BAR; PG8_WAIT_L(0); PG8_MMA(0, 0, At, B0); PG8_BAR; PG8_SCHED;
            PG8_LDB(B1, 1, 1); PG8_STAGE_B(PG8_SB(1, 0), b3);
            PG8_BAR; PG8_WAIT_L(0); PG8_MMA(0, 1, At, B1); PG8_BAR;
            PG8_LDA(At, 1, 1); PG8_STAGE_A(PG8_SA(1, 0), 0, last, k3);
            PG8_BAR; PG8_WAIT_L(0); PG8_MMA(1, 0, At, B0); PG8_BAR; PG8_SCHED;
            PG8_STAGE_B(PG8_SB(1, 1), b3 + hstepB);
            PG8_WAIT_V(6); PG8_BAR; PG8_MMA(1, 1, At, B1); PG8_BAR;
            }
        }
        if constexpr (F8) { asm volatile("s_nop 15\n\ts_nop 15" ::: "memory"); PG8_SCHED; }
        if constexpr (ALIGN_EPI) { if (wr == 0) PG8_BAR; }
        E(acc, cur, wr, wc, fr, fq);
        if (!has_next) break;
#pragma unroll
        for (int a = 0; a < 2; ++a)
#pragma unroll
            for (int b = 0; b < 2; ++b)
#pragma unroll
                for (int m = 0; m < 4; ++m)
#pragma unroll
                    for (int n = 0; n < 2; ++n) acc[a][b][m][n] = (f32x4){0.f, 0.f, 0.f, 0.f};
        cur = nxt; cA = nA; cB = nB; ++ui;
        if constexpr (GATHER) { _Pragma("unroll") for (int _h = 0; _h < 2; ++_h) _Pragma("unroll") for (int _i = 0; _i < 2; ++_i) gAc[_h][_i] = gAn[_h][_i]; }
        if constexpr (ALIGN_EPI) { if (wr == 1) PG8_BAR; }
    }
    PG8_WAIT_V(0);
    if constexpr (!ALIGN_EPI) { if (wr == 0) PG8_BAR; }
    PG8_BAR;
#undef PG8_SA
#undef PG8_SB
#undef PG8_GLDS
#undef PG8_STAGE_A
#undef PG8_STAGE_B
#undef PG8_LDA
#undef PG8_LDB
#undef PG8_MMA
#undef PG8_WAIT_V
#undef PG8_WAIT_L
#undef PG8_BAR
#undef PG8_SCHED
#undef PG8_GOFF
}
}

#define XB_TMO      128
#define XB_XCNT(j)  (256  + 64 * (j))
#define XB_XSUB(j)  (1280 + 64 * (j))
#define XB_XGEN(j)  (2304 + 64 * (j))
#define XB_TOP      3328
#define XB_TOPGEN   3392
#define XCD_BAR_WORDS 3456
#define XB_SPIN_CAP (1u << 18)
__device__ __forceinline__ unsigned xb_ld(unsigned* p)              { return __hip_atomic_load(p, __ATOMIC_RELAXED, __HIP_MEMORY_SCOPE_AGENT); }
__device__ __forceinline__ unsigned xb_add(unsigned* p, unsigned v) { return __hip_atomic_fetch_add(p, v, __ATOMIC_RELAXED, __HIP_MEMORY_SCOPE_AGENT); }
__device__ __forceinline__ unsigned xb_xcc_id() { return (unsigned)__builtin_amdgcn_s_getreg((3 << 11) | 20) & 0xFu; }
#define XB_SPIN(cond, bar) do { unsigned _sp = 0; while (cond) { __builtin_amdgcn_s_sleep(1); \
    if ((++_sp & 255u) == 0u) { if (xb_ld(&(bar)[XB_TMO])) break; if (_sp > XB_SPIN_CAP) { atomicAdd(&(bar)[XB_TMO], 1u); break; } } } } while (0)
struct XcdBarrier { unsigned* bar; unsigned x; volatile LAS unsigned* st; };
__device__ __forceinline__ XcdBarrier xcd_barrier_post(unsigned* bar, volatile LAS unsigned* st) {
    XcdBarrier b; b.bar = bar; b.x = xb_xcc_id(); b.st = st;
    if (threadIdx.x == 0) (void)xb_add(&bar[XB_XCNT(b.x)], 1u);
    return b;
}
__device__ __forceinline__ void xcd_barrier_complete(unsigned* bar, unsigned x, unsigned& nloc, unsigned& nx) {
    const unsigned G = gridDim.x * gridDim.y * gridDim.z;
    unsigned sum, cnt, mine, sp = 0u;
    for (;;) {
        sum = 0u; cnt = 0u; mine = 0u;
#pragma unroll
        for (unsigned j = 0; j < 16; ++j) { const unsigned c = xb_ld(&bar[XB_XCNT(j)]); sum += c; cnt += (c > 0u) ? 1u : 0u; mine = (j == x) ? c : mine; }
        if (sum == G) break;
        __builtin_amdgcn_s_sleep(1);
        if ((++sp & 255u) == 0u) { if (xb_ld(&bar[XB_TMO])) break; if (sp > XB_SPIN_CAP) { atomicAdd(&bar[XB_TMO], 1u); break; } }
    }
    nloc = mine > 0u ? mine : 1u; nx = cnt > 0u ? cnt : 1u;
}
__device__ __forceinline__ void xcd_barrier(const XcdBarrier& b) {
    asm volatile("s_waitcnt vmcnt(0)" ::: "memory");
    __syncthreads();
    if (threadIdx.x == 0) {
        unsigned* bar = b.bar;
        __builtin_amdgcn_s_waitcnt(0);
        unsigned nloc = b.st[0], nx = b.st[1];
        if (nloc == 0u) { xcd_barrier_complete(bar, b.x, nloc, nx); b.st[0] = nloc; b.st[1] = nx; }
        const unsigned old = xb_add(&bar[XB_XSUB(b.x)], 1u);
        const unsigned gen = old / nloc;
        if (old + 1u == (gen + 1u) * nloc) {
            __builtin_amdgcn_fence(__ATOMIC_RELEASE, "agent");
            asm volatile("s_waitcnt vmcnt(0)" ::: "memory");
            const unsigned og = xb_add(&bar[XB_TOP], 1u);
            const unsigned tg = og / nx;
            if (og + 1u == (tg + 1u) * nx) xb_add(&bar[XB_TOPGEN], 1u);
            else XB_SPIN(xb_ld(&bar[XB_TOPGEN]) == tg, bar);
            __builtin_amdgcn_fence(__ATOMIC_ACQUIRE, "agent");
            xb_add(&bar[XB_XGEN(b.x)], 1u);
            asm volatile("s_waitcnt vmcnt(0)" ::: "memory");
        } else {
            XB_SPIN(xb_ld(&bar[XB_XGEN(b.x)]) == gen, bar);
            __builtin_amdgcn_fence(__ATOMIC_ACQUIRE, "agent");
            asm volatile("s_waitcnt vmcnt(0)" ::: "memory");
        }
    }
    __syncthreads();
}

struct Frame {
    LAS unsigned char* lds;
    int tid, lane, wave, vcu, G;
    float* out; unsigned char* ws;
};
struct Args { const float* in[30]; float* out; unsigned char* ws; int ph_lo, ph_hi, li, pad; };
template <int CTRL> __device__ __forceinline__ float dpp_mov(float v) { return __builtin_bit_cast(float, __builtin_amdgcn_update_dpp(0, __builtin_bit_cast(int, v), CTRL, 0xf, 0xf, true)); }
__device__ __forceinline__ float sum8(float v) { v += dpp_mov<0xB1>(v); v += dpp_mov<0x4E>(v); v += dpp_mov<0x141>(v); return v; }
__device__ __forceinline__ float sum16(float v) { v = sum8(v); v += dpp_mov<0x140>(v); return v; }
__device__ __forceinline__ float wave_sum(float v) {
    v = sum16(v);
    const int iv = __builtin_bit_cast(int, v);
    return (__builtin_bit_cast(float, __builtin_amdgcn_readlane(iv, 0)) + __builtin_bit_cast(float, __builtin_amdgcn_readlane(iv, 16))) +
           (__builtin_bit_cast(float, __builtin_amdgcn_readlane(iv, 32)) + __builtin_bit_cast(float, __builtin_amdgcn_readlane(iv, 48)));
}

__device__ __forceinline__ float reduce8(const float (&a)[8], int lane) {
    const bool b0 = lane & 1, b1 = lane & 2, b2 = lane & 4;
    float b[4], c[2];
#pragma unroll
    for (int m = 0; m < 4; ++m) { const float keep = b0 ? a[2 * m + 1] : a[2 * m], send = b0 ? a[2 * m] : a[2 * m + 1]; b[m] = keep + dpp_mov<0xB1>(send); }
#pragma unroll
    for (int m = 0; m < 2; ++m) { const float keep = b1 ? b[2 * m + 1] : b[2 * m], send = b1 ? b[2 * m] : b[2 * m + 1]; c[m] = keep + dpp_mov<0x4E>(send); }
    float d;
    { const float keep = b2 ? c[1] : c[0], send = b2 ? c[0] : c[1]; d = keep + dpp_mov<0x124>(send); }
    d += dpp_mov<0x128>(d);
    { const unsigned u = __builtin_bit_cast(unsigned, d); const auto r = __builtin_amdgcn_permlane16_swap(u, u, false, false); d = __builtin_bit_cast(float, (unsigned)r[0]) + __builtin_bit_cast(float, (unsigned)r[1]); }
    { const unsigned u = __builtin_bit_cast(unsigned, d); const auto r = __builtin_amdgcn_permlane32_swap(u, u, false, false); d = __builtin_bit_cast(float, (unsigned)r[0]) + __builtin_bit_cast(float, (unsigned)r[1]); }
    return d;
}

__device__ __forceinline__ void tr_item(const float* W, int ldw, int k0, int srccol0, bf16* WT, int K, int dstrow0, LAS float* scr, int lane) {
    (void)scr;
    const int kr = lane >> 3, nq = lane & 7;
    const float* src = W + (size_t)(k0 + 8 * kr) * ldw + srccol0 + 4 * nq;
    f32x4 x[8];
#pragma unroll
    for (int b = 0; b < 8; ++b) x[b] = *(const GAS f32x4*)(src + (size_t)b * ldw);
    bf16* dst = WT + (size_t)(dstrow0 + 4 * nq) * K + k0 + 8 * kr;
#pragma unroll
    for (int q = 0; q < 4; ++q) { v4u o; o.x = pk2(x[0][q], x[1][q]); o.y = pk2(x[2][q], x[3][q]); o.z = pk2(x[4][q], x[5][q]); o.w = pk2(x[6][q], x[7][q]);
        *(GAS v4u*)(dst + (size_t)q * K) = o; }
}
__device__ __forceinline__ void tr_item_f8(const float* W, int ldw, int k0, int srccol0, unsigned char* WT, int K, int dstrow0, int lane, float sc) {
    const int kr = lane >> 3, nq = lane & 7;
    const float* src = W + (size_t)(k0 + 4 * kr) * ldw + srccol0 + 4 * nq;
    f32x4 x[4][4];
#pragma unroll
    for (int a = 0; a < 4; ++a)
#pragma unroll
        for (int b = 0; b < 4; ++b) x[a][b] = *(const GAS f32x4*)(src + (size_t)(32 * a + b) * ldw);
    unsigned char* dst = WT + (size_t)(dstrow0 + 4 * nq) * K + k0 + 4 * kr;
#pragma unroll
    for (int a = 0; a < 4; ++a)
#pragma unroll
        for (int q = 0; q < 4; ++q)
            *(GAS unsigned*)(dst + (size_t)q * K + 32 * a) = f8x4(x[a][0][q] * sc, x[a][1][q] * sc, x[a][2][q] * sc, x[a][3][q] * sc);
}
__device__ __forceinline__ void conv_mixer_item(Frame& F, const Args& A_, int l, unsigned char* dst, int r, LAS float* scr) {
    constexpr int I_IN = 16 * (NPROJ / 32), I_P = 8 * 32, I_O = 16 * 32;
    if (r < I_IN) { const int kb = r / (NPROJ / 32), nb = r % (NPROJ / 32); tr_item(A_.in[2] + (size_t)l * D * INC, INC, kb * 64, nb * 32 + (nb >= 104 ? 8 : 0), (bf16*)(dst + MW_IN), D, nb * 32, scr, F.lane); return; } r -= I_IN;
    if (r < I_P) { const int kb = r / 32, nb = r % 32; tr_item(A_.in[14] + (size_t)l * 512 * D, D, kb * 64, nb * 32, (bf16*)(dst + MW_PA), 512, nb * 32, scr, F.lane); return; } r -= I_P;
    if (r < I_P) { const int kb = r / 32, nb = r % 32; tr_item(A_.in[19] + (size_t)l * 512 * D, D, kb * 64, nb * 32, (bf16*)(dst + MW_PB), 512, nb * 32, scr, F.lane); return; } r -= I_P;
    { const int kb = r / 32, nb = r % 32; tr_item(A_.in[20] + (size_t)l * D * D, D, kb * 64, nb * 32, (bf16*)(dst + MW_OUT), D, nb * 32, scr, F.lane); }
}
constexpr int MIXER_ITEMS = 16 * (NPROJ / 32) + 2 * 8 * 32 + 16 * 32;
constexpr int FFN_ITEMS = 3 * 16 * (FF / 32);
__device__ __forceinline__ void conv_ffn_item(Frame& F, const float* wg, const float* wu, const float* wd, bf16* gu, bf16* dn, int r, LAS float* scr) {
    constexpr int I_G = 16 * (FF / 32);
    if (r < I_G) { const int kb = r / (FF / 32), nb = r % (FF / 32), n0 = nb * 32; tr_item(wg, FF, kb * 64, n0, gu, D, (n0 / 128) * 256 + (n0 % 128), scr, F.lane); return; } r -= I_G;
    if (r < I_G) { const int kb = r / (FF / 32), nb = r % (FF / 32), n0 = nb * 32; tr_item(wu, FF, kb * 64, n0, gu, D, (n0 / 128) * 256 + 128 + (n0 % 128), scr, F.lane); return; } r -= I_G;
    { const int kb = r / 32, nb = r % 32; tr_item(wd, D, kb * 64, nb * 32, dn, FF, nb * 32, scr, F.lane); }
}

constexpr int FFN_ITEMS8 = 3 * 8 * (FF / 32);
__device__ __forceinline__ void conv_ffn_item_f8(Frame& F, const float* wg, const float* wu, const float* wd, unsigned char* gu, unsigned char* dn, int r) {
    constexpr int I_G = 8 * (FF / 32);
    static_assert((FF / 128) * (D / 32) == I_G, "down items");
    if (r < I_G) { const int kb = r / (FF / 32), nb = r % (FF / 32), n0 = nb * 32; tr_item_f8(wg, FF, kb * 128, n0, gu, D, (n0 / 128) * 256 + (n0 % 128), F.lane, F8_SW); return; } r -= I_G;
    if (r < I_G) { const int kb = r / (FF / 32), nb = r % (FF / 32), n0 = nb * 32; tr_item_f8(wu, FF, kb * 128, n0, gu, D, (n0 / 128) * 256 + 128 + (n0 % 128), F.lane, F8_SW); return; } r -= I_G;
    { const int kb = r / 32, nb = r % 32; tr_item_f8(wd, D, kb * 128, nb * 32, dn, FF, nb * 32, F.lane, F8_SW); }
}

template <int MODE>
__device__ __forceinline__ void norm_phase(Frame& F, const float* xin, const float* gain, const float* w8src, int w8ld) {
    bf16* XN = (bf16*)(F.ws + WS_XN);
    f32x4 gv[4];
#pragma unroll
    for (int j = 0; j < 4; ++j) { gv[j] = *(const f32x4*)(gain + 4 * F.lane + 256 * j); if constexpr (MODE == 2) gv[j] = gv[j] * F8_SX; }
    float w8[4][4][8];
    if constexpr (MODE == 0 || MODE == 2) {
#pragma unroll
        for (int j = 0; j < 4; ++j)
#pragma unroll
            for (int q = 0; q < 4; ++q) { const float* s = w8src + (size_t)(4 * F.lane + 256 * j + q) * w8ld; const f32x4 a = *(const f32x4*)s, b = *(const f32x4*)(s + 4);
                w8[j][q][0] = a[0]; w8[j][q][1] = a[1]; w8[j][q][2] = a[2]; w8[j][q][3] = a[3]; w8[j][q][4] = b[0]; w8[j][q][5] = b[1]; w8[j][q][6] = b[2]; w8[j][q][7] = b[3]; }
    }
    LAS int* cnt = (LAS int*)(F.lds);
    for (int p = F.vcu; p < M / 256; p += F.G) {
        if constexpr (MODE == 2) { if (F.tid < 16) cnt[F.tid] = 0; __syncthreads(); }
        f32x4 nx[4][4];
#pragma unroll
        for (int r = 0; r < 4; ++r) { const GAS f32x4* xr = (const GAS f32x4*)(xin + (size_t)(p * 256 + r * 8 + F.wave) * D) + F.lane;
#pragma unroll
            for (int j = 0; j < 4; ++j) nx[r][j] = __builtin_nontemporal_load(&xr[64 * j]); }
#pragma unroll 4
        for (int i = 0; i < 32; ++i) {
            const int m = p * 256 + i * 8 + F.wave;
            f32x4 v[4]; float s = 0.f;
            if constexpr (MODE == 3) {
                const GAS v2u* tr = (const GAS v2u*)(XN + (size_t)m * D) + F.lane;
#pragma unroll
                for (int j = 0; j < 4; ++j) { const v2u t2 = __builtin_nontemporal_load(&tr[64 * j]); nx[i & 3][j] += (f32x4){bf_lo(t2.x), bf_hi(t2.x), bf_lo(t2.y), bf_hi(t2.y)}; } }
#pragma unroll
            for (int j = 0; j < 4; ++j) { v[j] = nx[i & 3][j]; s += (v[j].x * v[j].x + v[j].y * v[j].y) + (v[j].z * v[j].z + v[j].w * v[j].w); }
            if (i + 4 < 32) { const GAS f32x4* xr = (const GAS f32x4*)(xin + (size_t)(m + 32) * D) + F.lane;
#pragma unroll
                for (int j = 0; j < 4; ++j) nx[i & 3][j] = __builtin_nontemporal_load(&xr[64 * j]); }
            const float rstd = 1.0f / sqrtf(wave_sum(s) * (1.f / D) + 1e-6f);
#pragma unroll
            for (int j = 0; j < 4; ++j) v[j] = v[j] * rstd * gv[j];
            if constexpr (MODE == 3) { GAS f32x4* o = (GAS f32x4*)(F.out + (size_t)m * D) + F.lane;
#pragma unroll
                for (int j = 0; j < 4; ++j) __builtin_nontemporal_store(v[j], &o[64 * j]);
            } else if constexpr (MODE == 2) { GAS unsigned* o4 = (GAS unsigned*)((unsigned char*)XN + (size_t)m * D) + F.lane;
#pragma unroll
                for (int j = 0; j < 4; ++j) o4[64 * j] = f8x4(v[j].x, v[j].y, v[j].z, v[j].w);
            } else { GAS v2u* o8 = (GAS v2u*)(XN + (size_t)m * D) + F.lane;
#pragma unroll
                for (int j = 0; j < 4; ++j) { v2u w; w.x = pk2(v[j].x, v[j].y); w.y = pk2(v[j].z, v[j].w); o8[64 * j] = w; } }
            if constexpr (MODE == 0 || MODE == 2) {
                f32x2 pa2[4];
#pragma unroll
                for (int e2 = 0; e2 < 4; ++e2) pa2[e2] = (f32x2){0.f, 0.f};
#pragma unroll
                for (int j = 0; j < 4; ++j)
#pragma unroll
                    for (int q = 0; q < 4; ++q) { const float vv = v[j][q]; const f32x2 v2 = {vv, vv};
#pragma unroll
                        for (int e2 = 0; e2 < 4; ++e2) pa2[e2] += v2 * (f32x2){w8[j][q][2 * e2], w8[j][q][2 * e2 + 1]}; }
                const float pa[8] = {pa2[0][0], pa2[0][1], pa2[1][0], pa2[1][1], pa2[2][0], pa2[2][1], pa2[3][0], pa2[3][1]};
                const float tot = reduce8(pa, F.lane);
                if constexpr (MODE == 0) { if (F.lane < 8) ((float*)(F.ws + WS_AB))[(size_t)m * 8 + F.lane] = tot; }
                else {
                    float pr[8];
#pragma unroll
                    for (int e = 0; e < 8; ++e) pr[e] = __builtin_bit_cast(float, __builtin_amdgcn_readlane(__builtin_bit_cast(int, tot), e)) * (1.0f / F8_SX);
                    float b1 = pr[0]; int e1 = 0;
#pragma unroll
                    for (int e = 1; e < 8; ++e) if (pr[e] > b1) { b1 = pr[e]; e1 = e; }
                    float b2 = -3.0e38f; int e2 = 0;
#pragma unroll
                    for (int e = 0; e < 8; ++e) if (e != e1 && pr[e] > b2) { b2 = pr[e]; e2 = e; }
                    const float g1 = 1.0f / (1.0f + __expf(b2 - b1));
                    if (F.lane == 0) { ((int*)(F.ws + WS_RE))[m] = e1 | (e2 << 4); ((float*)(F.ws + WS_RG))[m] = g1; __hip_atomic_fetch_add(&cnt[e1], 1, __ATOMIC_RELAXED, __HIP_MEMORY_SCOPE_WORKGROUP); __hip_atomic_fetch_add(&cnt[8 + e2], 1, __ATOMIC_RELAXED, __HIP_MEMORY_SCOPE_WORKGROUP); }
                }
            }
        }
        if constexpr (MODE == 2) { __syncthreads(); if (F.tid < 16) ((int*)(F.ws + WS_WGCNT))[p * 16 + F.tid] = cnt[F.tid]; __syncthreads(); }
    }
}

__device__ __forceinline__ void route_scatter(Frame& F) {
    LAS int* sh = (LAS int*)F.lds;
    const int* wgcnt = (const int*)(F.ws + WS_WGCNT);
    int* list = (int*)(F.ws + WS_LIST); float* gatel = (float*)(F.ws + WS_GATEL); int* grp = (int*)(F.ws + WS_GRP);
    const int* re = (const int*)(F.ws + WS_RE); const float* rg = (const float*)(F.ws + WS_RG);
    for (int p = F.vcu; p < M / 256; p += F.G) {
        __syncthreads();
        { const int g = F.tid & 15, part = F.tid >> 4; int tot = 0, pre = 0;
#pragma unroll
          for (int j = 0; j < 8; ++j) { const int q = part * 8 + j; const int c = wgcnt[q * 16 + g]; pre += (q < p) ? c : 0; tot += c; }
          sh[128 + part * 16 + g] = tot; sh[128 + 512 + part * 16 + g] = pre; }
        __syncthreads();
        if (F.tid < 16) { int tot = 0, pre = 0; for (int q = 0; q < 32; ++q) { tot += sh[128 + q * 16 + F.tid]; pre += sh[128 + 512 + q * 16 + F.tid]; } sh[F.tid] = tot; sh[16 + F.tid] = pre; }
        __syncthreads();
        if (F.tid == 0) { int b = 0; for (int g = 0; g < 16; ++g) { sh[32 + g] = b; b += (sh[g] + 255) & ~255; } sh[48] = b; }
        __syncthreads();
        if (p == 0) {
            if (F.tid <= 16) grp[F.tid] = sh[32 + F.tid];
            if (F.tid < 16) grp[17 + F.tid] = sh[F.tid];
            for (int g = 0; g < 16; ++g) { const int lo = sh[32 + g] + sh[g], hi = sh[32 + g + 1]; for (int q = lo + F.tid; q < hi; q += NWAVES * 64) { list[q] = -1; gatel[q] = 0.f; } }
        }
        int e1 = 0, e2 = 0; float g1 = 0.f; int r1 = 0, r2 = 0;
        if (F.tid < 256) {
            const int m = p * 256 + F.tid; const int ee = re[m]; e1 = ee & 15; e2 = ee >> 4; g1 = rg[m];
#pragma unroll
            for (int e = 0; e < 8; ++e) {
                const unsigned long long m1 = __ballot(e1 == e), m2 = __ballot(e2 == e); const unsigned long long lt = (1ull << F.lane) - 1ull;
                if (e1 == e) r1 = __popcll(m1 & lt); if (e2 == e) r2 = __popcll(m2 & lt);
                if (F.lane == 0) { sh[64 + F.wave * 16 + e] = __popcll(m1); sh[64 + F.wave * 16 + 8 + e] = __popcll(m2); }
            }
        }
        __syncthreads();
        if (F.tid < 256) {
            const int m = p * 256 + F.tid; int o1 = sh[32 + e1] + sh[16 + e1] + r1, o2 = sh[32 + 8 + e2] + sh[16 + 8 + e2] + r2;
            for (int w = 0; w < F.wave; ++w) { o1 += sh[64 + w * 16 + e1]; o2 += sh[64 + w * 16 + 8 + e2]; }
            list[o1] = m; gatel[o1] = g1; list[o2] = m; gatel[o2] = 1.0f - g1;
        }
    }
}

constexpr int CH = 16, NCH = T / CH;
constexpr int RW_BYTES = 60736;
static_assert(2 * RW_BYTES <= RING_BYTES, "rwkv lds");
constexpr int XA_PITCH = 528;

typedef short bf16x4 __attribute__((ext_vector_type(4)));
#define MFMA32(a, b, c) __builtin_amdgcn_mfma_f32_16x16x32_bf16(a, b, c, 0, 0, 0)
#define MFMA16(a, b, c) __builtin_amdgcn_mfma_f32_16x16x16bf16_1k(a, b, c, 0, 0, 0)
__device__ __forceinline__ unsigned cvt2(float a, float b) { const f32x2 v = {a, b}; const bf16v2_t r = __builtin_convertvector(v, bf16v2_t); return __builtin_bit_cast(unsigned, r); }
__device__ __forceinline__ bf16x4 pack4(float a, float b, float c, float d) { v2u w; w.x = cvt2(a, b); w.y = cvt2(c, d); return __builtin_bit_cast(bf16x4, w); }
__device__ __forceinline__ bf16x8 pack8(const f32x4 a, const f32x4 b) { v4u w; w.x = cvt2(a[0], a[1]); w.y = cvt2(a[2], a[3]); w.z = cvt2(b[0], b[1]); w.w = cvt2(b[2], b[3]); return __builtin_bit_cast(bf16x8, w); }
#define WAVE_LDS_FENCE() asm volatile("s_waitcnt lgkmcnt(0)" ::: "memory")
constexpr int G2_KI = 0, G2_QI = 17408, G2_KT = 34816, G2_VT = 53248, G2_GR = 71680, G2_BE = 71936, G2_GC = 72192, G2_NM = 72448, G2_TI = 76544, G2_O = 79104, G2_CW = G2_O + 64 * 528, G2_BYTES = G2_CW + 4 * 384 * 4;
constexpr int G2_IP = 272, G2_TP = 144, G2_TIP = 40, G2_OP = 132;
static_assert(G2_BYTES <= RING_BYTES, "gdn lds");
constexpr int GB = 64, NGB = T / GB;

__device__ __forceinline__ void gdn_unit2(Frame& F, const Args& A_, int layer, int u) {
    const int b = u >> 2, h = u & 3, tid = F.tid, lane = F.lane, w = F.wave, c = lane & 15, g = lane >> 4;
    LAS unsigned char* L = F.lds;
    LAS float* GR = (LAS float*)(L + G2_GR); LAS float* BE = (LAS float*)(L + G2_BE); LAS float* GC = (LAS float*)(L + G2_GC); LAS float* NM = (LAS float*)(L + G2_NM); LAS float* Om = (LAS float*)(L + G2_O);
    const bf16* PROJ = (const bf16*)(F.ws + WS_PROJ);
    bf16* OUT = (bf16*)(F.ws + WS_XN);
    const float* AB = (const float*)(F.ws + WS_AB);
    const int part = g, cg = c;
    const int colbase = (part == 0 ? C_GQ : (part == 1 ? C_GK : C_GV)) + h * 128 + 8 * cg;
    LAS float* CW = (LAS float*)(L + G2_CW);
    for (int idx = tid; idx < 4 * 384; idx += NWAVES * 64) { const int j = idx / 384, cc = idx % 384; CW[idx] = A_.in[15][(size_t)layer * 4 * 1536 + j * 1536 + (cc >> 7) * 512 + h * 128 + (cc & 127)]; }
    const int cwoff = (part < 3 ? part : 0) * 128 + 8 * cg;
    __syncthreads();
    const float nexpa = -__expf(A_.in[16][layer * 4 + h]), dtb = A_.in[17][layer * 4 + h];
    const int d0 = (8 * cg) & 31, pc0 = (8 * cg & ~31) + 8 * ((d0 >> 2) & 3) + 4 * (d0 >> 4);
    const int ptok = tid >> 3, pch = (tid & 7) * 16;
    f32x4 S[8];
#pragma unroll
    for (int m = 0; m < 8; ++m) S[m] = (f32x4){0.f, 0.f, 0.f, 0.f};
    v4u pre[11]; v4u zpre[2]; float abpre[2];
    auto prefetch = [&](int bt) {
        const int tb = bt * GB;
#pragma unroll
        for (int i = 0; i < 11; ++i) { const int tok = tb + 8 * w - 3 + i; pre[i] = (v4u){0u, 0u, 0u, 0u};
            if (part < 3 && tok >= 0) pre[i] = *(const GAS v4u*)(PROJ + (size_t)(b * T + tok) * NPROJ + colbase); }
        abpre[0] = 0.f; abpre[1] = 0.f;
        if (part == 3 && cg < 8) { const float* ab = AB + (size_t)(b * T + tb + 8 * w + cg) * 8; abpre[0] = ab[h]; abpre[1] = ab[4 + h]; }
    };
    prefetch(0);
    for (int bt = 0; bt < NGB; ++bt) {
        const int tb = bt * GB;
        if (!(PADF & 4)) {
            unsigned ktp[8][4];
            float xr[4][8];
#pragma unroll
            for (int i = 0; i < 3; ++i) { xr[i][0] = bf_lo(pre[i].x); xr[i][1] = bf_hi(pre[i].x); xr[i][2] = bf_lo(pre[i].y); xr[i][3] = bf_hi(pre[i].y); xr[i][4] = bf_lo(pre[i].z); xr[i][5] = bf_hi(pre[i].z); xr[i][6] = bf_lo(pre[i].w); xr[i][7] = bf_hi(pre[i].w); }
            float yprev[8];
#pragma unroll
            for (int tk = 0; tk < 8; ++tk) {
                const v4u pw = pre[tk + 3];
                xr[3][0] = bf_lo(pw.x); xr[3][1] = bf_hi(pw.x); xr[3][2] = bf_lo(pw.y); xr[3][3] = bf_hi(pw.y); xr[3][4] = bf_lo(pw.z); xr[3][5] = bf_hi(pw.z); xr[3][6] = bf_lo(pw.w); xr[3][7] = bf_hi(pw.w);
                float y[8]; float ss = 0.f;
#pragma unroll
                for (int e = 0; e < 8; ++e) y[e] = 0.f;
#pragma unroll
                for (int j = 0; j < 4; ++j) { const f32x4 wa = *(const LAS f32x4*)(CW + j * 384 + cwoff), wb = *(const LAS f32x4*)(CW + j * 384 + cwoff + 4);
#pragma unroll
                    for (int e = 0; e < 4; ++e) { y[e] += wa[e] * xr[j][e]; y[4 + e] += wb[e] * xr[j][4 + e]; } }
#pragma unroll
                for (int e = 0; e < 8; ++e) { const float a = y[e]; y[e] = a * sigmoidf_(a); ss += y[e] * y[e]; }
                ss = sum16(ss);
                const float sc = part == 2 ? 1.0f : (__builtin_amdgcn_rsqf(ss + 1e-6f)) * (part == 0 ? 0.08838834764831845f : 1.0f);
#pragma unroll
                for (int e = 0; e < 8; ++e) y[e] *= sc;
                const int trow = 8 * w + tk;
                if (part < 2) { LAS unsigned char* img = L + (part == 0 ? G2_QI : G2_KI) + trow * G2_IP;
                    v2u a0; a0.x = pg8::cvt_pk_bf16(y[0], y[1]); a0.y = pg8::cvt_pk_bf16(y[2], y[3]); v2u a1; a1.x = pg8::cvt_pk_bf16(y[4], y[5]); a1.y = pg8::cvt_pk_bf16(y[6], y[7]);
                    *(LAS v2u*)(img + pc0 * 2) = a0; *(LAS v2u*)(img + (pc0 + 8) * 2) = a1; }
                if (tk & 1) {
#pragma unroll
                    for (int e = 0; e < 8; ++e) ktp[e][tk >> 1] = pg8::cvt_pk_bf16(yprev[e], y[e]); }
#pragma unroll
                for (int e = 0; e < 8; ++e) yprev[e] = y[e];
#pragma unroll
                for (int e = 0; e < 8; ++e) { xr[0][e] = xr[1][e]; xr[1][e] = xr[2][e]; xr[2][e] = xr[3][e]; }
            }
            if (part == 1 || part == 2) { LAS unsigned char* timg = L + (part == 1 ? G2_KT : G2_VT);
#pragma unroll
                for (int e = 0; e < 8; ++e) { v4u o; o.x = ktp[e][0]; o.y = ktp[e][1]; o.z = ktp[e][2]; o.w = ktp[e][3]; *(LAS v4u*)(timg + (8 * cg + e) * G2_TP + (8 * w) * 2) = o; } }
            if (part == 3 && cg < 8) { GR[8 * w + cg] = nexpa * softplusf_(abpre[0] + dtb); BE[8 * w + cg] = sigmoidf_(abpre[1]); }
        }
        __syncthreads();
        if (bt + 1 < NGB) prefetch(bt + 1);
        { const bf16* zp = PROJ + (size_t)(b * T + tb + ptok) * NPROJ + C_Z + h * 128 + pch; zpre[0] = *(const GAS v4u*)zp; zpre[1] = *(const GAS v4u*)(zp + 8); }
        if (w < 4 && !(PADF & 8)) {
            const int i = w;
            float gv = GR[16 * i + c];
#pragma unroll
            for (int o = 1; o < 16; o <<= 1) { const float t_ = __shfl_up(gv, o, 16); if (c >= o) gv += t_; }
            if (g == 0) GC[16 * i + c] = gv;
            f32x4 acc = (f32x4){0.f, 0.f, 0.f, 0.f};
            const LAS unsigned char* rowK = L + G2_KI + (16 * i + c) * G2_IP + g * 16;
#pragma unroll
            for (int s = 0; s < 4; ++s) { const bf16x8 f = *(const LAS bf16x8*)(rowK + 64 * s); acc = MFMA32(f, f, acc); }
            WAVE_LDS_FENCE();
            const f32x4 gct = *(const LAS f32x4*)(GC + 16 * i + 4 * g), bet = *(const LAS f32x4*)(BE + 16 * i + 4 * g);
#pragma unroll
            for (int r = 0; r < 4; ++r) { const int t_ = 4 * g + r; NM[i * 256 + t_ * 16 + c] = (c < t_) ? -bet[r] * acc[r] * __expf(fminf(gct[r] - gv, 0.f)) : 0.f; }
            WAVE_LDS_FENCE();
            float Tc[16];
#pragma unroll
            for (int t_ = 0; t_ < 16; ++t_) { float a = (t_ == c) ? 1.f : 0.f;
#pragma unroll
                for (int q4 = 0; q4 * 4 < t_; ++q4) { const f32x4 n4 = *(const LAS f32x4*)(NM + i * 256 + t_ * 16 + 4 * q4);
#pragma unroll
                    for (int e = 0; e < 4; ++e) if (4 * q4 + e < t_) a += n4[e] * Tc[4 * q4 + e]; }
                Tc[t_] = a; }
            if (g == 0) {
#pragma unroll
                for (int t_ = 0; t_ < 16; ++t_) *(LAS bf16*)(L + G2_TI + i * (16 * G2_TIP) + t_ * G2_TIP + c * 2) = (bf16)f2bf(Tc[t_]); }
        }
        __syncthreads();
#pragma unroll 1
        for (int i = (PADF & 16) ? 4 : 0; i < 4; ++i) {
            const LAS unsigned char* rowK = L + G2_KI + (16 * i + c) * G2_IP + g * 16; const LAS unsigned char* rowQ = L + G2_QI + (16 * i + c) * G2_IP + g * 16;
            bf16x8 kf[4], qf[4];
#pragma unroll
            for (int s = 0; s < 4; ++s) { kf[s] = *(const LAS bf16x8*)(rowK + 64 * s); qf[s] = *(const LAS bf16x8*)(rowQ + 64 * s); }
            const float gcc = GC[16 * i + c], gl = GC[16 * i + 15];
            const f32x4 gcr = *(const LAS f32x4*)(GC + 16 * i + 4 * g), ber = *(const LAS f32x4*)(BE + 16 * i + 4 * g);
            const v2u vw = *(const LAS v2u*)(L + G2_VT + (16 * w + c) * G2_TP + (16 * i + 4 * g) * 2);
            const bf16x4 tf = *(const LAS bf16x4*)(L + G2_TI + i * (16 * G2_TIP) + c * G2_TIP + g * 8);
            f32x4 dq = (f32x4){0.f, 0.f, 0.f, 0.f};
#pragma unroll
            for (int s = 0; s < 4; ++s) dq = MFMA32(kf[s], qf[s], dq);
            bf16x8 Sb[4];
#pragma unroll
            for (int s = 0; s < 4; ++s) Sb[s] = pack8(S[2 * s], S[2 * s + 1]);
            f32x4 y = (f32x4){0.f, 0.f, 0.f, 0.f}, qs = y;
#pragma unroll
            for (int s = 0; s < 4; ++s) y = MFMA32(kf[s], Sb[s], y);
#pragma unroll
            for (int s = 0; s < 4; ++s) qs = MFMA32(qf[s], Sb[s], qs);
            float qa[4], egr[4], xv[4];
            const float vv[4] = {bf_lo(vw.x), bf_hi(vw.x), bf_lo(vw.y), bf_hi(vw.y)};
#pragma unroll
            for (int r = 0; r < 4; ++r) { qa[r] = (4 * g + r <= c) ? dq[r] * __expf(fminf(gcc - gcr[r], 0.f)) : 0.f; egr[r] = __expf(gcr[r]); xv[r] = ber[r] * (vv[r] - egr[r] * y[r]); qs[r] *= egr[r]; }
            const f32x4 vn = MFMA16(tf, pack4(xv[0], xv[1], xv[2], xv[3]), ((f32x4){0.f, 0.f, 0.f, 0.f}));
            const f32x4 o = MFMA16(pack4(qa[0], qa[1], qa[2], qa[3]), pack4(vn[0], vn[1], vn[2], vn[3]), qs);
#pragma unroll
            for (int r = 0; r < 4; ++r) Om[(16 * i + 4 * g + r) * G2_OP + 16 * w + c] = o[r];
            const float egl = __expf(gl);
            const bf16x4 vsb = pack4(vn[0] * __expf(gl - gcr[0]), vn[1] * __expf(gl - gcr[1]), vn[2] * __expf(gl - gcr[2]), vn[3] * __expf(gl - gcr[3]));
#pragma unroll
            for (int m = 0; m < 8; ++m) { const bf16x4 kt = *(const LAS bf16x4*)(L + G2_KT + (16 * m + c) * G2_TP + (16 * i + 4 * g) * 2); S[m] = MFMA16(kt, vsb, S[m] * egl); }
        }
        __syncthreads();
        if (!(PADF & 32)) {
            f32x4 o4[4]; float ss = 0.f;
#pragma unroll
            for (int q = 0; q < 4; ++q) { o4[q] = *(const LAS f32x4*)(Om + ptok * G2_OP + pch + 4 * q); ss += (o4[q][0] * o4[q][0] + o4[q][1] * o4[q][1]) + (o4[q][2] * o4[q][2] + o4[q][3] * o4[q][3]); }
            ss = sum8(ss);
            const float rs = __builtin_amdgcn_rsqf(ss * (1.f / 128.f) + 1e-6f);
            const float* gp = A_.in[18] + layer * 128 + pch;
            const unsigned zz[8] = {zpre[0].x, zpre[0].y, zpre[0].z, zpre[0].w, zpre[1].x, zpre[1].y, zpre[1].z, zpre[1].w};
            unsigned ow[8];
#pragma unroll
            for (int q = 0; q < 4; ++q) { const f32x4 gq = *(const f32x4*)(gp + 4 * q);
                const float za = bf_lo(zz[2 * q]), zb = bf_hi(zz[2 * q]), zc = bf_lo(zz[2 * q + 1]), zd = bf_hi(zz[2 * q + 1]);
                ow[2 * q] = pk2(o4[q][0] * rs * gq[0] * za * sigmoidf_(za), o4[q][1] * rs * gq[1] * zb * sigmoidf_(zb));
                ow[2 * q + 1] = pk2(o4[q][2] * rs * gq[2] * zc * sigmoidf_(zc), o4[q][3] * rs * gq[3] * zd * sigmoidf_(zd)); }
            bf16* op = OUT + (size_t)(b * T + tb + ptok) * D + 512 + h * 128 + pch;
            *(GAS v4u*)op = (v4u){ow[0], ow[1], ow[2], ow[3]}; *(GAS v4u*)(op + 8) = (v4u){ow[4], ow[5], ow[6], ow[7]};
        }
    }
    __syncthreads();
}

constexpr int R2_AI = 0, R2_BI = 2304, R2_KI = 4608, R2_RI = 6912, R2_VI = 9216, R2_W15 = 16896;
constexpr int R2_IP = 144, R2_TP = 40;
constexpr int R3_XA = 0, R3_R = 8448, R3_KM = 12544, R3_V = 16640, R3_LW = 20736, R3_AV = 24832, R3_G = 28928, R3_O = 33024, R3_BON = 37120, R3_MU = 37184, R3_IMG = 38976;
static_assert(R3_IMG + R2_W15 + 256 <= RW_BYTES && R3_R + 32768 <= RW_BYTES, "rwkv lds map");
__device__ __forceinline__ float fast_tanh(float x) { const float e = __expf(2.0f * x); return 1.0f - 2.0f * __builtin_amdgcn_rcpf(e + 1.0f); }
__device__ __forceinline__ float fast_softplus(float x) { return x > 20.f ? x : __logf(1.0f + __expf(x)); }
__device__ __forceinline__ bf16x4 pack4v(const f32x4 v) { return pack4(v[0], v[1], v[2], v[3]); }

__device__ __forceinline__ void rwkv_pair2(Frame& F, const Args& A_, int layer, int pairidx) {
    const int half = F.wave >> 2, wq = F.wave & 3, ht = F.tid & 255, lane = F.lane, c = lane & 15, g = lane >> 4;
    const int h = 2 * (pairidx & 3) + half, b = pairidx >> 2;
    LAS unsigned char* L = F.lds + half * RW_BYTES;
    LAS float* Rm = (LAS float*)(L + R3_R); LAS float* KM = (LAS float*)(L + R3_KM); LAS float* Vm = (LAS float*)(L + R3_V); LAS float* LW = (LAS float*)(L + R3_LW);
    LAS float* AV = (LAS float*)(L + R3_AV); LAS float* Gm = (LAS float*)(L + R3_G);
    LAS float* Om = (LAS float*)(L + R3_O); LAS float* BON = (LAS float*)(L + R3_BON); LAS float* MU = (LAS float*)(L + R3_MU);
    LAS unsigned char* IM = L + R3_IMG;
    const bf16* PROJ = (const bf16*)(F.ws + WS_PROJ);
    bf16* OUT = (bf16*)(F.ws + WS_XN);
    const int jc = 16 * wq + c, kg = g, hj = h * 64 + jc;
    bf16x8 bd[2], bi[2], bg[4];
    {
        const float* Wd = A_.in[5] + (size_t)layer * 64 * 512 + h * 64; const float* Wi = A_.in[7] + (size_t)layer * 64 * 512 + h * 64; const float* Wg = A_.in[8] + (size_t)layer * 128 * 512 + h * 64;
        LAS bf16* WT = (LAS bf16*)(L + R3_R);
#pragma unroll 1
        for (int idx = ht; idx < 4096; idx += 256) { const int k = idx >> 6, j = idx & 63; WT[j * 64 + k] = (bf16)f2bf(Wd[(size_t)k * 512 + j]); WT[4096 + j * 64 + k] = (bf16)f2bf(Wi[(size_t)k * 512 + j]); }
#pragma unroll 1
        for (int idx = ht; idx < 8192; idx += 256) { const int k = idx >> 6, j = idx & 63; WT[8192 + j * 128 + k] = (bf16)f2bf(Wg[(size_t)k * 512 + j]); }
        __syncthreads();
#pragma unroll
        for (int s = 0; s < 2; ++s) { bd[s] = *(const LAS bf16x8*)(WT + jc * 64 + 32 * s + 8 * kg); bi[s] = *(const LAS bf16x8*)(WT + 4096 + jc * 64 + 32 * s + 8 * kg); }
#pragma unroll
        for (int s = 0; s < 4; ++s) bg[s] = *(const LAS bf16x8*)(WT + 8192 + jc * 128 + 32 * s + 8 * kg);
        __syncthreads();
    }
    const float w0c = A_.in[4][layer * 512 + hj], a0c = A_.in[6][layer * 512 + hj];
    const int tid = F.tid;
    const int atok = tid >> 5, apc = tid & 31;
    int bun[2], btok[2], bpc[2]; bool bval[2];
#pragma unroll
    for (int j = 0; j < 2; ++j) { const int idx = tid + 512 * j; bval[j] = idx < 768; const int ii = bval[j] ? idx : 0; bun[j] = ii / 384; const int rem = ii - 384 * bun[j]; btok[j] = rem / 24; bpc[j] = rem - 24 * btok[j]; }
    f32x4 amu[2], bmu[2][2];
    { const float* mup = A_.in[3] + layer * 1792;
      amu[0] = *(const f32x4*)(mup + C_WL + 8 * apc); amu[1] = *(const f32x4*)(mup + C_WL + 8 * apc + 4);
#pragma unroll
      for (int j = 0; j < 2; ++j) { const int hh = 2 * (pairidx & 3) + bun[j]; const int col = (bpc[j] < 8 ? C_R : (bpc[j] < 16 ? C_K : C_V)) + hh * 64 + 8 * (bpc[j] & 7);
          bmu[j][0] = *(const f32x4*)(mup + col); bmu[j][1] = *(const f32x4*)(mup + col + 4); } }
    const bool a_th = apc < 8, a_id = apc >= 8 && apc < 16;
    constexpr size_t CHB = (size_t)CH * NPROJ * 2;
    const size_t aoff = ((size_t)(b * T + atok) * NPROJ + C_WL + 8 * apc) * 2;
    size_t boff[2]; unsigned bdst[2];
#pragma unroll
    for (int j = 0; j < 2; ++j) { const int hh = 2 * (pairidx & 3) + bun[j]; const int col = (bpc[j] < 8 ? C_R : (bpc[j] < 16 ? C_K : C_V)) + hh * 64 + 8 * (bpc[j] & 7);
        boff[j] = ((size_t)(b * T + btok[j]) * NPROJ + col) * 2;
        bdst[j] = (unsigned)(bun[j] * RW_BYTES + (bpc[j] < 8 ? R3_R : (bpc[j] < 16 ? R3_KM : R3_V)) + (btok[j] * 64 + 8 * (bpc[j] & 7)) * 4); }
    const unsigned adst = (unsigned)(R3_XA + atok * XA_PITCH + apc * 16);
    const int tt = ht >> 4, jq = (ht & 15) * 4;
    const f32x4 kkv = *(const f32x4*)(A_.in[9] + layer * 512 + h * 64 + jq), kav = *(const f32x4*)(A_.in[10] + layer * 512 + h * 64 + jq), rkv = *(const f32x4*)(A_.in[11] + layer * 512 + h * 64 + jq);
    const f32x4 lgv = *(const f32x4*)(A_.in[12] + layer * 512 + h * 64 + jq), lbv = *(const f32x4*)(A_.in[13] + layer * 512 + h * 64 + jq);
    const int pimg = (jq & ~31) + 8 * (((jq & 31) >> 2) & 3) + 4 * ((jq & 31) >> 4);
    bf16x4 ltri;
#pragma unroll
    for (int j = 0; j < 4; ++j) ltri[j] = (4 * g + j <= c) ? (short)0x3F80 : (short)0;
    f32x4 P[4];
#pragma unroll
    for (int m = 0; m < 4; ++m) P[m] = (f32x4){0.f, 0.f, 0.f, 0.f};
    struct PF { v4u acur, aprv, bcur[2], bprv[2]; };
    PF pf0, pf1;
    auto prefetch = [&](int ch, PF& q_) {
        const char* base = (const char*)PROJ + (size_t)ch * CHB;
        { const bool first = (ch == 0 && atok == 0); const char* p = base + aoff; q_.acur = *(const GAS v4u*)p; q_.aprv = *(const GAS v4u*)(first ? p : p - NPROJ * 2); }
#pragma unroll
        for (int j = 0; j < 2; ++j) { const bool first = (ch == 0 && btok[j] == 0); const char* p = base + boff[j]; q_.bcur[j] = *(const GAS v4u*)p; q_.bprv[j] = *(const GAS v4u*)(first ? p : p - NPROJ * 2); }
    };
    prefetch(0, pf0); prefetch(1, pf1);
    auto do_chunk = [&](const int ch, PF& q_) __attribute__((always_inline)) {
        const int t0 = ch * CH;
        v4u acur = q_.acur, aprv = q_.aprv, bcur[2] = {q_.bcur[0], q_.bcur[1]}, bprv[2] = {q_.bprv[0], q_.bprv[1]};
        if (ch == 0) {
            if (atok == 0) aprv = (v4u){0u, 0u, 0u, 0u};
#pragma unroll
            for (int j = 0; j < 2; ++j) if (btok[j] == 0) bprv[j] = (v4u){0u, 0u, 0u, 0u};
        }
        if (!(PADF & 64)) {
#define RW_UNPACK(W_, X_) const float X_[8] = {bf_lo((W_)[0]), bf_hi((W_)[0]), bf_lo((W_)[1]), bf_hi((W_)[1]), bf_lo((W_)[2]), bf_hi((W_)[2]), bf_lo((W_)[3]), bf_hi((W_)[3])}
            { RW_UNPACK(acur, xc); RW_UNPACK(aprv, xp);
              const float be = a_th ? 2.f : 1.f, ga = a_th ? -1.f : 0.f;
              float y[8];
#pragma unroll
              for (int e = 0; e < 8; ++e) { const float val = xc[e] + (xp[e] - xc[e]) * (e < 4 ? amu[0][e] : amu[1][e - 4]); const float sg = __builtin_amdgcn_rcpf(1.0f + __expf(-be * val)); y[e] = a_id ? val : be * sg + ga; }
              v4u o; o.x = pk2(y[0], y[1]); o.y = pk2(y[2], y[3]); o.z = pk2(y[4], y[5]); o.w = pk2(y[6], y[7]);
              *(LAS v4u*)(F.lds + adst) = o; }
#pragma unroll
            for (int j = 0; j < 2; ++j) if (bval[j]) { RW_UNPACK(bcur[j], xc); RW_UNPACK(bprv[j], xp);
                float val[8];
#pragma unroll
                for (int e = 0; e < 8; ++e) val[e] = xc[e] + (xp[e] - xc[e]) * (e < 4 ? bmu[j][0][e] : bmu[j][1][e - 4]);
                LAS float* dst = (LAS float*)(F.lds + bdst[j]);
                *(LAS f32x4*)dst = (f32x4){val[0], val[1], val[2], val[3]}; *(LAS f32x4*)(dst + 4) = (f32x4){val[4], val[5], val[6], val[7]}; }
#undef RW_UNPACK
        }
        if (ch + 2 < NCH) prefetch(ch + 2, q_);
        __syncthreads();
        if (!(PADF & 128)) {
            f32x4 ad = (f32x4){0.f, 0.f, 0.f, 0.f}, aa = ad, ag = ad;
            const LAS unsigned char* xa = F.lds + R3_XA + c * XA_PITCH + kg * 16;
#pragma unroll
            for (int s = 0; s < 2; ++s) ad = MFMA32(*(const LAS bf16x8*)(xa + s * 64), bd[s], ad);
#pragma unroll
            for (int s = 0; s < 2; ++s) aa = MFMA32(*(const LAS bf16x8*)(xa + 128 + s * 64), bi[s], aa);
#pragma unroll
            for (int s = 0; s < 4; ++s) ag = MFMA32(*(const LAS bf16x8*)(xa + 256 + s * 64), bg[s], ag);
            f32x4 lwv;
#pragma unroll
            for (int r = 0; r < 4; ++r) { const int t = 4 * kg + r;
                lwv[r] = -0.60653065971f * sigmoidf_(w0c + ad[r]);
                AV[t * 64 + jc] = sigmoidf_(a0c + aa[r]); Gm[t * 64 + jc] = ag[r]; }
            { const bf16x4 hi = pack4v(lwv); const v2u hw = __builtin_bit_cast(v2u, hi);
              const f32x4 lo = lwv - (f32x4){bf_lo(hw.x), bf_hi(hw.x), bf_lo(hw.y), bf_hi(hw.y)};
              f32x4 cs = MFMA16(ltri, hi, ((f32x4){0.f, 0.f, 0.f, 0.f})); cs = MFMA16(ltri, pack4v(lo), cs);
#pragma unroll
              for (int r = 0; r < 4; ++r) LW[(4 * kg + r) * 64 + jc] = cs[r]; }
        }
        __syncthreads();
        if (!(PADF & 256)) {
            const f32x4 k4 = *(const LAS f32x4*)(KM + tt * 64 + jq), a4 = *(const LAS f32x4*)(AV + tt * 64 + jq), r4 = *(const LAS f32x4*)(Rm + tt * 64 + jq), v4 = *(const LAS f32x4*)(Vm + tt * 64 + jq);
            const f32x4 cl = *(const LAS f32x4*)(LW + tt * 64 + jq);
            f32x4 clp = *(const LAS f32x4*)(LW + (tt > 0 ? tt - 1 : 0) * 64 + jq); if (tt == 0) clp = (f32x4){0.f, 0.f, 0.f, 0.f};
            const f32x4 kr = k4 * kkv; float ss = (kr[0] * kr[0] + kr[1] * kr[1]) + (kr[2] * kr[2] + kr[3] * kr[3]);
            ss = sum16(ss);
            const float inv = __builtin_amdgcn_rsqf(ss + 1e-6f);
            const f32x4 kk = kr * inv; const f32x4 km = k4 * (1.0f + (a4 - 1.0f) * kav);
            float bo = (r4[0] * km[0] * rkv[0] + r4[1] * km[1] * rkv[1]) + (r4[2] * km[2] * rkv[2] + r4[3] * km[3] * rkv[3]);
            bo = sum16(bo);
            if ((ht & 15) == 0) BON[tt] = bo;
            f32x4 wt, wi, wp;
#pragma unroll
            for (int e = 0; e < 4; ++e) { wt[e] = __expf(cl[e]); wi[e] = __expf(-cl[e]); wp[e] = __expf(clp[e]); }
            const f32x4 at = -kk * wp, bt = kk * a4 * wi, kt = km * wi, rt = r4 * wt;
            LAS unsigned char* irow = IM + tt * R2_IP + pimg * 2;
            { v2u w; w.x = pk2(at[0], at[1]); w.y = pk2(at[2], at[3]); *(LAS v2u*)(irow + R2_AI) = w; }
            { v2u w; w.x = pk2(bt[0], bt[1]); w.y = pk2(bt[2], bt[3]); *(LAS v2u*)(irow + R2_BI) = w; }
            { v2u w; w.x = pk2(kt[0], kt[1]); w.y = pk2(kt[2], kt[3]); *(LAS v2u*)(irow + R2_KI) = w; }
            { v2u w; w.x = pk2(rt[0], rt[1]); w.y = pk2(rt[2], rt[3]); *(LAS v2u*)(irow + R2_RI) = w; }
            { v2u w; w.x = pk2(v4[0], v4[1]); w.y = pk2(v4[2], v4[3]); *(LAS v2u*)(IM + R2_VI + tt * R2_IP + jq * 2) = w; }
            if (tt == 15) *(LAS f32x4*)(IM + R2_W15 + jq * 4) = wt;
        }
        __syncthreads();
        if (!(PADF & 512)) {
            bf16x8 af[2], bf_[2], kf[2], rf[2];
#pragma unroll
            for (int s = 0; s < 2; ++s) { const LAS unsigned char* p = IM + c * R2_IP + 64 * s + 16 * g;
                af[s] = *(const LAS bf16x8*)(p + R2_AI); bf_[s] = *(const LAS bf16x8*)(p + R2_BI); kf[s] = *(const LAS bf16x8*)(p + R2_KI); rf[s] = *(const LAS bf16x8*)(p + R2_RI); }
            const unsigned trb = (unsigned)(size_t)IM + (unsigned)((4 * g + ((lane >> 2) & 3)) * R2_IP + 16 * (lane & 3));
            const unsigned trv = (unsigned)(size_t)IM + (unsigned)(R2_VI + (4 * g + ((lane >> 2) & 3)) * R2_IP + 8 * (lane & 3) + 32 * wq);
            bf16x4 vt, btm[4], ktm[4];
            asm volatile("ds_read_b64_tr_b16 %0, %9\n\tds_read_b64_tr_b16 %1, %10 offset:%11\n\tds_read_b64_tr_b16 %2, %10 offset:%12\n\tds_read_b64_tr_b16 %3, %10 offset:%13\n\tds_read_b64_tr_b16 %4, %10 offset:%14\n\t"
                         "ds_read_b64_tr_b16 %5, %10 offset:%15\n\tds_read_b64_tr_b16 %6, %10 offset:%16\n\tds_read_b64_tr_b16 %7, %10 offset:%17\n\tds_read_b64_tr_b16 %8, %10 offset:%18\n\ts_waitcnt lgkmcnt(0)"
                         : "=&v"(vt), "=&v"(btm[0]), "=&v"(btm[1]), "=&v"(btm[2]), "=&v"(btm[3]), "=&v"(ktm[0]), "=&v"(ktm[1]), "=&v"(ktm[2]), "=&v"(ktm[3])
                         : "v"(trv), "v"(trb), "i"(R2_BI + 0), "i"(R2_BI + 8), "i"(R2_BI + 64), "i"(R2_BI + 72), "i"(R2_KI + 0), "i"(R2_KI + 8), "i"(R2_KI + 64), "i"(R2_KI + 72) : "memory");
            __builtin_amdgcn_sched_barrier(0);
            const f32x4 zero = (f32x4){0.f, 0.f, 0.f, 0.f};
            f32x4 X0 = zero, Y0 = zero, Dka = zero, Dbr = zero, Dkr = zero;
#pragma unroll
            for (int s = 0; s < 2; ++s) { X0 = MFMA32(af[s], bf_[s], X0); Y0 = MFMA32(bf_[s], af[s], Y0); Dka = MFMA32(kf[s], af[s], Dka); Dbr = MFMA32(bf_[s], rf[s], Dbr); Dkr = MFMA32(kf[s], rf[s], Dkr); }
            f32x4 idn;
#pragma unroll
            for (int r = 0; r < 4; ++r) { const int row = 4 * g + r; idn[r] = (row == c) ? 1.f : 0.f;
                X0[r] = (c < row) ? X0[r] : 0.f;
                Y0[r] = (row < c) ? Y0[r] : 0.f;
                Dka[r] = (row < c) ? Dka[r] : 0.f;
                Dbr[r] = (row <= c) ? Dbr[r] : 0.f; Dkr[r] = (row <= c) ? Dkr[r] : 0.f; }
            const bf16x4 x0b = pack4v(X0), y0b = pack4v(Y0);
            const f32x4 X1 = MFMA16(y0b, x0b, zero), Y1 = MFMA16(x0b, y0b, zero);
            const bf16x4 x1b = pack4v(X1), y1b = pack4v(Y1);
            const f32x4 X2 = MFMA16(y1b, x1b, zero), Y2 = MFMA16(x1b, y1b, zero);
            const bf16x4 x2b = pack4v(X2), y2b = pack4v(Y2);
            const f32x4 X3 = MFMA16(y2b, x2b, zero);
            f32x4 U = Y0 + idn;
            U = MFMA16(pack4v(X1 + idn), pack4v(U), zero);
            U = MFMA16(pack4v(X2 + idn), pack4v(U), zero);
            U = MFMA16(pack4v(X3 + idn), pack4v(U), zero);
            bf16x8 Pb[2];
#pragma unroll
            for (int s = 0; s < 2; ++s) Pb[s] = pack8(P[2 * s], P[2 * s + 1]);
            f32x4 X = zero, O = zero;
#pragma unroll
            for (int s = 0; s < 2; ++s) { X = MFMA32(af[s], Pb[s], X); O = MFMA32(rf[s], Pb[s], O); }
            X = MFMA16(pack4v(Dka), vt, X);
            const f32x4 Z = MFMA16(pack4v(U), pack4v(X), zero);
            const bf16x4 zb = pack4v(Z);
            O = MFMA16(pack4v(Dbr), zb, O);
            O = MFMA16(pack4v(Dkr), vt, O);
#pragma unroll
            for (int r = 0; r < 4; ++r) Om[(4 * g + r) * 64 + 16 * wq + c] = O[r];
#pragma unroll
            for (int m = 0; m < 4; ++m) {
                const f32x4 w15 = *(const LAS f32x4*)(IM + R2_W15 + (16 * m + 4 * g) * 4);
                f32x4 pm = MFMA16(btm[m], zb, P[m]); pm = MFMA16(ktm[m], vt, pm); P[m] = pm * w15; }
        }
        __syncthreads();
        if (!(PADF & 1024)) {
            const f32x4 o4 = *(const LAS f32x4*)(Om + tt * 64 + jq);
            float s1 = sum16((o4[0] + o4[1]) + (o4[2] + o4[3]));
            const float mean = s1 * (1.f / 64.f); const f32x4 d4 = o4 - mean;
            float s2 = sum16((d4[0] * d4[0] + d4[1] * d4[1]) + (d4[2] * d4[2] + d4[3] * d4[3]));
            const float rs = __builtin_amdgcn_rsqf(s2 * (1.f / 64.f) + 64e-5f);
            f32x4 v4;
            { const v2u vw = *(const LAS v2u*)(IM + R2_VI + tt * R2_IP + jq * 2); v4 = (f32x4){bf_lo(vw.x), bf_hi(vw.x), bf_lo(vw.y), bf_hi(vw.y)}; }
            const f32x4 g4 = *(const LAS f32x4*)(Gm + tt * 64 + jq);
            const f32x4 y = ((d4 * rs) * lgv + lbv + v4 * BON[tt]) * g4;
            v2u w; w.x = pk2(y[0], y[1]); w.y = pk2(y[2], y[3]);
            *(GAS v2u*)(OUT + (size_t)(b * T + t0 + tt) * D + h * 64 + jq) = w;
        }
    };
    for (int ch = 0; ch < NCH; ch += 2) { do_chunk(ch, pf0); do_chunk(ch + 1, pf1); }
    __syncthreads();
}

constexpr int NPHASE = 19;
#ifndef PH_ONLY
#define PH_ONLY -1
#endif
#define PROBE_SCAN 0
#ifndef SCAN_SEL
#define SCAN_SEL 0
#endif
#define PH_ON(k) (PH_ONLY < 0 || PH_ONLY == (k))

template <int LAYER>
__device__ __forceinline__ void layer_phases(Frame& F, const Args& A_, const XcdBarrier& bar, const int lo, const int hi) {
#define IN(k) (PH_ON(k) && lo <= (k) && (k) < hi)
#define SEAM(k) do { if (lo <= (k) && (k) + 1 < hi) xcd_barrier(bar); } while (0)
    bf16* XN = (bf16*)(F.ws + WS_XN); bf16* PROJ = (bf16*)(F.ws + WS_PROJ);
    const int gw = F.vcu * NWAVES + F.wave, NGW = F.G * NWAVES;
    constexpr int pb = 1 + LAYER * 8;
    unsigned char* wmix = LAYER == 0 ? F.ws + WS_WS : F.ws + WS_W1;
    const float* xres = LAYER == 0 ? A_.in[0] : F.out;
    if (IN(pb)) {
        pg8::Gemm g{XN, (const bf16*)(wmix + MW_IN), D, D, D, nullptr}; pg8::StaticOrder S; S.init(M / 256, NPROJ / 256, F.G, (int)blockIdx.x);
        pg8::EpiBf16Plain E{PROJ, NPROJ};
        pg8::gemm_phase<pg8::EpiBf16Plain, pg8::StaticOrder, true, true, false>(F.lds, g, S, E);
    }
    SEAM(pb);
    if (IN(pb + 1)) {
        { const int job = F.vcu; if (job < 128) { if (SCAN_SEL != 2 && !(PADF & 2)) gdn_unit2(F, A_, LAYER, job); } else if (job < 256) { if (SCAN_SEL != 1 && !(PADF & 1)) rwkv_pair2(F, A_, LAYER, job - 128); } }
        if (F.vcu < 128 && !PADF) {
            __syncthreads();
            LAS float* scr = (LAS float*)(F.lds + F.wave * 16384);
            const int cw = F.vcu * NWAVES + F.wave, NCW = 128 * NWAVES;
            if constexpr (LAYER == 0) {
                for (int it = cw; it < MIXER_ITEMS + FFN_ITEMS; it += NCW) {
                    if (it < MIXER_ITEMS) conv_mixer_item(F, A_, 1, F.ws + WS_W1, it, scr);
                    else conv_ffn_item(F, A_.in[22], A_.in[23], A_.in[24], (bf16*)(F.ws + WS_WS + FW_GU), (bf16*)(F.ws + WS_WS + FW_DN), it - MIXER_ITEMS, scr); }
                for (int it = cw; it < NE_EARLY * FFN_ITEMS8; it += NCW) { const int e = it / FFN_ITEMS8, r = it % FFN_ITEMS8;
                    conv_ffn_item_f8(F, A_.in[26] + (size_t)e * D * FF, A_.in[27] + (size_t)e * D * FF, A_.in[28] + (size_t)e * FF * D,
                                     F.ws + WS_WS + EW_GU + (size_t)e * NGU * D, F.ws + WS_WS + EW_DN + (size_t)e * D * FF, r); }
            } else {
                for (int it = cw + NE_EARLY * FFN_ITEMS8; it < NE * FFN_ITEMS8; it += NCW) { const int e = it / FFN_ITEMS8, r = it % FFN_ITEMS8;
                    conv_ffn_item_f8(F, A_.in[26] + (size_t)e * D * FF, A_.in[27] + (size_t)e * D * FF, A_.in[28] + (size_t)e * FF * D,
                                     F.ws + WS_WS + EW_GU + (size_t)e * NGU * D, F.ws + WS_WS + EW_DN + (size_t)e * D * FF, r); }
            }
        }
    }
    SEAM(pb + 1);
    if (IN(pb + 2)) {
        pg8::StaticOrder S; S.init(M / 256, D / 256, F.G, (int)blockIdx.x);
        { pg8::Gemm g{XN, (const bf16*)(wmix + MW_PA), D, 512, 512, nullptr}; pg8::EpiMerge<true> E{PROJ, PROJ + C_GA, NPROJ};
          pg8::gemm_phase<pg8::EpiMerge<true>, pg8::StaticOrder, true, true, false>(F.lds, g, S, E); }
        { pg8::Gemm g{XN + 512, (const bf16*)(wmix + MW_PB), D, 512, 512, nullptr}; pg8::EpiMerge<false> E{PROJ, PROJ + C_GB, NPROJ};
          pg8::gemm_phase<pg8::EpiMerge<false>, pg8::StaticOrder, true, true, false>(F.lds, g, S, E); }
    }
    SEAM(pb + 2);
    if (IN(pb + 3)) {
        pg8::Gemm g{PROJ, (const bf16*)(wmix + MW_OUT), NPROJ, D, D, nullptr}; pg8::StaticOrder S; S.init(M / 256, D / 256, F.G, (int)blockIdx.x);
        pg8::EpiResid E{xres, F.out, D};
        pg8::gemm_phase<pg8::EpiResid, pg8::StaticOrder, true, true, false>(F.lds, g, S, E);
    }
    SEAM(pb + 3);
    if constexpr (LAYER == 0) {
        if (IN(5)) norm_phase<1>(F, F.out, A_.in[21], nullptr, 0);
        SEAM(5);
        if (IN(6)) {
            pg8::Gemm g{XN, (const bf16*)(F.ws + WS_WS + FW_GU), D, D, D, nullptr}; pg8::StaticOrder S; S.init(M / 256, NGU / 256, F.G, (int)blockIdx.x);
            pg8::EpiSwiglu E{PROJ, FF};
            pg8::gemm_phase<pg8::EpiSwiglu, pg8::StaticOrder, true, true, false>(F.lds, g, S, E);
        }
        SEAM(6);
        if (IN(7)) {
            pg8::Gemm g{PROJ, (const bf16*)(F.ws + WS_WS + FW_DN), FF, FF, FF, nullptr}; pg8::StaticOrder S; S.init(M / 256, D / 256, F.G, (int)blockIdx.x);
            pg8::EpiResid E{F.out, F.out, D};
            pg8::gemm_phase<pg8::EpiResid, pg8::StaticOrder, true, true, false>(F.lds, g, S, E);
        }
        SEAM(7);
        if (IN(8)) norm_phase<0>(F, F.out, A_.in[1] + D, A_.in[2] + (size_t)D * INC + SRC_AB, INC);
        SEAM(8);
    } else {
        if (IN(13)) {
            norm_phase<2>(F, F.out, A_.in[21] + D, A_.in[25], 8);
        }
        SEAM(13);
        if (IN(14)) route_scatter(F);
        SEAM(14);
        const int* grp = (const int*)(F.ws + WS_GRP);
        if (IN(15)) {
            const int np = grp[16] / 256;
            pg8::Gemm g{XN, (const bf16*)(F.ws + WS_WS + EW_GU), D, D, D, (const int*)(F.ws + WS_LIST)}; pg8::MoeOrder S; S.init(grp, 0, np, NGU / 256, F.G, (int)blockIdx.x);
            pg8::EpiSwigluF8 E{(unsigned char*)PROJ, FF, 1.0f / (F8_SX * F8_SW), F8_SH};
            pg8::gemm_phase<pg8::EpiSwigluF8, pg8::MoeOrder, true, true, true, true>(F.lds, g, S, E);
        }
        SEAM(15);
        if (IN(16)) {
            const int np = grp[16] / 256;
            pg8::Gemm g{PROJ, (const bf16*)(F.ws + WS_WS + EW_DN), FF, FF, FF, nullptr}; pg8::MoeOrder S; S.init(grp, 0, np, D / 256, F.G, (int)blockIdx.x);
            pg8::EpiMoeDown E{F.out, (const int*)(F.ws + WS_LIST), (const float*)(F.ws + WS_GATEL), XN, grp[8], 1.0f / (F8_SH * F8_SW)};
            pg8::gemm_phase<pg8::EpiMoeDown, pg8::MoeOrder, true, true, false, true>(F.lds, g, S, E);
        }
        SEAM(16);
        if (IN(18)) norm_phase<3>(F, F.out, A_.in[29], nullptr, 0);
    }
}

__global__ void __launch_bounds__(NWAVES * 64, 2) trunk_fwd(Args A_) {
    extern __shared__ __attribute__((aligned(16))) unsigned char lds[];
    Frame F;
    F.lds = (LAS unsigned char*)lds;
    F.tid = threadIdx.x; F.lane = F.tid & 63; F.wave = __builtin_amdgcn_readfirstlane(F.tid >> 6);
    F.G = gridDim.x; { const int bx = blockIdx.x; F.vcu = (F.G % 8 == 0) ? (bx % 8) * (F.G / 8) + bx / 8 : bx; }
    F.out = A_.out; F.ws = A_.ws;
    unsigned* ctl = (unsigned*)(F.ws + WS_CTL);
    for (int u = F.tid; u < (LDS_BYTES - LDSCTL_OFF) / 4; u += NWAVES * 64) ((LAS unsigned*)(F.lds + LDSCTL_OFF))[u] = 0u;
    __syncthreads();
    XcdBarrier bar; bar.bar = ctl + CW_BAR + A_.li * XCD_BAR_WORDS; bar.x = 0; bar.st = nullptr;
    if (!MK_PER_PHASE) bar = xcd_barrier_post(ctl + CW_BAR + A_.li * XCD_BAR_WORDS, (volatile LAS unsigned*)(F.lds + MISC_OFF) + 8);
    const int lo = A_.ph_lo, hi = A_.ph_hi;
    if (IN(0)) {
        const int gw = F.vcu * NWAVES + F.wave, NGW = F.G * NWAVES;
        LAS float* scr = (LAS float*)(F.lds + F.wave * 16384);
        for (int it = gw; it < MIXER_ITEMS; it += NGW) conv_mixer_item(F, A_, 0, F.ws + WS_WS, it, scr);
        __syncthreads();
        norm_phase<0>(F, A_.in[0], A_.in[1], A_.in[2] + SRC_AB, INC);
    }
    SEAM(0);
    layer_phases<0>(F, A_, bar, lo, hi);
    layer_phases<1>(F, A_, bar, lo, hi);
#undef IN
#undef SEAM
}

extern "C" void kernel_launch(void* const* d_in, const int* in_sizes, int n_in, void* d_out, int out_size, void* d_ws, size_t ws_size, hipStream_t stream) {
    static int grid = 0;
    if (grid == 0) {
        if (n_in != 30 || in_sizes[0] != M * D || out_size != M * D || ws_size < WS_END) { fprintf(stderr, "kernel_launch: unexpected shapes / workspace (n_in %d, ws %zu, need %zu)\n", n_in, ws_size, (size_t)WS_END); grid = -1; return; }
        int dev = 0, cus = 0, per_cu = 0;
        if (hipGetDevice(&dev) != hipSuccess || hipDeviceGetAttribute(&cus, hipDeviceAttributeMultiprocessorCount, dev) != hipSuccess) { grid = -1; return; }
        if (hipFuncSetAttribute((const void*)trunk_fwd, hipFuncAttributeMaxDynamicSharedMemorySize, LDS_BYTES) != hipSuccess) { grid = -1; return; }
        if (hipOccupancyMaxActiveBlocksPerMultiprocessor(&per_cu, (const void*)trunk_fwd, NWAVES * 64, LDS_BYTES) != hipSuccess || per_cu < 1) { fprintf(stderr, "kernel_launch: occupancy query says %d\n", per_cu); }
        (void)hipGetLastError();
        grid = cus;
    }
    if (grid < 0) return;
    if (hipMemsetAsync((char*)d_ws + WS_CTL, 0, CTL_ZERO_BYTES, stream) != hipSuccess) return;
    Args a{};
    for (int i = 0; i < 30; ++i) a.in[i] = (const float*)d_in[i];
    a.out = (float*)d_out; a.ws = (unsigned char*)d_ws;
#if MK_PER_PHASE
    for (int p = 0; p < NPHASE; ++p) { a.ph_lo = p; a.ph_hi = p + 1; a.li = 0; hipLaunchKernelGGL(trunk_fwd, dim3(grid), dim3(NWAVES * 64), LDS_BYTES, stream, a); }
#elif PROBE_DUP >= 0
    a.ph_lo = 0; a.ph_hi = PROBE_DUP; a.li = 0; a.pad = 0; hipLaunchKernelGGL(trunk_fwd, dim3(grid), dim3(NWAVES * 64), LDS_BYTES, stream, a);
    a.ph_lo = PROBE_DUP; a.ph_hi = PROBE_DUP + 1; a.li = 1; a.pad = PROBE_SCAN; hipLaunchKernelGGL(trunk_fwd, dim3(grid), dim3(NWAVES * 64), LDS_BYTES, stream, a);
    a.ph_lo = PROBE_DUP; a.ph_hi = NPHASE; a.li = 2; a.pad = 0; hipLaunchKernelGGL(trunk_fwd, dim3(grid), dim3(NWAVES * 64), LDS_BYTES, stream, a);
#else
    a.ph_lo = 0; a.ph_hi = NPHASE; a.li = 0;
    hipLaunchKernelGGL(trunk_fwd, dim3(grid), dim3(NWAVES * 64), LDS_BYTES, stream, a);
#endif
}
```

```cpp
#include <hip/hip_runtime.h>
#include <cstdio>
#include <cstdint>
#pragma clang fp reassociate(on) contract(fast)

#ifndef MK_PER_PHASE
#define MK_PER_PHASE 0
#endif
#define PROBE_DUP -1
#define PADF (PROBE_DUP >= 0 ? A_.pad : 0)

#define GAS __attribute__((address_space(1)))
#define LAS __attribute__((address_space(3)))
typedef unsigned short bf16;
typedef unsigned v4u __attribute__((ext_vector_type(4)));
typedef unsigned v2u __attribute__((ext_vector_type(2)));
typedef float f32x4 __attribute__((ext_vector_type(4)));
typedef float f32x2 __attribute__((ext_vector_type(2)));
typedef short bf16x8 __attribute__((ext_vector_type(8)));
typedef GAS unsigned gu32;

constexpr int NWAVES = 8;
constexpr int BATCH = 32, T = 2048, D = 1024, M = BATCH * T;
constexpr int INC = 5896, NPROJ = 5888;
constexpr int C_R = 0, C_K = 512, C_V = 1024, C_WL = 1536, C_GQ = 1792, C_GK = 2304, C_GV = 2816, C_Z = 3328, C_GA = 3840, C_GB = 4864;
constexpr int SRC_AB = 3328;
constexpr int FF = 2816, NGU = 2 * FF, NE = 8;
constexpr int LISTCAP = 2 * M + 16 * 256;

constexpr size_t MiB = 1u << 20;
constexpr size_t WS_CTL = 0, CTL_ZERO_BYTES = 1 * MiB;
constexpr size_t WS_AB = 1 * MiB;
constexpr size_t WS_RE = 3 * MiB;
constexpr size_t WS_RG = WS_RE + (size_t)M * 4;
constexpr size_t WS_WGCNT = WS_RG + (size_t)M * 4;
constexpr size_t WS_GRP = WS_WGCNT + 256 * 16 * 4;
constexpr size_t WS_RS = 3 * MiB + 768 * 1024;
constexpr size_t WS_LIST = 4 * MiB;
constexpr size_t WS_GATEL = 5 * MiB;
constexpr size_t WS_RSL = 6 * MiB;
constexpr size_t WS_W1 = 8 * MiB;
constexpr size_t WS_WS = 24 * MiB;
constexpr size_t WS_XN = 156 * MiB;
constexpr size_t WS_PROJ = 284 * MiB;
constexpr size_t WS_END = WS_PROJ + (size_t)M * NPROJ * 2;
static_assert(WS_END == 1020 * MiB, "ws map");
static_assert((size_t)LISTCAP * NGU <= (size_t)M * NPROJ * 2, "moe hidden fits in the PROJ region");
constexpr size_t MW_IN = 0, MW_PA = MW_IN + (size_t)NPROJ * D * 2, MW_PB = MW_PA + (size_t)D * 512 * 2, MW_OUT = MW_PB + (size_t)D * 512 * 2, MW_END = MW_OUT + (size_t)D * D * 2;
constexpr size_t FW_GU = MW_END, FW_DN = FW_GU + (size_t)NGU * D * 2, FW_END = FW_DN + (size_t)D * FF * 2;
constexpr size_t EW_GU = 56 * MiB, EW_DN = EW_GU + (size_t)NE * NGU * D;
static_assert(WS_W1 + MW_END <= WS_WS && FW_END <= EW_GU && WS_WS + EW_DN + (size_t)NE * D * FF <= WS_XN, "weight map");
constexpr int NE_EARLY = 3;
constexpr int CW_BAR = 4096;

constexpr int RING_BYTES = 131072;
constexpr int LDSCTL_OFF = RING_BYTES, MISC_OFF = LDSCTL_OFF + 320;
constexpr int LDS_BYTES = 147456;

#define RLX_AGENT __ATOMIC_RELAXED, __HIP_MEMORY_SCOPE_AGENT
#define LDS_WAIT() asm volatile("s_waitcnt lgkmcnt(0)" ::: "memory")
#define VM_WAIT() asm volatile("s_waitcnt vmcnt(0)" ::: "memory")
__device__ __forceinline__ unsigned f2bf(float f) { return (unsigned)__builtin_bit_cast(unsigned short, (__bf16)f); }
typedef __bf16 bf16v2_t __attribute__((ext_vector_type(2)));
__device__ __forceinline__ unsigned pk2(float lo, float hi) { const f32x2 v = {lo, hi}; return __builtin_bit_cast(unsigned, __builtin_convertvector(v, bf16v2_t)); }
__device__ __forceinline__ float bf_lo(unsigned w) { return __builtin_bit_cast(float, w << 16); }
__device__ __forceinline__ float bf_hi(unsigned w) { return __builtin_bit_cast(float, w & 0xffff0000u); }
__device__ __forceinline__ float bf2f(bf16 v) { return __builtin_bit_cast(float, (unsigned)v << 16); }
__device__ __forceinline__ float sigmoidf_(float x) { return __builtin_amdgcn_rcpf(1.0f + __expf(-x)); }
__device__ __forceinline__ float softplusf_(float x) { return x > 20.f ? x : log1pf(__expf(x)); }
__device__ __forceinline__ unsigned f8x4(float a, float b, float c, float d) {
    a = __builtin_amdgcn_fmed3f(a, -448.f, 448.f); b = __builtin_amdgcn_fmed3f(b, -448.f, 448.f); c = __builtin_amdgcn_fmed3f(c, -448.f, 448.f); d = __builtin_amdgcn_fmed3f(d, -448.f, 448.f);
    int w = __builtin_amdgcn_cvt_pk_fp8_f32(a, b, 0, false); w = __builtin_amdgcn_cvt_pk_fp8_f32(c, d, w, true); return (unsigned)w; }
constexpr float F8_SX = 8.f, F8_SW = 256.f, F8_SH = 8.f;
constexpr float I8_WMAX = 5.0f * 0.03125f, I8_WS = I8_WMAX / 127.f, I8_WINV = 127.f / I8_WMAX;
__device__ __forceinline__ unsigned q8x4(float a, float b, float c, float d) {
    const float mg = 12582912.f;
    const unsigned ua = __builtin_bit_cast(unsigned, __builtin_amdgcn_fmed3f(a, -127.f, 127.f) + mg), ub = __builtin_bit_cast(unsigned, __builtin_amdgcn_fmed3f(b, -127.f, 127.f) + mg);
    const unsigned uc = __builtin_bit_cast(unsigned, __builtin_amdgcn_fmed3f(c, -127.f, 127.f) + mg), ud = __builtin_bit_cast(unsigned, __builtin_amdgcn_fmed3f(d, -127.f, 127.f) + mg);
    return (ua & 0xffu) | ((ub & 0xffu) << 8) | ((uc & 0xffu) << 16) | (ud << 24);
}

namespace pg8 {
constexpr int BM = 256, BK = 64, HALF = 128, HTB = HALF * BK * 2, STAGE_BYTES = 8 * HTB, NXCD = 8, WGM = 4;
__host__ __device__ __forceinline__ int lds_byte(int r, int c) { const int st = (r >> 4) * 2 + (c >> 5), rr = r & 15, cc = c & 31, ob = rr * 64 + cc * 2; return st * 1024 + (ob ^ (((ob >> 9) & 1) << 5)); }
__host__ __device__ __forceinline__ void stage_rc(int b, int& R, int& C) { const int st = b / 1024, sb = b % 1024, swz = sb ^ (((sb >> 9) & 1) << 5); R = (st >> 1) * 16 + swz / 64; C = (st & 1) * 32 + (swz % 64) / 2; }
__host__ __device__ __forceinline__ int perm32(int rho) { const int n = rho >> 4, i = rho & 15; return 8 * (i >> 2) + 4 * n + (i & 3); }

struct Unit { int pm, pn, pb; };
struct Gemm { const bf16* A; const bf16* Bt; int lda, ldb, K; const int* rows; };

struct StaticOrder {
    int nM, nN, nwg, G, c;
    __device__ void init(int nM_, int nN_, int G_, int c_) { nM = nM_; nN = nN_; nwg = nM * nN; G = G_; c = c_; }
    __device__ bool next(int i, Unit& u) const {
        const long L = (long)i * G + c; if (L >= nwg) return false;
        int wgid = (int)L; { const int q = nwg / NXCD, r = nwg % NXCD, xcd = wgid % NXCD, off = wgid / NXCD; wgid = (xcd < r ? xcd * (q + 1) : r * (q + 1) + (xcd - r) * q) + off; }
        const int nig = WGM * nN, gid = wgid / nig, fm = gid * WGM, gsz = (nM - fm) < WGM ? (nM - fm) : WGM;
        u.pm = fm + ((wgid % nig) % gsz); u.pn = (wgid % nig) / gsz; u.pb = u.pn; return true;
    }
};
struct MoeOrder {
    int nM, nN, nwg, G, c, p0; int gb[16];
    __device__ void init(const int* grp, int p0_, int nM_, int nN_, int G_, int c_) { p0 = p0_; nM = nM_; nN = nN_; nwg = nM * nN; G = G_; c = c_;
#pragma unroll
        for (int k = 0; k < 16; ++k) gb[k] = grp[k]; }
    __device__ bool next(int i, Unit& u) const {
        const long L = (long)i * G + c; if (L >= nwg) return false;
        int wgid = (int)L; { const int q = nwg / NXCD, r = nwg % NXCD, xcd = wgid % NXCD, off = wgid / NXCD; wgid = (xcd < r ? xcd * (q + 1) : r * (q + 1) + (xcd - r) * q) + off; }
        const int nig = WGM * nN, gid = wgid / nig, fm = gid * WGM, gsz = (nM - fm) < WGM ? (nM - fm) : WGM;
        u.pm = p0 + fm + ((wgid % nig) % gsz); u.pn = (wgid % nig) / gsz;
        const int rowpos = u.pm * BM; int g = 0;
#pragma unroll
        for (int k = 1; k < 16; ++k) g += (rowpos >= gb[k]) ? 1 : 0;
        u.pb = (g & 7) * nN + u.pn; return true;
    }
};

__device__ __forceinline__ unsigned cvt_pk_bf16(float lo, float hi) { unsigned r; asm volatile("v_cvt_pk_bf16_f32 %0, %1, %2" : "=v"(r) : "v"(lo), "v"(hi)); return r; }

struct EpiBf16Plain {
    static constexpr bool PERM = true;
    bf16* O; int ldc;
    __device__ __forceinline__ void operator()(const f32x4 (&acc)[2][2][4][2], const Unit& u, int wr, int wc, int fr, int fq) const {
        const int row0 = u.pm * BM + wr * 64 + fr, col0 = u.pn * BM + wc * 32 + 8 * fq;
#pragma unroll
        for (int ai = 0; ai < 2; ++ai)
#pragma unroll
            for (int m = 0; m < 4; ++m) { bf16* rowp = O + (size_t)(row0 + ai * HALF + m * 16) * ldc + col0;
#pragma unroll
                for (int bj = 0; bj < 2; ++bj) { const f32x4 v0 = acc[ai][bj][m][0], v1 = acc[ai][bj][m][1];
                    v4u w; w.x = cvt_pk_bf16(v0[0], v0[1]); w.y = cvt_pk_bf16(v0[2], v0[3]); w.z = cvt_pk_bf16(v1[0], v1[1]); w.w = cvt_pk_bf16(v1[2], v1[3]);
                    *(v4u*)(rowp + bj * HALF) = w; } }
    }
};
template <bool FIRST> struct EpiMerge {
    static constexpr bool PERM = true;
    bf16* Y; const bf16* Gt; int ldc;
    __device__ __forceinline__ void operator()(const f32x4 (&acc)[2][2][4][2], const Unit& u, int wr, int wc, int fr, int fq) const {
        const int row0 = u.pm * BM + wr * 64 + fr, col0 = u.pn * BM + wc * 32 + 8 * fq;
#pragma unroll
        for (int ai = 0; ai < 2; ++ai)
#pragma unroll
            for (int mp = 0; mp < 2; ++mp) {
                v4u gw[2][2], yw[2][2];
#pragma unroll
                for (int mm = 0; mm < 2; ++mm)
#pragma unroll
                    for (int bj = 0; bj < 2; ++bj) { const size_t ro = (size_t)(row0 + ai * HALF + (2 * mp + mm) * 16) * ldc + col0 + bj * HALF;
                        gw[mm][bj] = *(const v4u*)(Gt + ro); if (!FIRST) yw[mm][bj] = *(const v4u*)(Y + ro); }
#pragma unroll
                for (int mm = 0; mm < 2; ++mm)
#pragma unroll
                    for (int bj = 0; bj < 2; ++bj) { const int m = 2 * mp + mm; const size_t ro = (size_t)(row0 + ai * HALF + m * 16) * ldc + col0 + bj * HALF;
                        const f32x4 v0 = acc[ai][bj][m][0], v1 = acc[ai][bj][m][1]; const v4u g4 = gw[mm][bj];
                        auto mg2 = [](unsigned gw2, float a0, float a1) { const f32x2 t = (f32x2){bf_lo(gw2), bf_hi(gw2)} * (f32x2){-1.44269504089f, -1.44269504089f};
                            f32x2 e; e[0] = __builtin_amdgcn_exp2f(t[0]); e[1] = __builtin_amdgcn_exp2f(t[1]); const f32x2 d = e + (f32x2){1.0f, 1.0f};
                            f32x2 r; r[0] = __builtin_amdgcn_rcpf(d[0]); r[1] = __builtin_amdgcn_rcpf(d[1]); return r * (f32x2){a0, a1}; };
                        f32x2 o[4];
                        o[0] = mg2(g4.x, v0[0], v0[1]); o[1] = mg2(g4.y, v0[2], v0[3]); o[2] = mg2(g4.z, v1[0], v1[1]); o[3] = mg2(g4.w, v1[2], v1[3]);
                        if (!FIRST) { const v4u y4 = yw[mm][bj];
                            o[0] += (f32x2){bf_lo(y4.x), bf_hi(y4.x)}; o[1] += (f32x2){bf_lo(y4.y), bf_hi(y4.y)}; o[2] += (f32x2){bf_lo(y4.z), bf_hi(y4.z)}; o[3] += (f32x2){bf_lo(y4.w), bf_hi(y4.w)}; }
                        v4u w; w.x = cvt_pk_bf16(o[0][0], o[0][1]); w.y = cvt_pk_bf16(o[1][0], o[1][1]); w.z = cvt_pk_bf16(o[2][0], o[2][1]); w.w = cvt_pk_bf16(o[3][0], o[3][1]);
                        *(v4u*)(Y + ro) = w; }
            }
    }
};
struct EpiResid {
    static constexpr bool PERM = false;
    const float* base; float* out; int ldc;
    __device__ __forceinline__ void operator()(const f32x4 (&acc)[2][2][4][2], const Unit& u, int wr, int wc, int fr, int fq) const {
        const int row0 = u.pm * BM + wr * 64 + fr, col0 = u.pn * BM + wc * 32 + 4 * fq;
        f32x4 bs[2][2][2][2];
#define ER_LOAD(q, slot) do { _Pragma("unroll") for (int mm = 0; mm < 2; ++mm) _Pragma("unroll") for (int bj = 0; bj < 2; ++bj) _Pragma("unroll") for (int n = 0; n < 2; ++n) \
            bs[slot][mm][bj][n] = *(const f32x4*)(base + (size_t)(row0 + ((q) >> 1) * HALF + (2 * ((q) & 1) + mm) * 16) * ldc + col0 + bj * HALF + n * 16); } while (0)
#define ER_STORE(q, slot) do { _Pragma("unroll") for (int mm = 0; mm < 2; ++mm) _Pragma("unroll") for (int bj = 0; bj < 2; ++bj) _Pragma("unroll") for (int n = 0; n < 2; ++n) \
            *(f32x4*)(out + (size_t)(row0 + ((q) >> 1) * HALF + (2 * ((q) & 1) + mm) * 16) * ldc + col0 + bj * HALF + n * 16) = bs[slot][mm][bj][n] + acc[(q) >> 1][bj][2 * ((q) & 1) + mm][n]; } while (0)
        ER_LOAD(0, 0); ER_LOAD(1, 1); ER_STORE(0, 0); ER_LOAD(2, 0); ER_STORE(1, 1); ER_LOAD(3, 1); ER_STORE(2, 0); ER_STORE(3, 1);
#undef ER_LOAD
#undef ER_STORE
    }
};
__device__ __forceinline__ f32x2 silu_mul2(const f32x2 g, const f32x2 up, float c1, float lc, float kinv) {
    const f32x2 a = g * (f32x2){c1, c1} + (f32x2){lc, lc};
    f32x2 e; e[0] = __builtin_amdgcn_exp2f(a[0]); e[1] = __builtin_amdgcn_exp2f(a[1]);
    const f32x2 d = e + (f32x2){kinv, kinv};
    f32x2 r; r[0] = __builtin_amdgcn_rcpf(d[0]); r[1] = __builtin_amdgcn_rcpf(d[1]);
    return (g * up) * r;
}
struct EpiSwiglu {
    static constexpr bool PERM = true;
    bf16* H; int ldc;
    __device__ __forceinline__ void operator()(const f32x4 (&acc)[2][2][4][2], const Unit& u, int wr, int wc, int fr, int fq) const {
        const int row0 = u.pm * BM + wr * 64 + fr, col0 = u.pn * HALF + wc * 32 + 8 * fq;
#pragma unroll
        for (int ai = 0; ai < 2; ++ai)
#pragma unroll
            for (int m = 0; m < 4; ++m) { bf16* rowp = H + (size_t)(row0 + ai * HALF + m * 16) * ldc + col0;
                f32x2 o[4];
#pragma unroll
                for (int n = 0; n < 2; ++n)
#pragma unroll
                    for (int jp = 0; jp < 2; ++jp) { const f32x4 g4 = acc[ai][0][m][n], u4 = acc[ai][1][m][n];
                        o[n * 2 + jp] = silu_mul2((f32x2){g4[2 * jp], g4[2 * jp + 1]}, (f32x2){u4[2 * jp], u4[2 * jp + 1]}, -1.44269504089f, 0.f, 1.0f); }
                v4u w; w.x = cvt_pk_bf16(o[0][0], o[0][1]); w.y = cvt_pk_bf16(o[1][0], o[1][1]); w.z = cvt_pk_bf16(o[2][0], o[2][1]); w.w = cvt_pk_bf16(o[3][0], o[3][1]);
                *(v4u*)rowp = w; }
    }
};
struct EpiSwigluF8 {
    static constexpr bool PERM = true;
    unsigned char* H; int ldc; float insc, osc;
    __device__ __forceinline__ void operator()(const f32x4 (&acc)[2][2][4][2], const Unit& u, int wr, int wc, int fr, int fq) const {
        const int row0 = u.pm * BM + wr * 64 + fr, col0 = u.pn * HALF + wc * 32 + 8 * fq;
#pragma unroll
        for (int ai = 0; ai < 2; ++ai)
#pragma unroll
            for (int m = 0; m < 4; ++m) { unsigned char* rowp = H + (size_t)(row0 + ai * HALF + m * 16) * ldc + col0;
                const float c2 = insc * insc * osc, c1 = -1.44269504089f * insc, lc = -__builtin_log2f(c2), kinv = 1.0f / c2;
                f32x2 o[4];
#pragma unroll
                for (int n = 0; n < 2; ++n)
#pragma unroll
                    for (int jp = 0; jp < 2; ++jp) { const f32x4 g4 = acc[ai][0][m][n], u4 = acc[ai][1][m][n];
                        o[n * 2 + jp] = silu_mul2((f32x2){g4[2 * jp], g4[2 * jp + 1]}, (f32x2){u4[2 * jp], u4[2 * jp + 1]}, c1, lc, kinv); }
                v2u w; w.x = f8x4(o[0][0], o[0][1], o[1][0], o[1][1]); w.y = f8x4(o[2][0], o[2][1], o[3][0], o[3][1]);
                *(v2u*)rowp = w; }
    }
};
template <bool OUTF8> struct EpiSwigluI8 {
    static constexpr bool PERM = true;
    unsigned char* H; int ldc; const float* rs; float sw, osc;
    __device__ __forceinline__ void operator()(const f32x4 (&acc)[2][2][4][2], const Unit& u, int wr, int wc, int fr, int fq) const {
        const int row0 = u.pm * BM + wr * 64 + fr, col0 = u.pn * HALF + wc * 32 + 8 * fq;
        float c0[2][4];
#pragma unroll
        for (int ai = 0; ai < 2; ++ai)
#pragma unroll
            for (int m = 0; m < 4; ++m) c0[ai][m] = rs[row0 + ai * HALF + m * 16] * sw;
#pragma unroll
        for (int ai = 0; ai < 2; ++ai)
#pragma unroll
            for (int m = 0; m < 4; ++m) { unsigned char* rowp = H + ((size_t)(row0 + ai * HALF + m * 16) * ldc + col0) * (OUTF8 ? 1 : 2);
                const float cc = c0[ai][m], c2 = cc * cc * osc, c1 = -1.44269504089f * cc, lc = -__builtin_amdgcn_logf(c2), kinv = __builtin_amdgcn_rcpf(c2);
                f32x2 o[4];
#pragma unroll
                for (int n = 0; n < 2; ++n)
#pragma unroll
                    for (int jp = 0; jp < 2; ++jp) { const f32x4 g4 = acc[ai][0][m][n], u4 = acc[ai][1][m][n];
                        o[n * 2 + jp] = silu_mul2((f32x2){g4[2 * jp], g4[2 * jp + 1]}, (f32x2){u4[2 * jp], u4[2 * jp + 1]}, c1, lc, kinv); }
                if constexpr (OUTF8) { v2u w; w.x = f8x4(o[0][0], o[0][1], o[1][0], o[1][1]); w.y = f8x4(o[2][0], o[2][1], o[3][0], o[3][1]); *(v2u*)rowp = w; }
                else { v4u w; w.x = cvt_pk_bf16(o[0][0], o[0][1]); w.y = cvt_pk_bf16(o[1][0], o[1][1]); w.z = cvt_pk_bf16(o[2][0], o[2][1]); w.w = cvt_pk_bf16(o[3][0], o[3][1]); *(v4u*)rowp = w; } }
    }
};
struct EpiMoeDown {
    static constexpr bool PERM = false;
    float* out; const int* list; const float* gatel; bf16* tmp; int split; float sc;
    __device__ __forceinline__ void operator()(const f32x4 (&acc)[2][2][4][2], const Unit& u, int wr, int wc, int fr, int fq) const {
        const int row0 = u.pm * BM + wr * 64 + fr, col0 = u.pn * BM + wc * 32 + 4 * fq;
        int tok[2][4]; float gt[2][4];
#pragma unroll
        for (int ai = 0; ai < 2; ++ai)
#pragma unroll
            for (int m = 0; m < 4; ++m) { const int p = row0 + ai * HALF + m * 16; tok[ai][m] = list[p]; gt[ai][m] = gatel[p] * sc; }
        if (u.pm * BM >= split) {
#pragma unroll
            for (int ai = 0; ai < 2; ++ai)
#pragma unroll
                for (int m = 0; m < 4; ++m) { const int tk = tok[ai][m]; const float g = gt[ai][m];
                    if (tk >= 0) { bf16* rowp = tmp + (size_t)tk * D + col0;
#pragma unroll
                        for (int bj = 0; bj < 2; ++bj)
#pragma unroll
                            for (int n = 0; n < 2; ++n) { const f32x4 o = acc[ai][bj][m][n] * g; v2u w; w.x = cvt_pk_bf16(o[0], o[1]); w.y = cvt_pk_bf16(o[2], o[3]); *(v2u*)(rowp + bj * HALF + n * 16) = w; } } }
            return;
        }
#pragma unroll
        for (int ai = 0; ai < 2; ++ai)
#pragma unroll
            for (int mp = 0; mp < 2; ++mp) {
                f32x4 bs[2][2][2];
#pragma unroll
                for (int mm = 0; mm < 2; ++mm) { const int tk = tok[ai][2 * mp + mm]; const float* rowp = out + (size_t)(tk < 0 ? 0 : tk) * D + col0;
#pragma unroll
                    for (int bj = 0; bj < 2; ++bj)
#pragma unroll
                        for (int n = 0; n < 2; ++n) bs[mm][bj][n] = *(const f32x4*)(rowp + bj * HALF + n * 16); }
#pragma unroll
                for (int mm = 0; mm < 2; ++mm) { const int tk = tok[ai][2 * mp + mm]; const float g = gt[ai][2 * mp + mm];
                    if (tk >= 0) { float* rowp = out + (size_t)tk * D + col0;
#pragma unroll
                        for (int bj = 0; bj < 2; ++bj)
#pragma unroll
                            for (int n = 0; n < 2; ++n) *(f32x4*)(rowp + bj * HALF + n * 16) = bs[mm][bj][n] + acc[ai][bj][2 * mp + mm][n] * g; } }
            }
    }
};

typedef int v4i_t __attribute__((ext_vector_type(4)));
typedef int v8i_t __attribute__((ext_vector_type(8)));
__device__ __forceinline__ v8i_t cat8(const bf16x8 a, const bf16x8 b) { return __builtin_shufflevector(__builtin_bit_cast(v4i_t, a), __builtin_bit_cast(v4i_t, b), 0, 1, 2, 3, 4, 5, 6, 7); }
template <class Epi, class Sched, bool ALIGN_EPI, bool SP2, bool GATHER, int PREC = 0>
__device__ __forceinline__ void gemm_phase(LAS unsigned char* lds, const Gemm g, const Sched& S, const Epi& E) {
    constexpr bool F8 = PREC == 1, I8 = PREC == 2;
    constexpr unsigned EB = PREC ? 1u : 2u;
    const int tid = threadIdx.x, wid = __builtin_amdgcn_readfirstlane(tid >> 6), lane = tid & 63, wr = wid >> 2, wc = wid & 3, fr = lane & 15, fq = lane >> 4;
    const int K = g.K, nt = K / (PREC ? 2 * BK : BK);
    unsigned voffA[2], voffB[2]; int stR[2], stC[2];
#pragma unroll
    for (int i = 0; i < 2; ++i) { int R, C; stage_rc(tid * 16 + i * 8192, R, C); const int Rb = Epi::PERM ? ((R & ~31) + perm32(R & 31)) : R;
        voffA[i] = (unsigned)(R * g.lda) * EB + (unsigned)C * 2u; voffB[i] = (unsigned)(Rb * g.ldb) * EB + (unsigned)C * 2u; stR[i] = R; stC[i] = C; }
    const size_t kstep = (size_t)(BK * 2);
    const size_t hstepA = (size_t)HALF * g.lda * EB, tstepA = 2 * hstepA, hstepB = (size_t)HALF * g.ldb * EB, tstepB = 2 * hstepB;
    const unsigned ldsw = (unsigned)wid * 1024u;
    const int aoff = lds_byte(wr * 64 + fr, fq * 8), boff = lds_byte(wc * 32 + fr, fq * 8);
    unsigned gAc[2][2], gAn[2][2];
#define PG8_SA(b, h) (((b) * 2 + (h)) * HTB)
#define PG8_SB(b, h) ((4 + (b) * 2 + (h)) * HTB)
#define PG8_GLDS(src, bufoff, i) __builtin_amdgcn_global_load_lds((const unsigned*)(src), (LAS unsigned*)(lds + (bufoff) + ldsw + (i) * 8192), 16, 0, 0)
#define PG8_STAGE_B(bufoff, gbase) do { _Pragma("unroll") for (int _i = 0; _i < 2; ++_i) PG8_GLDS((const char*)(gbase) + voffB[_i], bufoff, _i); } while (0)
#define PG8_STAGE_A(bufoff, h, NX, kb) do { \
        if constexpr (GATHER) { _Pragma("unroll") for (int _i = 0; _i < 2; ++_i) { const unsigned _o = (NX) ? gAn[h][_i] : gAc[h][_i]; PG8_GLDS((const char*)g.A + _o + (kb), bufoff, _i); } } \
        else { const char* _b = ((NX) ? nA : cA) + (h) * hstepA + (kb); _Pragma("unroll") for (int _i = 0; _i < 2; ++_i) PG8_GLDS(_b + voffA[_i], bufoff, _i); } } while (0)
#define PG8_LDA(dst, b, h) do { _Pragma("unroll") for (int m = 0; m < 4; ++m) _Pragma("unroll") for (int k = 0; k < 2; ++k) dst[m][k] = *(const LAS bf16x8*)(lds + PG8_SA(b, h) + aoff + m * 2048 + k * 1024); } while (0)
#define PG8_LDB(dst, b, h) do { _Pragma("unroll") for (int n = 0; n < 2; ++n) _Pragma("unroll") for (int k = 0; k < 2; ++k) dst[n][k] = *(const LAS bf16x8*)(lds + PG8_SB(b, h) + boff + n * 2048 + k * 1024); } while (0)
#define PG8_MMA(ai, bj, At, Bt) do { __builtin_amdgcn_s_setprio(1); _Pragma("unroll") for (int m = 0; m < 4; ++m) _Pragma("unroll") for (int n = 0; n < 2; ++n) { \
        if constexpr (F8) asm("v_mfma_f32_16x16x128_f8f6f4 %0, %1, %2, %0" : "+v"(acc[ai][bj][m][n]) : "v"(cat8(Bt[n][0], Bt[n][1])), "v"(cat8(At[m][0], At[m][1]))); \
        else if constexpr (I8) { _Pragma("unroll") for (int k = 0; k < 2; ++k) acc[ai][bj][m][n] = __builtin_bit_cast(f32x4, __builtin_amdgcn_mfma_i32_16x16x64_i8(__builtin_bit_cast(v4i_t, Bt[n][k]), __builtin_bit_cast(v4i_t, At[m][k]), __builtin_bit_cast(v4i_t, acc[ai][bj][m][n]), 0, 0, 0)); } \
        else { _Pragma("unroll") for (int k = 0; k < 2; ++k) acc[ai][bj][m][n] = __builtin_amdgcn_mfma_f32_16x16x32_bf16(Bt[n][k], At[m][k], acc[ai][bj][m][n], 0, 0, 0); } } __builtin_amdgcn_s_setprio(0); } while (0)
#define PG8_WAIT_V(n) asm volatile("s_waitcnt vmcnt(" #n ")" ::: "memory")
#define PG8_WAIT_L(n) asm volatile("s_waitcnt lgkmcnt(" #n ")" ::: "memory")
#define PG8_BAR __builtin_amdgcn_s_barrier()
#define PG8_SCHED __builtin_amdgcn_sched_barrier(0)
#define PG8_GOFF(dst, unit) do { _Pragma("unroll") for (int _h = 0; _h < 2; ++_h) _Pragma("unroll") for (int _i = 0; _i < 2; ++_i) { int _t = g.rows[(unit).pm * BM + _h * HALF + stR[_i]]; _t = _t < 0 ? 0 : _t; \
        dst[_h][_i] = (unsigned)_t * ((unsigned)g.lda * EB) + (unsigned)(stC[_i] * 2); } } while (0)
    Unit cur, nxt; int ui = 0;
    if (!S.next(0, cur)) return;
    f32x4 acc[2][2][4][2];
#pragma unroll
    for (int a = 0; a < 2; ++a)
#pragma unroll
        for (int b = 0; b < 2; ++b)
#pragma unroll
            for (int m = 0; m < 4; ++m)
#pragma unroll
                for (int n = 0; n < 2; ++n) acc[a][b][m][n] = (f32x4){0.f, 0.f, 0.f, 0.f};
    bf16x8 At[4][2], B0[2][2], B1[2][2];
    const char* cA = (const char*)g.A + (size_t)cur.pm * tstepA; const char* cB = (const char*)g.Bt + (size_t)cur.pb * tstepB;
    const char* nA = cA;
    if constexpr (GATHER) { PG8_GOFF(gAc, cur); _Pragma("unroll") for (int _h = 0; _h < 2; ++_h) _Pragma("unroll") for (int _i = 0; _i < 2; ++_i) gAn[_h][_i] = gAc[_h][_i]; }
    if constexpr (SP2) {
        PG8_STAGE_B(PG8_SB(0, 0), cB); PG8_STAGE_B(PG8_SB(0, 1), cB + hstepB); PG8_STAGE_A(PG8_SA(0, 0), 0, false, 0); PG8_STAGE_A(PG8_SA(0, 1), 1, false, 0);
        if (wr == 1) PG8_BAR;
        PG8_WAIT_V(2); PG8_BAR;
        PG8_STAGE_B(PG8_SB(1, 0), cB + kstep); PG8_STAGE_A(PG8_SA(1, 0), 0, false, kstep); PG8_STAGE_B(PG8_SB(1, 1), cB + hstepB + kstep);
        PG8_WAIT_V(6); PG8_BAR;
    } else {
        PG8_STAGE_B(PG8_SB(0, 0), cB); PG8_STAGE_A(PG8_SA(0, 0), 0, false, 0); PG8_STAGE_B(PG8_SB(0, 1), cB + hstepB); PG8_STAGE_A(PG8_SA(0, 1), 1, false, 0);
        if (wr == 1) PG8_BAR;
        PG8_WAIT_V(4); PG8_BAR;
        PG8_STAGE_B(PG8_SB(1, 0), cB + kstep); PG8_STAGE_A(PG8_SA(1, 0), 0, false, kstep); PG8_STAGE_B(PG8_SB(1, 1), cB + hstepB + kstep);
        PG8_WAIT_V(6); PG8_BAR;
    }
    for (;;) {
        const bool has_next = S.next(ui + 1, nxt);
        nA = has_next ? (const char*)g.A + (size_t)nxt.pm * tstepA : cA; const char* nB = has_next ? (const char*)g.Bt + (size_t)nxt.pb * tstepB : cB;
        if constexpr (GATHER) { if (has_next) PG8_GOFF(gAn, nxt); }
        for (int t = 0; t < nt; t += 2) {
            const bool last = (t == nt - 2);
            const size_t k1 = (size_t)(t + 1) * kstep;
            const size_t k2 = last ? 0 : (size_t)(t + 2) * kstep, k3 = k2 + kstep;
            const char* b2 = last ? nB : cB + (size_t)(t + 2) * kstep; const char* b3 = b2 + kstep;
            if constexpr (SP2) {
            PG8_LDB(B0, 0, 0); PG8_LDB(B1, 0, 1); PG8_SCHED; PG8_LDA(At, 0, 0); PG8_STAGE_A(PG8_SA(1, 1), 1, false, k1);
            PG8_WAIT_V(8); PG8_WAIT_L(0); PG8_BAR; PG8_MMA(0, 0, At, B0); PG8_MMA(0, 1, At, B1); PG8_BAR; PG8_SCHED;
            PG8_LDA(At, 0, 1); PG8_STAGE_B(PG8_SB(0, 0), b2); PG8_STAGE_B(PG8_SB(0, 1), b2 + hstepB); PG8_STAGE_A(PG8_SA(0, 0), 0, last, k2);
            PG8_WAIT_V(8); PG8_WAIT_L(0); PG8_BAR; PG8_MMA(1, 0, At, B0); PG8_MMA(1, 1, At, B1); PG8_BAR; PG8_SCHED;
            PG8_LDB(B0, 1, 0); PG8_LDB(B1, 1, 1); PG8_SCHED; PG8_LDA(At, 1, 0); PG8_STAGE_A(PG8_SA(0, 1), 1, last, k2);
            PG8_WAIT_V(8); PG8_WAIT_L(0); PG8_BAR; PG8_MMA(0, 0, At, B0); PG8_MMA(0, 1, At, B1); PG8_BAR; PG8_SCHED;
            PG8_LDA(At, 1, 1); PG8_STAGE_B(PG8_SB(1, 0), b3); PG8_STAGE_B(PG8_SB(1, 1), b3 + hstepB); PG8_STAGE_A(PG8_SA(1, 0), 0, last, k3);
            PG8_WAIT_V(8); PG8_WAIT_L(0); PG8_BAR; PG8_MMA(1, 0, At, B0); PG8_MMA(1, 1, At, B1); PG8_BAR; PG8_SCHED;
            } else {
            PG8_LDB(B0, 0, 0); PG8_SCHED; PG8_LDA(At, 0, 0); PG8_STAGE_A(PG8_SA(1, 1), 1, false, k1);
            PG8_WAIT_L(8); PG8_BAR; PG8_WAIT_L(0); PG8_MMA(0, 0, At, B0); PG8_BAR; PG8_SCHED;
            PG8_LDB(B1, 0, 1); PG8_STAGE_B(PG8_SB(0, 0), b2);
            PG8_BAR; PG8_WAIT_L(0); PG8_MMA(0, 1, At, B1); PG8_BAR;
            PG8_LDA(At, 0, 1); PG8_STAGE_A(PG8_SA(0, 0), 0, last, k2);
            PG8_BAR; PG8_WAIT_L(0); PG8_MMA(1, 0, At, B0); PG8_BAR; PG8_SCHED;
            PG8_STAGE_B(PG8_SB(0, 1), b2 + hstepB);
            PG8_WAIT_V(6); PG8_BAR; PG8_MMA(1, 1, At, B1); PG8_BAR;
            PG8_LDB(B0, 1, 0); PG8_SCHED; PG8_LDA(At, 1, 0); PG8_STAGE_A(PG8_SA(0, 1), 1, last, k2);
            PG8_WAIT_L(8); PG8_BAR; PG8_WAIT_L(0); PG8_MMA(0, 0, At, B0); PG8_BAR; PG8_SCHED;
            PG8_LDB(B1, 1, 1); PG8_STAGE_B(PG8_SB(1, 0), b3);
            PG8_BAR; PG8_WAIT_L(0); PG8_MMA(0, 1, At, B1); PG8_BAR;
            PG8_LDA(At, 1, 1); PG8_STAGE_A(PG8_SA(1, 0), 0, last, k3);
            PG8_BAR; PG8_WAIT_L(0); PG8_MMA(1, 0, At, B0); PG8_BAR; PG8_SCHED;
            PG8_STAGE_B(PG8_SB(1, 1), b3 + hstepB);
            PG8_WAIT_V(6); PG8_BAR; PG8_MMA(1, 1, At, B1); PG8_BAR;
            }
        }
        if constexpr (F8) { asm volatile("s_nop 15\n\ts_nop 15" ::: "memory"); PG8_SCHED; }
        if constexpr (ALIGN_EPI) { if (wr == 0) PG8_BAR; }
        if constexpr (I8) {
#pragma unroll
            for (int a = 0; a < 2; ++a)
#pragma unroll
                for (int b = 0; b < 2; ++b)
#pragma unroll
                    for (int m = 0; m < 4; ++m)
#pragma unroll
                        for (int n = 0; n < 2; ++n) acc[a][b][m][n] = __builtin_convertvector(__builtin_bit_cast(v4i_t, acc[a][b][m][n]), f32x4); }
        E(acc, cur, wr, wc, fr, fq);
        if (!has_next) break;
#pragma unroll
        for (int a = 0; a < 2; ++a)
#pragma unroll
            for (int b = 0; b < 2; ++b)
#pragma unroll
                for (int m = 0; m < 4; ++m)
#pragma unroll
                    for (int n = 0; n < 2; ++n) acc[a][b][m][n] = (f32x4){0.f, 0.f, 0.f, 0.f};
        cur = nxt; cA = nA; cB = nB; ++ui;
        if constexpr (GATHER) { _Pragma("unroll") for (int _h = 0; _h < 2; ++_h) _Pragma("unroll") for (int _i = 0; _i < 2; ++_i) gAc[_h][_i] = gAn[_h][_i]; }
        if constexpr (ALIGN_EPI) { if (wr == 1) PG8_BAR; }
    }
    PG8_WAIT_V(0);
    if constexpr (!ALIGN_EPI) { if (wr == 0) PG8_BAR; }
    PG8_BAR;
#undef PG8_SA
#undef PG8_SB
#undef PG8_GLDS
#undef PG8_STAGE_A
#undef PG8_STAGE_B
#undef PG8_LDA
#undef PG8_LDB
#undef PG8_MMA
#undef PG8_WAIT_V
#undef PG8_WAIT_L
#undef PG8_BAR
#undef PG8_SCHED
#undef PG8_GOFF
}
}

#define XB_TMO      128
#define XB_XCNT(j)  (256  + 64 * (j))
#define XB_XSUB(j)  (1280 + 64 * (j))
#define XB_XGEN(j)  (2304 + 64 * (j))
#define XB_TOP      3328
#define XB_TOPGEN   3392
#define XCD_BAR_WORDS 3456
#define XB_SPIN_CAP (1u << 18)
__device__ __forceinline__ unsigned xb_ld(unsigned* p)              { return __hip_atomic_load(p, __ATOMIC_RELAXED, __HIP_MEMORY_SCOPE_AGENT); }
__device__ __forceinline__ unsigned xb_add(unsigned* p, unsigned v) { return __hip_atomic_fetch_add(p, v, __ATOMIC_RELAXED, __HIP_MEMORY_SCOPE_AGENT); }
__device__ __forceinline__ unsigned xb_xcc_id() { return (unsigned)__builtin_amdgcn_s_getreg((3 << 11) | 20) & 0xFu; }
#define XB_SPIN(cond, bar) do { unsigned _sp = 0; while (cond) { __builtin_amdgcn_s_sleep(1); \
    if ((++_sp & 255u) == 0u) { if (xb_ld(&(bar)[XB_TMO])) break; if (_sp > XB_SPIN_CAP) { atomicAdd(&(bar)[XB_TMO], 1u); break; } } } } while (0)
struct XcdBarrier { unsigned* bar; unsigned x; volatile LAS unsigned* st; };
__device__ __forceinline__ XcdBarrier xcd_barrier_post(unsigned* bar, volatile LAS unsigned* st) {
    XcdBarrier b; b.bar = bar; b.x = xb_xcc_id(); b.st = st;
    if (threadIdx.x == 0) (void)xb_add(&bar[XB_XCNT(b.x)], 1u);
    return b;
}
__device__ __forceinline__ void xcd_barrier_complete(unsigned* bar, unsigned x, unsigned& nloc, unsigned& nx) {
    const unsigned G = gridDim.x * gridDim.y * gridDim.z;
    unsigned sum, cnt, mine, sp = 0u;
    for (;;) {
        sum = 0u; cnt = 0u; mine = 0u;
#pragma unroll
        for (unsigned j = 0; j < 16; ++j) { const unsigned c = xb_ld(&bar[XB_XCNT(j)]); sum += c; cnt += (c > 0u) ? 1u : 0u; mine = (j == x) ? c : mine; }
        if (sum == G) break;
        __builtin_amdgcn_s_sleep(1);
        if ((++sp & 255u) == 0u) { if (xb_ld(&bar[XB_TMO])) break; if (sp > XB_SPIN_CAP) { atomicAdd(&bar[XB_TMO], 1u); break; } }
    }
    nloc = mine > 0u ? mine : 1u; nx = cnt > 0u ? cnt : 1u;
}
__device__ __forceinline__ void xcd_barrier(const XcdBarrier& b) {
    asm volatile("s_waitcnt vmcnt(0)" ::: "memory");
    __syncthreads();
    if (threadIdx.x == 0) {
        unsigned* bar = b.bar;
        __builtin_amdgcn_s_waitcnt(0);
        unsigned nloc = b.st[0], nx = b.st[1];
        if (nloc == 0u) { xcd_barrier_complete(bar, b.x, nloc, nx); b.st[0] = nloc; b.st[1] = nx; }
        const unsigned old = xb_add(&bar[XB_XSUB(b.x)], 1u);
        const unsigned gen = old / nloc;
        if (old + 1u == (gen + 1u) * nloc) {
            __builtin_amdgcn_fence(__ATOMIC_RELEASE, "agent");
            asm volatile("s_waitcnt vmcnt(0)" ::: "memory");
            const unsigned og = xb_add(&bar[XB_TOP], 1u);
            const unsigned tg = og / nx;
            if (og + 1u == (tg + 1u) * nx) xb_add(&bar[XB_TOPGEN], 1u);
            else XB_SPIN(xb_ld(&bar[XB_TOPGEN]) == tg, bar);
            __builtin_amdgcn_fence(__ATOMIC_ACQUIRE, "agent");
            xb_add(&bar[XB_XGEN(b.x)], 1u);
            asm volatile("s_waitcnt vmcnt(0)" ::: "memory");
        } else {
            XB_SPIN(xb_ld(&bar[XB_XGEN(b.x)]) == gen, bar);
            __builtin_amdgcn_fence(__ATOMIC_ACQUIRE, "agent");
            asm volatile("s_waitcnt vmcnt(0)" ::: "memory");
        }
    }
    __syncthreads();
}

struct Frame {
    LAS unsigned char* lds;
    int tid, lane, wave, vcu, G;
    float* out; unsigned char* ws;
};
struct Args { const float* in[30]; float* out; unsigned char* ws; int ph_lo, ph_hi, li, pad; };
template <int CTRL> __device__ __forceinline__ float dpp_mov(float v) { return __builtin_bit_cast(float, __builtin_amdgcn_update_dpp(0, __builtin_bit_cast(int, v), CTRL, 0xf, 0xf, true)); }
__device__ __forceinline__ float sum8(float v) { v += dpp_mov<0xB1>(v); v += dpp_mov<0x4E>(v); v += dpp_mov<0x141>(v); return v; }
__device__ __forceinline__ float sum16(float v) { v = sum8(v); v += dpp_mov<0x140>(v); return v; }
__device__ __forceinline__ float wave_sum(float v) {
    v = sum16(v);
    const int iv = __builtin_bit_cast(int, v);
    return (__builtin_bit_cast(float, __builtin_amdgcn_readlane(iv, 0)) + __builtin_bit_cast(float, __builtin_amdgcn_readlane(iv, 16))) +
           (__builtin_bit_cast(float, __builtin_amdgcn_readlane(iv, 32)) + __builtin_bit_cast(float, __builtin_amdgcn_readlane(iv, 48)));
}

__device__ __forceinline__ float wave_max(float v) {
    v = fmaxf(v, dpp_mov<0xB1>(v)); v = fmaxf(v, dpp_mov<0x4E>(v)); v = fmaxf(v, dpp_mov<0x141>(v)); v = fmaxf(v, dpp_mov<0x140>(v));
    const int iv = __builtin_bit_cast(int, v);
    return fmaxf(fmaxf(__builtin_bit_cast(float, __builtin_amdgcn_readlane(iv, 0)), __builtin_bit_cast(float, __builtin_amdgcn_readlane(iv, 16))),
                 fmaxf(__builtin_bit_cast(float, __builtin_amdgcn_readlane(iv, 32)), __builtin_bit_cast(float, __builtin_amdgcn_readlane(iv, 48))));
}
__device__ __forceinline__ float reduce8(const float (&a)[8], int lane) {
    const bool b0 = lane & 1, b1 = lane & 2, b2 = lane & 4;
    float b[4], c[2];
#pragma unroll
    for (int m = 0; m < 4; ++m) { const float keep = b0 ? a[2 * m + 1] : a[2 * m], send = b0 ? a[2 * m] : a[2 * m + 1]; b[m] = keep + dpp_mov<0xB1>(send); }
#pragma unroll
    for (int m = 0; m < 2; ++m) { const float keep = b1 ? b[2 * m + 1] : b[2 * m], send = b1 ? b[2 * m] : b[2 * m + 1]; c[m] = keep + dpp_mov<0x4E>(send); }
    float d;
    { const float keep = b2 ? c[1] : c[0], send = b2 ? c[0] : c[1]; d = keep + dpp_mov<0x124>(send); }
    d += dpp_mov<0x128>(d);
    { const unsigned u = __builtin_bit_cast(unsigned, d); const auto r = __builtin_amdgcn_permlane16_swap(u, u, false, false); d = __builtin_bit_cast(float, (unsigned)r[0]) + __builtin_bit_cast(float, (unsigned)r[1]); }
    { const unsigned u = __builtin_bit_cast(unsigned, d); const auto r = __builtin_amdgcn_permlane32_swap(u, u, false, false); d = __builtin_bit_cast(float, (unsigned)r[0]) + __builtin_bit_cast(float, (unsigned)r[1]); }
    return d;
}

__device__ __forceinline__ void tr_item(const float* W, int ldw, int k0, int srccol0, bf16* WT, int K, int dstrow0, LAS float* scr, int lane) {
    (void)scr;
    const int kr = lane >> 3, nq = lane & 7;
    const float* src = W + (size_t)(k0 + 8 * kr) * ldw + srccol0 + 4 * nq;
    f32x4 x[8];
#pragma unroll
    for (int b = 0; b < 8; ++b) x[b] = *(const GAS f32x4*)(src + (size_t)b * ldw);
    bf16* dst = WT + (size_t)(dstrow0 + 4 * nq) * K + k0 + 8 * kr;
#pragma unroll
    for (int q = 0; q < 4; ++q) { v4u o; o.x = pk2(x[0][q], x[1][q]); o.y = pk2(x[2][q], x[3][q]); o.z = pk2(x[4][q], x[5][q]); o.w = pk2(x[6][q], x[7][q]);
        *(GAS v4u*)(dst + (size_t)q * K) = o; }
}
__device__ __forceinline__ void tr_item_f8(const float* W, int ldw, int k0, int srccol0, unsigned char* WT, int K, int dstrow0, int lane, float sc) {
    const int kr = lane >> 3, nq = lane & 7;
    const float* src = W + (size_t)(k0 + 4 * kr) * ldw + srccol0 + 4 * nq;
    f32x4 x[4][4];
#pragma unroll
    for (int a = 0; a < 4; ++a)
#pragma unroll
        for (int b = 0; b < 4; ++b) x[a][b] = *(const GAS f32x4*)(src + (size_t)(32 * a + b) * ldw);
    unsigned char* dst = WT + (size_t)(dstrow0 + 4 * nq) * K + k0 + 4 * kr;
#pragma unroll
    for (int a = 0; a < 4; ++a)
#pragma unroll
        for (int q = 0; q < 4; ++q)
            *(GAS unsigned*)(dst + (size_t)q * K + 32 * a) = f8x4(x[a][0][q] * sc, x[a][1][q] * sc, x[a][2][q] * sc, x[a][3][q] * sc);
}
__device__ __forceinline__ void conv_mixer_item(Frame& F, const Args& A_, int l, unsigned char* dst, int r, LAS float* scr) {
    constexpr int I_IN = 16 * (NPROJ / 32), I_P = 8 * 32, I_O = 16 * 32;
    if (r < I_IN) { const int kb = r / (NPROJ / 32), nb = r % (NPROJ / 32); tr_item(A_.in[2] + (size_t)l * D * INC, INC, kb * 64, nb * 32 + (nb >= 104 ? 8 : 0), (bf16*)(dst + MW_IN), D, nb * 32, scr, F.lane); return; } r -= I_IN;
    if (r < I_P) { const int kb = r / 32, nb = r % 32; tr_item(A_.in[14] + (size_t)l * 512 * D, D, kb * 64, nb * 32, (bf16*)(dst + MW_PA), 512, nb * 32, scr, F.lane); return; } r -= I_P;
    if (r < I_P) { const int kb = r / 32, nb = r % 32; tr_item(A_.in[19] + (size_t)l * 512 * D, D, kb * 64, nb * 32, (bf16*)(dst + MW_PB), 512, nb * 32, scr, F.lane); return; } r -= I_P;
    { const int kb = r / 32, nb = r % 32; tr_item(A_.in[20] + (size_t)l * D * D, D, kb * 64, nb * 32, (bf16*)(dst + MW_OUT), D, nb * 32, scr, F.lane); }
}
constexpr int MIXER_ITEMS = 16 * (NPROJ / 32) + 2 * 8 * 32 + 16 * 32;
constexpr int FFN_ITEMS = 3 * 16 * (FF / 32);
__device__ __forceinline__ void conv_ffn_item(Frame& F, const float* wg, const float* wu, const float* wd, bf16* gu, bf16* dn, int r, LAS float* scr) {
    constexpr int I_G = 16 * (FF / 32);
    if (r < I_G) { const int kb = r / (FF / 32), nb = r % (FF / 32), n0 = nb * 32; tr_item(wg, FF, kb * 64, n0, gu, D, (n0 / 128) * 256 + (n0 % 128), scr, F.lane); return; } r -= I_G;
    if (r < I_G) { const int kb = r / (FF / 32), nb = r % (FF / 32), n0 = nb * 32; tr_item(wu, FF, kb * 64, n0, gu, D, (n0 / 128) * 256 + 128 + (n0 % 128), scr, F.lane); return; } r -= I_G;
    { const int kb = r / 32, nb = r % 32; tr_item(wd, D, kb * 64, nb * 32, dn, FF, nb * 32, scr, F.lane); }
}

__device__ __forceinline__ void tr_item_i8(const float* W, int ldw, int k0, int srccol0, unsigned char* WT, int K, int dstrow0, int lane) {
    const int kr = lane >> 3, nq = lane & 7;
    const float* src = W + (size_t)(k0 + 4 * kr) * ldw + srccol0 + 4 * nq;
    f32x4 x[4][4];
#pragma unroll
    for (int a = 0; a < 4; ++a)
#pragma unroll
        for (int b = 0; b < 4; ++b) x[a][b] = *(const GAS f32x4*)(src + (size_t)(32 * a + b) * ldw);
    unsigned char* dst = WT + (size_t)(dstrow0 + 4 * nq) * K + k0 + 4 * kr;
#pragma unroll
    for (int a = 0; a < 4; ++a)
#pragma unroll
        for (int q = 0; q < 4; ++q)
            *(GAS unsigned*)(dst + (size_t)q * K + 32 * a) = q8x4(x[a][0][q] * I8_WINV, x[a][1][q] * I8_WINV, x[a][2][q] * I8_WINV, x[a][3][q] * I8_WINV);
}
constexpr int FFN_ITEMS8 = 3 * 8 * (FF / 32);
__device__ __forceinline__ void conv_ffn_item_f8(Frame& F, const float* wg, const float* wu, const float* wd, unsigned char* gu, unsigned char* dn, int r) {
    constexpr int I_G = 8 * (FF / 32);
    static_assert((FF / 128) * (D / 32) == I_G, "down items");
    if (r < I_G) { const int kb = r / (FF / 32), nb = r % (FF / 32), n0 = nb * 32; tr_item_i8(wg, FF, kb * 128, n0, gu, D, (n0 / 128) * 256 + (n0 % 128), F.lane); return; } r -= I_G;
    if (r < I_G) { const int kb = r / (FF / 32), nb = r % (FF / 32), n0 = nb * 32; tr_item_i8(wu, FF, kb * 128, n0, gu, D, (n0 / 128) * 256 + 128 + (n0 % 128), F.lane); return; } r -= I_G;
    { const int kb = r / 32, nb = r % 32; tr_item_f8(wd, D, kb * 128, nb * 32, dn, FF, nb * 32, F.lane, F8_SW); }
}

template <int MODE>
__device__ __forceinline__ void norm_phase(Frame& F, const float* xin, const float* gain, const float* w8src, int w8ld) {
    bf16* XN = (bf16*)(F.ws + WS_XN);
    f32x4 gv[4];
#pragma unroll
    for (int j = 0; j < 4; ++j) { gv[j] = *(const f32x4*)(gain + 4 * F.lane + 256 * j); }
    float w8[4][4][8];
    if constexpr (MODE == 0 || MODE == 2) {
#pragma unroll
        for (int j = 0; j < 4; ++j)
#pragma unroll
            for (int q = 0; q < 4; ++q) { const float* s = w8src + (size_t)(4 * F.lane + 256 * j + q) * w8ld; const f32x4 a = *(const f32x4*)s, b = *(const f32x4*)(s + 4);
                w8[j][q][0] = a[0]; w8[j][q][1] = a[1]; w8[j][q][2] = a[2]; w8[j][q][3] = a[3]; w8[j][q][4] = b[0]; w8[j][q][5] = b[1]; w8[j][q][6] = b[2]; w8[j][q][7] = b[3]; }
    }
    LAS int* cnt = (LAS int*)(F.lds);
    for (int p = F.vcu; p < M / 256; p += F.G) {
        if constexpr (MODE == 2) { if (F.tid < 16) cnt[F.tid] = 0; __syncthreads(); }
        f32x4 nx[4][4];
#pragma unroll
        for (int r = 0; r < 4; ++r) { const GAS f32x4* xr = (const GAS f32x4*)(xin + (size_t)(p * 256 + r * 8 + F.wave) * D) + F.lane;
#pragma unroll
            for (int j = 0; j < 4; ++j) nx[r][j] = __builtin_nontemporal_load(&xr[64 * j]); }
#pragma unroll 4
        for (int i = 0; i < 32; ++i) {
            const int m = p * 256 + i * 8 + F.wave;
            f32x4 v[4]; float s = 0.f;
            if constexpr (MODE == 3) {
                const GAS v2u* tr = (const GAS v2u*)(XN + (size_t)m * D) + F.lane;
#pragma unroll
                for (int j = 0; j < 4; ++j) { const v2u t2 = __builtin_nontemporal_load(&tr[64 * j]); nx[i & 3][j] += (f32x4){bf_lo(t2.x), bf_hi(t2.x), bf_lo(t2.y), bf_hi(t2.y)}; } }
#pragma unroll
            for (int j = 0; j < 4; ++j) { v[j] = nx[i & 3][j]; s += (v[j].x * v[j].x + v[j].y * v[j].y) + (v[j].z * v[j].z + v[j].w * v[j].w); }
            if (i + 4 < 32) { const GAS f32x4* xr = (const GAS f32x4*)(xin + (size_t)(m + 32) * D) + F.lane;
#pragma unroll
                for (int j = 0; j < 4; ++j) nx[i & 3][j] = __builtin_nontemporal_load(&xr[64 * j]); }
            const float rstd = 1.0f / sqrtf(wave_sum(s) * (1.f / D) + 1e-6f);
#pragma unroll
            for (int j = 0; j < 4; ++j) v[j] = v[j] * rstd * gv[j];
            if constexpr (MODE == 3) { GAS f32x4* o = (GAS f32x4*)(F.out + (size_t)m * D) + F.lane;
#pragma unroll
                for (int j = 0; j < 4; ++j) __builtin_nontemporal_store(v[j], &o[64 * j]);
            } else if constexpr (MODE == 1 || MODE == 2) {
                float am = 0.f;
#pragma unroll
                for (int j = 0; j < 4; ++j) am = fmaxf(fmaxf(am, fmaxf(fabsf(v[j].x), fabsf(v[j].y))), fmaxf(fabsf(v[j].z), fabsf(v[j].w)));
                am = fmaxf(wave_max(am), 1e-20f);
                const float qi = 127.f * __builtin_amdgcn_rcpf(am);
                if (F.lane == 0) ((float*)(F.ws + WS_RS))[m] = am * (1.f / 127.f);
                GAS unsigned* o4 = (GAS unsigned*)((unsigned char*)XN + (size_t)m * D) + F.lane;
#pragma unroll
                for (int j = 0; j < 4; ++j) o4[64 * j] = q8x4(v[j].x * qi, v[j].y * qi, v[j].z * qi, v[j].w * qi);
            } else { GAS v2u* o8 = (GAS v2u*)(XN + (size_t)m * D) + F.lane;
#pragma unroll
                for (int j = 0; j < 4; ++j) { v2u w; w.x = pk2(v[j].x, v[j].y); w.y = pk2(v[j].z, v[j].w); o8[64 * j] = w; } }
            if constexpr (MODE == 0 || MODE == 2) {
                f32x2 pa2[4];
#pragma unroll
                for (int e2 = 0; e2 < 4; ++e2) pa2[e2] = (f32x2){0.f, 0.f};
#pragma unroll
                for (int j = 0; j < 4; ++j)
#pragma unroll
                    for (int q = 0; q < 4; ++q) { const float vv = v[j][q]; const f32x2 v2 = {vv, vv};
#pragma unroll
                        for (int e2 = 0; e2 < 4; ++e2) pa2[e2] += v2 * (f32x2){w8[j][q][2 * e2], w8[j][q][2 * e2 + 1]}; }
                const float pa[8] = {pa2[0][0], pa2[0][1], pa2[1][0], pa2[1][1], pa2[2][0], pa2[2][1], pa2[3][0], pa2[3][1]};
                const float tot = reduce8(pa, F.lane);
                if constexpr (MODE == 0) { if (F.lane < 8) ((float*)(F.ws + WS_AB))[(size_t)m * 8 + F.lane] = tot; }
                else {
                    float pr[8];
#pragma unroll
                    for (int e = 0; e < 8; ++e) pr[e] = __builtin_bit_cast(float, __builtin_amdgcn_readlane(__builtin_bit_cast(int, tot), e));
                    float b1 = pr[0]; int e1 = 0;
#pragma unroll
                    for (int e = 1; e < 8; ++e) if (pr[e] > b1) { b1 = pr[e]; e1 = e; }
                    float b2 = -3.0e38f; int e2 = 0;
#pragma unroll
                    for (int e = 0; e < 8; ++e) if (e != e1 && pr[e] > b2) { b2 = pr[e]; e2 = e; }
                    const float g1 = 1.0f / (1.0f + __expf(b2 - b1));
                    if (F.lane == 0) { ((int*)(F.ws + WS_RE))[m] = e1 | (e2 << 4); ((float*)(F.ws + WS_RG))[m] = g1; __hip_atomic_fetch_add(&cnt[e1], 1, __ATOMIC_RELAXED, __HIP_MEMORY_SCOPE_WORKGROUP); __hip_atomic_fetch_add(&cnt[8 + e2], 1, __ATOMIC_RELAXED, __HIP_MEMORY_SCOPE_WORKGROUP); }
                }
            }
        }
        if constexpr (MODE == 2) { __syncthreads(); if (F.tid < 16) ((int*)(F.ws + WS_WGCNT))[p * 16 + F.tid] = cnt[F.tid]; __syncthreads(); }
    }
}

__device__ __forceinline__ void route_scatter(Frame& F) {
    LAS int* sh = (LAS int*)F.lds;
    const int* wgcnt = (const int*)(F.ws + WS_WGCNT);
    int* list = (int*)(F.ws + WS_LIST); float* gatel = (float*)(F.ws + WS_GATEL); int* grp = (int*)(F.ws + WS_GRP); float* rsl = (float*)(F.ws + WS_RSL); const float* rsv = (const float*)(F.ws + WS_RS);
    const int* re = (const int*)(F.ws + WS_RE); const float* rg = (const float*)(F.ws + WS_RG);
    for (int p = F.vcu; p < M / 256; p += F.G) {
        __syncthreads();
        { const int g = F.tid & 15, part = F.tid >> 4; int tot = 0, pre = 0;
#pragma unroll
          for (int j = 0; j < 8; ++j) { const int q = part * 8 + j; const int c = wgcnt[q * 16 + g]; pre += (q < p) ? c : 0; tot += c; }
          sh[128 + part * 16 + g] = tot; sh[128 + 512 + part * 16 + g] = pre; }
        __syncthreads();
        if (F.tid < 16) { int tot = 0, pre = 0; for (int q = 0; q < 32; ++q) { tot += sh[128 + q * 16 + F.tid]; pre += sh[128 + 512 + q * 16 + F.tid]; } sh[F.tid] = tot; sh[16 + F.tid] = pre; }
        __syncthreads();
        if (F.tid == 0) { int b = 0; for (int g = 0; g < 16; ++g) { sh[32 + g] = b; b += (sh[g] + 255) & ~255; } sh[48] = b; }
        __syncthreads();
        if (p == 0) {
            if (F.tid <= 16) grp[F.tid] = sh[32 + F.tid];
            if (F.tid < 16) grp[17 + F.tid] = sh[F.tid];
            for (int g = 0; g < 16; ++g) { const int lo = sh[32 + g] + sh[g], hi = sh[32 + g + 1]; for (int q = lo + F.tid; q < hi; q += NWAVES * 64) { list[q] = -1; gatel[q] = 0.f; rsl[q] = 0.f; } }
        }
        int e1 = 0, e2 = 0; float g1 = 0.f; int r1 = 0, r2 = 0;
        if (F.tid < 256) {
            const int m = p * 256 + F.tid; const int ee = re[m]; e1 = ee & 15; e2 = ee >> 4; g1 = rg[m];
#pragma unroll
            for (int e = 0; e < 8; ++e) {
                const unsigned long long m1 = __ballot(e1 == e), m2 = __ballot(e2 == e); const unsigned long long lt = (1ull << F.lane) - 1ull;
                if (e1 == e) r1 = __popcll(m1 & lt); if (e2 == e) r2 = __popcll(m2 & lt);
                if (F.lane == 0) { sh[64 + F.wave * 16 + e] = __popcll(m1); sh[64 + F.wave * 16 + 8 + e] = __popcll(m2); }
            }
        }
        __syncthreads();
        if (F.tid < 256) {
            const int m = p * 256 + F.tid; int o1 = sh[32 + e1] + sh[16 + e1] + r1, o2 = sh[32 + 8 + e2] + sh[16 + 8 + e2] + r2;
            for (int w = 0; w < F.wave; ++w) { o1 += sh[64 + w * 16 + e1]; o2 += sh[64 + w * 16 + 8 + e2]; }
            const float sm = rsv[m];
            list[o1] = m; gatel[o1] = g1; rsl[o1] = sm; list[o2] = m; gatel[o2] = 1.0f - g1; rsl[o2] = sm;
        }
    }
}

constexpr int CH = 16, NCH = T / CH;
constexpr int RW_BYTES = 60736;
static_assert(2 * RW_BYTES <= RING_BYTES, "rwkv lds");
constexpr int XA_PITCH = 528;

typedef short bf16x4 __attribute__((ext_vector_type(4)));
#define MFMA32(a, b, c) __builtin_amdgcn_mfma_f32_16x16x32_bf16(a, b, c, 0, 0, 0)
#define MFMA16(a, b, c) __builtin_amdgcn_mfma_f32_16x16x16bf16_1k(a, b, c, 0, 0, 0)
__device__ __forceinline__ unsigned cvt2(float a, float b) { const f32x2 v = {a, b}; const bf16v2_t r = __builtin_convertvector(v, bf16v2_t); return __builtin_bit_cast(unsigned, r); }
__device__ __forceinline__ bf16x4 pack4(float a, float b, float c, float d) { v2u w; w.x = cvt2(a, b); w.y = cvt2(c, d); return __builtin_bit_cast(bf16x4, w); }
__device__ __forceinline__ bf16x8 pack8(const f32x4 a, const f32x4 b) { v4u w; w.x = cvt2(a[0], a[1]); w.y = cvt2(a[2], a[3]); w.z = cvt2(b[0], b[1]); w.w = cvt2(b[2], b[3]); return __builtin_bit_cast(bf16x8, w); }
#define WAVE_LDS_FENCE() asm volatile("s_waitcnt lgkmcnt(0)" ::: "memory")
constexpr int G2_KI = 0, G2_QI = 17408, G2_KT = 34816, G2_VT = 53248, G2_GR = 71680, G2_BE = 71936, G2_GC = 72192, G2_NM = 72448, G2_TI = 76544, G2_O = 79104, G2_CW = G2_O + 64 * 528, G2_BYTES = G2_CW + 4 * 384 * 4;
constexpr int G2_IP = 272, G2_TP = 144, G2_TIP = 40, G2_OP = 132;
static_assert(G2_BYTES <= RING_BYTES, "gdn lds");
constexpr int GB = 64, NGB = T / GB;

__device__ __forceinline__ void gdn_unit2(Frame& F, const Args& A_, int layer, int u) {
    const int b = u >> 2, h = u & 3, tid = F.tid, lane = F.lane, w = F.wave, c = lane & 15, g = lane >> 4;
    LAS unsigned char* L = F.lds;
    LAS float* GR = (LAS float*)(L + G2_GR); LAS float* BE = (LAS float*)(L + G2_BE); LAS float* GC = (LAS float*)(L + G2_GC); LAS float* NM = (LAS float*)(L + G2_NM); LAS float* Om = (LAS float*)(L + G2_O);
    const bf16* PROJ = (const bf16*)(F.ws + WS_PROJ);
    bf16* OUT = (bf16*)(F.ws + WS_XN);
    const float* AB = (const float*)(F.ws + WS_AB);
    const int part = g, cg = c;
    const int colbase = (part == 0 ? C_GQ : (part == 1 ? C_GK : C_GV)) + h * 128 + 8 * cg;
    LAS float* CW = (LAS float*)(L + G2_CW);
    for (int idx = tid; idx < 4 * 384; idx += NWAVES * 64) { const int j = idx / 384, cc = idx % 384; CW[idx] = A_.in[15][(size_t)layer * 4 * 1536 + j * 1536 + (cc >> 7) * 512 + h * 128 + (cc & 127)]; }
    const int cwoff = (part < 3 ? part : 0) * 128 + 8 * cg;
    __syncthreads();
    const float nexpa = -__expf(A_.in[16][layer * 4 + h]), dtb = A_.in[17][layer * 4 + h];
    const int d0 = (8 * cg) & 31, pc0 = (8 * cg & ~31) + 8 * ((d0 >> 2) & 3) + 4 * (d0 >> 4);
    const int ptok = tid >> 3, pch = (tid & 7) * 16;
    f32x4 S[8];
#pragma unroll
    for (int m = 0; m < 8; ++m) S[m] = (f32x4){0.f, 0.f, 0.f, 0.f};
    v4u pre[11]; v4u zpre[2]; float abpre[2];
    auto prefetch = [&](int bt) {
        const int tb = bt * GB;
#pragma unroll
        for (int i = 0; i < 11; ++i) { const int tok = tb + 8 * w - 3 + i; pre[i] = (v4u){0u, 0u, 0u, 0u};
            if (part < 3 && tok >= 0) pre[i] = *(const GAS v4u*)(PROJ + (size_t)(b * T + tok) * NPROJ + colbase); }
        abpre[0] = 0.f; abpre[1] = 0.f;
        if (part == 3 && cg < 8) { const float* ab = AB + (size_t)(b * T + tb + 8 * w + cg) * 8; abpre[0] = ab[h]; abpre[1] = ab[4 + h]; }
    };
    prefetch(0);
    for (int bt = 0; bt < NGB; ++bt) {
        const int tb = bt * GB;
        if (!(PADF & 4)) {
            unsigned ktp[8][4];
            float xr[4][8];
#pragma unroll
            for (int i = 0; i < 3; ++i) { xr[i][0] = bf_lo(pre[i].x); xr[i][1] = bf_hi(pre[i].x); xr[i][2] = bf_lo(pre[i].y); xr[i][3] = bf_hi(pre[i].y); xr[i][4] = bf_lo(pre[i].z); xr[i][5] = bf_hi(pre[i].z); xr[i][6] = bf_lo(pre[i].w); xr[i][7] = bf_hi(pre[i].w); }
            float yprev[8];
#pragma unroll
            for (int tk = 0; tk < 8; ++tk) {
                const v4u pw = pre[tk + 3];
                xr[3][0] = bf_lo(pw.x); xr[3][1] = bf_hi(pw.x); xr[3][2] = bf_lo(pw.y); xr[3][3] = bf_hi(pw.y); xr[3][4] = bf_lo(pw.z); xr[3][5] = bf_hi(pw.z); xr[3][6] = bf_lo(pw.w); xr[3][7] = bf_hi(pw.w);
                float y[8]; float ss = 0.f;
#pragma unroll
                for (int e = 0; e < 8; ++e) y[e] = 0.f;
#pragma unroll
                for (int j = 0; j < 4; ++j) { const f32x4 wa = *(const LAS f32x4*)(CW + j * 384 + cwoff), wb = *(const LAS f32x4*)(CW + j * 384 + cwoff + 4);
#pragma unroll
                    for (int e = 0; e < 4; ++e) { y[e] += wa[e] * xr[j][e]; y[4 + e] += wb[e] * xr[j][4 + e]; } }
#pragma unroll
                for (int e = 0; e < 8; ++e) { const float a = y[e]; y[e] = a * sigmoidf_(a); ss += y[e] * y[e]; }
                ss = sum16(ss);
                const float sc = part == 2 ? 1.0f : (__builtin_amdgcn_rsqf(ss + 1e-6f)) * (part == 0 ? 0.08838834764831845f : 1.0f);
#pragma unroll
                for (int e = 0; e < 8; ++e) y[e] *= sc;
                const int trow = 8 * w + tk;
                if (part < 2) { LAS unsigned char* img = L + (part == 0 ? G2_QI : G2_KI) + trow * G2_IP;
                    v2u a0; a0.x = pg8::cvt_pk_bf16(y[0], y[1]); a0.y = pg8::cvt_pk_bf16(y[2], y[3]); v2u a1; a1.x = pg8::cvt_pk_bf16(y[4], y[5]); a1.y = pg8::cvt_pk_bf16(y[6], y[7]);
                    *(LAS v2u*)(img + pc0 * 2) = a0; *(LAS v2u*)(img + (pc0 + 8) * 2) = a1; }
                if (tk & 1) {
#pragma unroll
                    for (int e = 0; e < 8; ++e) ktp[e][tk >> 1] = pg8::cvt_pk_bf16(yprev[e], y[e]); }
#pragma unroll
                for (int e = 0; e < 8; ++e) yprev[e] = y[e];
#pragma unroll
                for (int e = 0; e < 8; ++e) { xr[0][e] = xr[1][e]; xr[1][e] = xr[2][e]; xr[2][e] = xr[3][e]; }
            }
            if (part == 1 || part == 2) { LAS unsigned char* timg = L + (part == 1 ? G2_KT : G2_VT);
#pragma unroll
                for (int e = 0; e < 8; ++e) { v4u o; o.x = ktp[e][0]; o.y = ktp[e][1]; o.z = ktp[e][2]; o.w = ktp[e][3]; *(LAS v4u*)(timg + (8 * cg + e) * G2_TP + (8 * w) * 2) = o; } }
            if (part == 3 && cg < 8) { GR[8 * w + cg] = nexpa * softplusf_(abpre[0] + dtb); BE[8 * w + cg] = sigmoidf_(abpre[1]); }
        }
        __syncthreads();
        if (bt + 1 < NGB) prefetch(bt + 1);
        { const bf16* zp = PROJ + (size_t)(b * T + tb + ptok) * NPROJ + C_Z + h * 128 + pch; zpre[0] = *(const GAS v4u*)zp; zpre[1] = *(const GAS v4u*)(zp + 8); }
        if (w < 4 && !(PADF & 8)) {
            const int i = w;
            float gv = GR[16 * i + c];
#pragma unroll
            for (int o = 1; o < 16; o <<= 1) { const float t_ = __shfl_up(gv, o, 16); if (c >= o) gv += t_; }
            if (g == 0) GC[16 * i + c] = gv;
            f32x4 acc = (f32x4){0.f, 0.f, 0.f, 0.f};
            const LAS unsigned char* rowK = L + G2_KI + (16 * i + c) * G2_IP + g * 16;
#pragma unroll
            for (int s = 0; s < 4; ++s) { const bf16x8 f = *(const LAS bf16x8*)(rowK + 64 * s); acc = MFMA32(f, f, acc); }
            WAVE_LDS_FENCE();
            const f32x4 gct = *(const LAS f32x4*)(GC + 16 * i + 4 * g), bet = *(const LAS f32x4*)(BE + 16 * i + 4 * g);
#pragma unroll
            for (int r = 0; r < 4; ++r) { const int t_ = 4 * g + r; NM[i * 256 + t_ * 16 + c] = (c < t_) ? -bet[r] * acc[r] * __expf(fminf(gct[r] - gv, 0.f)) : 0.f; }
            WAVE_LDS_FENCE();
            float Tc[16];
#pragma unroll
            for (int t_ = 0; t_ < 16; ++t_) { float a = (t_ == c) ? 1.f : 0.f;
#pragma unroll
                for (int q4 = 0; q4 * 4 < t_; ++q4) { const f32x4 n4 = *(const LAS f32x4*)(NM + i * 256 + t_ * 16 + 4 * q4);
#pragma unroll
                    for (int e = 0; e < 4; ++e) if (4 * q4 + e < t_) a += n4[e] * Tc[4 * q4 + e]; }
                Tc[t_] = a; }
            if (g == 0) {
#pragma unroll
                for (int t_ = 0; t_ < 16; ++t_) *(LAS bf16*)(L + G2_TI + i * (16 * G2_TIP) + t_ * G2_TIP + c * 2) = (bf16)f2bf(Tc[t_]); }
        }
        __syncthreads();
#pragma unroll 1
        for (int i = (PADF & 16) ? 4 : 0; i < 4; ++i) {
            const LAS unsigned char* rowK = L + G2_KI + (16 * i + c) * G2_IP + g * 16; const LAS unsigned char* rowQ = L + G2_QI + (16 * i + c) * G2_IP + g * 16;
            bf16x8 kf[4], qf[4];
#pragma unroll
            for (int s = 0; s < 4; ++s) { kf[s] = *(const LAS bf16x8*)(rowK + 64 * s); qf[s] = *(const LAS bf16x8*)(rowQ + 64 * s); }
            const float gcc = GC[16 * i + c], gl = GC[16 * i + 15];
            const f32x4 gcr = *(const LAS f32x4*)(GC + 16 * i + 4 * g), ber = *(const LAS f32x4*)(BE + 16 * i + 4 * g);
            const v2u vw = *(const LAS v2u*)(L + G2_VT + (16 * w + c) * G2_TP + (16 * i + 4 * g) * 2);
            const bf16x4 tf = *(const LAS bf16x4*)(L + G2_TI + i * (16 * G2_TIP) + c * G2_TIP + g * 8);
            f32x4 dq = (f32x4){0.f, 0.f, 0.f, 0.f};
#pragma unroll
            for (int s = 0; s < 4; ++s) dq = MFMA32(kf[s], qf[s], dq);
            bf16x8 Sb[4];
#pragma unroll
            for (int s = 0; s < 4; ++s) Sb[s] = pack8(S[2 * s], S[2 * s + 1]);
            f32x4 y = (f32x4){0.f, 0.f, 0.f, 0.f}, qs = y;
#pragma unroll
            for (int s = 0; s < 4; ++s) y = MFMA32(kf[s], Sb[s], y);
#pragma unroll
            for (int s = 0; s < 4; ++s) qs = MFMA32(qf[s], Sb[s], qs);
            float qa[4], egr[4], xv[4];
            const float vv[4] = {bf_lo(vw.x), bf_hi(vw.x), bf_lo(vw.y), bf_hi(vw.y)};
#pragma unroll
            for (int r = 0; r < 4; ++r) { qa[r] = (4 * g + r <= c) ? dq[r] * __expf(fminf(gcc - gcr[r], 0.f)) : 0.f; egr[r] = __expf(gcr[r]); xv[r] = ber[r] * (vv[r] - egr[r] * y[r]); qs[r] *= egr[r]; }
            const f32x4 vn = MFMA16(tf, pack4(xv[0], xv[1], xv[2], xv[3]), ((f32x4){0.f, 0.f, 0.f, 0.f}));
            const f32x4 o = MFMA16(pack4(qa[0], qa[1], qa[2], qa[3]), pack4(vn[0], vn[1], vn[2], vn[3]), qs);
#pragma unroll
            for (int r = 0; r < 4; ++r) Om[(16 * i + 4 * g + r) * G2_OP + 16 * w + c] = o[r];
            const float egl = __expf(gl);
            const bf16x4 vsb = pack4(vn[0] * __expf(gl - gcr[0]), vn[1] * __expf(gl - gcr[1]), vn[2] * __expf(gl - gcr[2]), vn[3] * __expf(gl - gcr[3]));
#pragma unroll
            for (int m = 0; m < 8; ++m) { const bf16x4 kt = *(const LAS bf16x4*)(L + G2_KT + (16 * m + c) * G2_TP + (16 * i + 4 * g) * 2); S[m] = MFMA16(kt, vsb, S[m] * egl); }
        }
        __syncthreads();
        if (!(PADF & 32)) {
            f32x4 o4[4]; float ss = 0.f;
#pragma unroll
            for (int q = 0; q < 4; ++q) { o4[q] = *(const LAS f32x4*)(Om + ptok * G2_OP + pch + 4 * q); ss += (o4[q][0] * o4[q][0] + o4[q][1] * o4[q][1]) + (o4[q][2] * o4[q][2] + o4[q][3] * o4[q][3]); }
            ss = sum8(ss);
            const float rs = __builtin_amdgcn_rsqf(ss * (1.f / 128.f) + 1e-6f);
            const float* gp = A_.in[18] + layer * 128 + pch;
            const unsigned zz[8] = {zpre[0].x, zpre[0].y, zpre[0].z, zpre[0].w, zpre[1].x, zpre[1].y, zpre[1].z, zpre[1].w};
            unsigned ow[8];
#pragma unroll
            for (int q = 0; q < 4; ++q) { const f32x4 gq = *(const f32x4*)(gp + 4 * q);
                const float za = bf_lo(zz[2 * q]), zb = bf_hi(zz[2 * q]), zc = bf_lo(zz[2 * q + 1]), zd = bf_hi(zz[2 * q + 1]);
                ow[2 * q] = pk2(o4[q][0] * rs * gq[0] * za * sigmoidf_(za), o4[q][1] * rs * gq[1] * zb * sigmoidf_(zb));
                ow[2 * q + 1] = pk2(o4[q][2] * rs * gq[2] * zc * sigmoidf_(zc), o4[q][3] * rs * gq[3] * zd * sigmoidf_(zd)); }
            bf16* op = OUT + (size_t)(b * T + tb + ptok) * D + 512 + h * 128 + pch;
            *(GAS v4u*)op = (v4u){ow[0], ow[1], ow[2], ow[3]}; *(GAS v4u*)(op + 8) = (v4u){ow[4], ow[5], ow[6], ow[7]};
        }
    }
    __syncthreads();
}

constexpr int R2_AI = 0, R2_BI = 2304, R2_KI = 4608, R2_RI = 6912, R2_VI = 9216, R2_W15 = 16896;
constexpr int R2_IP = 144, R2_TP = 40;
constexpr int R3_XA = 0, R3_R = 8448, R3_KM = 12544, R3_V = 16640, R3_LW = 20736, R3_AV = 24832, R3_G = 28928, R3_O = 33024, R3_BON = 37120, R3_MU = 37184, R3_IMG = 38976;
static_assert(R3_IMG + R2_W15 + 256 <= RW_BYTES && R3_R + 32768 <= RW_BYTES, "rwkv lds map");
__device__ __forceinline__ float fast_tanh(float x) { const float e = __expf(2.0f * x); return 1.0f - 2.0f * __builtin_amdgcn_rcpf(e + 1.0f); }
__device__ __forceinline__ float fast_softplus(float x) { return x > 20.f ? x : __logf(1.0f + __expf(x)); }
__device__ __forceinline__ bf16x4 pack4v(const f32x4 v) { return pack4(v[0], v[1], v[2], v[3]); }

__device__ __forceinline__ void rwkv_pair2(Frame& F, const Args& A_, int layer, int pairidx) {
    const int half = F.wave >> 2, wq = F.wave & 3, ht = F.tid & 255, lane = F.lane, c = lane & 15, g = lane >> 4;
    const int h = 2 * (pairidx & 3) + half, b = pairidx >> 2;
    LAS unsigned char* L = F.lds + half * RW_BYTES;
    LAS float* Rm = (LAS float*)(L + R3_R); LAS float* KM = (LAS float*)(L + R3_KM); LAS float* Vm = (LAS float*)(L + R3_V); LAS float* LW = (LAS float*)(L + R3_LW);
    LAS float* AV = (LAS float*)(L + R3_AV); LAS float* Gm = (LAS float*)(L + R3_G);
    LAS float* Om = (LAS float*)(L + R3_O); LAS float* BON = (LAS float*)(L + R3_BON); LAS float* MU = (LAS float*)(L + R3_MU);
    LAS unsigned char* IM = L + R3_IMG;
    const bf16* PROJ = (const bf16*)(F.ws + WS_PROJ);
    bf16* OUT = (bf16*)(F.ws + WS_XN);
    const int jc = 16 * wq + c, kg = g, hj = h * 64 + jc;
    bf16x8 bd[2], bi[2], bg[4];
    {
        const float* Wd = A_.in[5] + (size_t)layer * 64 * 512 + h * 64; const float* Wi = A_.in[7] + (size_t)layer * 64 * 512 + h * 64; const float* Wg = A_.in[8] + (size_t)layer * 128 * 512 + h * 64;
        LAS bf16* WT = (LAS bf16*)(L + R3_R);
#pragma unroll 1
        for (int idx = ht; idx < 4096; idx += 256) { const int k = idx >> 6, j = idx & 63; WT[j * 64 + k] = (bf16)f2bf(Wd[(size_t)k * 512 + j]); WT[4096 + j * 64 + k] = (bf16)f2bf(Wi[(size_t)k * 512 + j]); }
#pragma unroll 1
        for (int idx = ht; idx < 8192; idx += 256) { const int k = idx >> 6, j = idx & 63; WT[8192 + j * 128 + k] = (bf16)f2bf(Wg[(size_t)k * 512 + j]); }
        __syncthreads();
#pragma unroll
        for (int s = 0; s < 2; ++s) { bd[s] = *(const LAS bf16x8*)(WT + jc * 64 + 32 * s + 8 * kg); bi[s] = *(const LAS bf16x8*)(WT + 4096 + jc * 64 + 32 * s + 8 * kg); }
#pragma unroll
        for (int s = 0; s < 4; ++s) bg[s] = *(const LAS bf16x8*)(WT + 8192 + jc * 128 + 32 * s + 8 * kg);
        __syncthreads();
    }
    const float w0c = A_.in[4][layer * 512 + hj], a0c = A_.in[6][layer * 512 + hj];
    const int tid = F.tid;
    const int atok = tid >> 5, apc = tid & 31;
    int bun[2], btok[2], bpc[2]; bool bval[2];
#pragma unroll
    for (int j = 0; j < 2; ++j) { const int idx = tid + 512 * j; bval[j] = idx < 768; const int ii = bval[j] ? idx : 0; bun[j] = ii / 384; const int rem = ii - 384 * bun[j]; btok[j] = rem / 24; bpc[j] = rem - 24 * btok[j]; }
    f32x4 amu[2], bmu[2][2];
    { const float* mup = A_.in[3] + layer * 1792;
      amu[0] = *(const f32x4*)(mup + C_WL + 8 * apc); amu[1] = *(const f32x4*)(mup + C_WL + 8 * apc + 4);
#pragma unroll
      for (int j = 0; j < 2; ++j) { const int hh = 2 * (pairidx & 3) + bun[j]; const int col = (bpc[j] < 8 ? C_R : (bpc[j] < 16 ? C_K : C_V)) + hh * 64 + 8 * (bpc[j] & 7);
          bmu[j][0] = *(const f32x4*)(mup + col); bmu[j][1] = *(const f32x4*)(mup + col + 4); } }
    const bool a_th = apc < 8, a_id = apc >= 8 && apc < 16;
    constexpr size_t CHB = (size_t)CH * NPROJ * 2;
    const size_t aoff = ((size_t)(b * T + atok) * NPROJ + C_WL + 8 * apc) * 2;
    size_t boff[2]; unsigned bdst[2];
#pragma unroll
    for (int j = 0; j < 2; ++j) { const int hh = 2 * (pairidx & 3) + bun[j]; const int col = (bpc[j] < 8 ? C_R : (bpc[j] < 16 ? C_K : C_V)) + hh * 64 + 8 * (bpc[j] & 7);
        boff[j] = ((size_t)(b * T + btok[j]) * NPROJ + col) * 2;
        bdst[j] = (unsigned)(bun[j] * RW_BYTES + (bpc[j] < 8 ? R3_R : (bpc[j] < 16 ? R3_KM : R3_V)) + (btok[j] * 64 + 8 * (bpc[j] & 7)) * 4); }
    const unsigned adst = (unsigned)(R3_XA + atok * XA_PITCH + apc * 16);
    const int tt = ht >> 4, jq = (ht & 15) * 4;
    const f32x4 kkv = *(const f32x4*)(A_.in[9] + layer * 512 + h * 64 + jq), kav = *(const f32x4*)(A_.in[10] + layer * 512 + h * 64 + jq), rkv = *(const f32x4*)(A_.in[11] + layer * 512 + h * 64 + jq);
    const f32x4 lgv = *(const f32x4*)(A_.in[12] + layer * 512 + h * 64 + jq), lbv = *(const f32x4*)(A_.in[13] + layer * 512 + h * 64 + jq);
    const int pimg = (jq & ~31) + 8 * (((jq & 31) >> 2) & 3) + 4 * ((jq & 31) >> 4);
    bf16x4 ltri;
#pragma unroll
    for (int j = 0; j < 4; ++j) ltri[j] = (4 * g + j <= c) ? (short)0x3F80 : (short)0;
    f32x4 P[4];
#pragma unroll
    for (int m = 0; m < 4; ++m) P[m] = (f32x4){0.f, 0.f, 0.f, 0.f};
    struct PF { v4u acur, aprv, bcur[2], bprv[2]; };
    PF pf0, pf1;
    auto prefetch = [&](int ch, PF& q_) {
        const char* base = (const char*)PROJ + (size_t)ch * CHB;
        { const bool first = (ch == 0 && atok == 0); const char* p = base + aoff; q_.acur = *(const GAS v4u*)p; q_.aprv = *(const GAS v4u*)(first ? p : p - NPROJ * 2); }
#pragma unroll
        for (int j = 0; j < 2; ++j) { const bool first = (ch == 0 && btok[j] == 0); const char* p = base + boff[j]; q_.bcur[j] = *(const GAS v4u*)p; q_.bprv[j] = *(const GAS v4u*)(first ? p : p - NPROJ * 2); }
    };
    prefetch(0, pf0); prefetch(1, pf1);
    auto do_chunk = [&](const int ch, PF& q_) __attribute__((always_inline)) {
        const int t0 = ch * CH;
        v4u acur = q_.acur, aprv = q_.aprv, bcur[2] = {q_.bcur[0], q_.bcur[1]}, bprv[2] = {q_.bprv[0], q_.bprv[1]};
        if (ch == 0) {
            if (atok == 0) aprv = (v4u){0u, 0u, 0u, 0u};
#pragma unroll
            for (int j = 0; j < 2; ++j) if (btok[j] == 0) bprv[j] = (v4u){0u, 0u, 0u, 0u};
        }
        if (!(PADF & 64)) {
#define RW_UNPACK(W_, X_) const float X_[8] = {bf_lo((W_)[0]), bf_hi((W_)[0]), bf_lo((W_)[1]), bf_hi((W_)[1]), bf_lo((W_)[2]), bf_hi((W_)[2]), bf_lo((W_)[3]), bf_hi((W_)[3])}
            { RW_UNPACK(acur, xc); RW_UNPACK(aprv, xp);
              const float be = a_th ? 2.f : 1.f, ga = a_th ? -1.f : 0.f;
              float y[8];
#pragma unroll
              for (int e = 0; e < 8; ++e) { const float val = xc[e] + (xp[e] - xc[e]) * (e < 4 ? amu[0][e] : amu[1][e - 4]); const float sg = __builtin_amdgcn_rcpf(1.0f + __expf(-be * val)); y[e] = a_id ? val : be * sg + ga; }
              v4u o; o.x = pk2(y[0], y[1]); o.y = pk2(y[2], y[3]); o.z = pk2(y[4], y[5]); o.w = pk2(y[6], y[7]);
              *(LAS v4u*)(F.lds + adst) = o; }
#pragma unroll
            for (int j = 0; j < 2; ++j) if (bval[j]) { RW_UNPACK(bcur[j], xc); RW_UNPACK(bprv[j], xp);
                float val[8];
#pragma unroll
                for (int e = 0; e < 8; ++e) val[e] = xc[e] + (xp[e] - xc[e]) * (e < 4 ? bmu[j][0][e] : bmu[j][1][e - 4]);
                LAS float* dst = (LAS float*)(F.lds + bdst[j]);
                *(LAS f32x4*)dst = (f32x4){val[0], val[1], val[2], val[3]}; *(LAS f32x4*)(dst + 4) = (f32x4){val[4], val[5], val[6], val[7]}; }
#undef RW_UNPACK
        }
        if (ch + 2 < NCH) prefetch(ch + 2, q_);
        __syncthreads();
        if (!(PADF & 128)) {
            f32x4 ad = (f32x4){0.f, 0.f, 0.f, 0.f}, aa = ad, ag = ad;
            const LAS unsigned char* xa = F.lds + R3_XA + c * XA_PITCH + kg * 16;
#pragma unroll
            for (int s = 0; s < 2; ++s) ad = MFMA32(*(const LAS bf16x8*)(xa + s * 64), bd[s], ad);
#pragma unroll
            for (int s = 0; s < 2; ++s) aa = MFMA32(*(const LAS bf16x8*)(xa + 128 + s * 64), bi[s], aa);
#pragma unroll
            for (int s = 0; s < 4; ++s) ag = MFMA32(*(const LAS bf16x8*)(xa + 256 + s * 64), bg[s], ag);
            f32x4 lwv;
#pragma unroll
            for (int r = 0; r < 4; ++r) { const int t = 4 * kg + r;
                lwv[r] = -0.60653065971f * sigmoidf_(w0c + ad[r]);
                AV[t * 64 + jc] = sigmoidf_(a0c + aa[r]); Gm[t * 64 + jc] = ag[r]; }
            { const bf16x4 hi = pack4v(lwv); const v2u hw = __builtin_bit_cast(v2u, hi);
              const f32x4 lo = lwv - (f32x4){bf_lo(hw.x), bf_hi(hw.x), bf_lo(hw.y), bf_hi(hw.y)};
              f32x4 cs = MFMA16(ltri, hi, ((f32x4){0.f, 0.f, 0.f, 0.f})); cs = MFMA16(ltri, pack4v(lo), cs);
#pragma unroll
              for (int r = 0; r < 4; ++r) LW[(4 * kg + r) * 64 + jc] = cs[r]; }
        }
        __syncthreads();
        if (!(PADF & 256)) {
            const f32x4 k4 = *(const LAS f32x4*)(KM + tt * 64 + jq), a4 = *(const LAS f32x4*)(AV + tt * 64 + jq), r4 = *(const LAS f32x4*)(Rm + tt * 64 + jq), v4 = *(const LAS f32x4*)(Vm + tt * 64 + jq);
            const f32x4 cl = *(const LAS f32x4*)(LW + tt * 64 + jq);
            f32x4 clp = *(const LAS f32x4*)(LW + (tt > 0 ? tt - 1 : 0) * 64 + jq); if (tt == 0) clp = (f32x4){0.f, 0.f, 0.f, 0.f};
            const f32x4 kr = k4 * kkv; float ss = (kr[0] * kr[0] + kr[1] * kr[1]) + (kr[2] * kr[2] + kr[3] * kr[3]);
            ss = sum16(ss);
            const float inv = __builtin_amdgcn_rsqf(ss + 1e-6f);
            const f32x4 kk = kr * inv; const f32x4 km = k4 * (1.0f + (a4 - 1.0f) * kav);
            float bo = (r4[0] * km[0] * rkv[0] + r4[1] * km[1] * rkv[1]) + (r4[2] * km[2] * rkv[2] + r4[3] * km[3] * rkv[3]);
            bo = sum16(bo);
            if ((ht & 15) == 0) BON[tt] = bo;
            f32x4 wt, wi, wp;
#pragma unroll
            for (int e = 0; e < 4; ++e) { wt[e] = __expf(cl[e]); wi[e] = __expf(-cl[e]); wp[e] = __expf(clp[e]); }
            const f32x4 at = -kk * wp, bt = kk * a4 * wi, kt = km * wi, rt = r4 * wt;
            LAS unsigned char* irow = IM + tt * R2_IP + pimg * 2;
            { v2u w; w.x = pk2(at[0], at[1]); w.y = pk2(at[2], at[3]); *(LAS v2u*)(irow + R2_AI) = w; }
            { v2u w; w.x = pk2(bt[0], bt[1]); w.y = pk2(bt[2], bt[3]); *(LAS v2u*)(irow + R2_BI) = w; }
            { v2u w; w.x = pk2(kt[0], kt[1]); w.y = pk2(kt[2], kt[3]); *(LAS v2u*)(irow + R2_KI) = w; }
            { v2u w; w.x = pk2(rt[0], rt[1]); w.y = pk2(rt[2], rt[3]); *(LAS v2u*)(irow + R2_RI) = w; }
            { v2u w; w.x = pk2(v4[0], v4[1]); w.y = pk2(v4[2], v4[3]); *(LAS v2u*)(IM + R2_VI + tt * R2_IP + jq * 2) = w; }
            if (tt == 15) *(LAS f32x4*)(IM + R2_W15 + jq * 4) = wt;
        }
        __syncthreads();
        if (!(PADF & 512)) {
            bf16x8 af[2], bf_[2], kf[2], rf[2];
#pragma unroll
            for (int s = 0; s < 2; ++s) { const LAS unsigned char* p = IM + c * R2_IP + 64 * s + 16 * g;
                af[s] = *(const LAS bf16x8*)(p + R2_AI); bf_[s] = *(const LAS bf16x8*)(p + R2_BI); kf[s] = *(const LAS bf16x8*)(p + R2_KI); rf[s] = *(const LAS bf16x8*)(p + R2_RI); }
            const unsigned trb = (unsigned)(size_t)IM + (unsigned)((4 * g + ((lane >> 2) & 3)) * R2_IP + 16 * (lane & 3));
            const unsigned trv = (unsigned)(size_t)IM + (unsigned)(R2_VI + (4 * g + ((lane >> 2) & 3)) * R2_IP + 8 * (lane & 3) + 32 * wq);
            bf16x4 vt, btm[4], ktm[4];
            asm volatile("ds_read_b64_tr_b16 %0, %9\n\tds_read_b64_tr_b16 %1, %10 offset:%11\n\tds_read_b64_tr_b16 %2, %10 offset:%12\n\tds_read_b64_tr_b16 %3, %10 offset:%13\n\tds_read_b64_tr_b16 %4, %10 offset:%14\n\t"
                         "ds_read_b64_tr_b16 %5, %10 offset:%15\n\tds_read_b64_tr_b16 %6, %10 offset:%16\n\tds_read_b64_tr_b16 %7, %10 offset:%17\n\tds_read_b64_tr_b16 %8, %10 offset:%18\n\ts_waitcnt lgkmcnt(0)"
                         : "=&v"(vt), "=&v"(btm[0]), "=&v"(btm[1]), "=&v"(btm[2]), "=&v"(btm[3]), "=&v"(ktm[0]), "=&v"(ktm[1]), "=&v"(ktm[2]), "=&v"(ktm[3])
                         : "v"(trv), "v"(trb), "i"(R2_BI + 0), "i"(R2_BI + 8), "i"(R2_BI + 64), "i"(R2_BI + 72), "i"(R2_KI + 0), "i"(R2_KI + 8), "i"(R2_KI + 64), "i"(R2_KI + 72) : "memory");
            __builtin_amdgcn_sched_barrier(0);
            const f32x4 zero = (f32x4){0.f, 0.f, 0.f, 0.f};
            f32x4 X0 = zero, Y0 = zero, Dka = zero, Dbr = zero, Dkr = zero;
#pragma unroll
            for (int s = 0; s < 2; ++s) { X0 = MFMA32(af[s], bf_[s], X0); Y0 = MFMA32(bf_[s], af[s], Y0); Dka = MFMA32(kf[s], af[s], Dka); Dbr = MFMA32(bf_[s], rf[s], Dbr); Dkr = MFMA32(kf[s], rf[s], Dkr); }
            f32x4 idn;
#pragma unroll
            for (int r = 0; r < 4; ++r) { const int row = 4 * g + r; idn[r] = (row == c) ? 1.f : 0.f;
                X0[r] = (c < row) ? X0[r] : 0.f;
                Y0[r] = (row < c) ? Y0[r] : 0.f;
                Dka[r] = (row < c) ? Dka[r] : 0.f;
                Dbr[r] = (row <= c) ? Dbr[r] : 0.f; Dkr[r] = (row <= c) ? Dkr[r] : 0.f; }
            const bf16x4 x0b = pack4v(X0), y0b = pack4v(Y0);
            const f32x4 X1 = MFMA16(y0b, x0b, zero), Y1 = MFMA16(x0b, y0b, zero);
            const bf16x4 x1b = pack4v(X1), y1b = pack4v(Y1);
            const f32x4 X2 = MFMA16(y1b, x1b, zero), Y2 = MFMA16(x1b, y1b, zero);
            const bf16x4 x2b = pack4v(X2), y2b = pack4v(Y2);
            const f32x4 X3 = MFMA16(y2b, x2b, zero);
            f32x4 U = Y0 + idn;
            U = MFMA16(pack4v(X1 + idn), pack4v(U), zero);
            U = MFMA16(pack4v(X2 + idn), pack4v(U), zero);
            U = MFMA16(pack4v(X3 + idn), pack4v(U), zero);
            bf16x8 Pb[2];
#pragma unroll
            for (int s = 0; s < 2; ++s) Pb[s] = pack8(P[2 * s], P[2 * s + 1]);
            f32x4 X = zero, O = zero;
#pragma unroll
            for (int s = 0; s < 2; ++s) { X = MFMA32(af[s], Pb[s], X); O = MFMA32(rf[s], Pb[s], O); }
            X = MFMA16(pack4v(Dka), vt, X);
            const f32x4 Z = MFMA16(pack4v(U), pack4v(X), zero);
            const bf16x4 zb = pack4v(Z);
            O = MFMA16(pack4v(Dbr), zb, O);
            O = MFMA16(pack4v(Dkr), vt, O);
#pragma unroll
            for (int r = 0; r < 4; ++r) Om[(4 * g + r) * 64 + 16 * wq + c] = O[r];
#pragma unroll
            for (int m = 0; m < 4; ++m) {
                const f32x4 w15 = *(const LAS f32x4*)(IM + R2_W15 + (16 * m + 4 * g) * 4);
                f32x4 pm = MFMA16(btm[m], zb, P[m]); pm = MFMA16(ktm[m], vt, pm); P[m] = pm * w15; }
        }
        __syncthreads();
        if (!(PADF & 1024)) {
            const f32x4 o4 = *(const LAS f32x4*)(Om + tt * 64 + jq);
            float s1 = sum16((o4[0] + o4[1]) + (o4[2] + o4[3]));
            const float mean = s1 * (1.f / 64.f); const f32x4 d4 = o4 - mean;
            float s2 = sum16((d4[0] * d4[0] + d4[1] * d4[1]) + (d4[2] * d4[2] + d4[3] * d4[3]));
            const float rs = __builtin_amdgcn_rsqf(s2 * (1.f / 64.f) + 64e-5f);
            f32x4 v4;
            { const v2u vw = *(const LAS v2u*)(IM + R2_VI + tt * R2_IP + jq * 2); v4 = (f32x4){bf_lo(vw.x), bf_hi(vw.x), bf_lo(vw.y), bf_hi(vw.y)}; }
            const f32x4 g4 = *(const LAS f32x4*)(Gm + tt * 64 + jq);
            const f32x4 y = ((d4 * rs) * lgv + lbv + v4 * BON[tt]) * g4;
            v2u w; w.x = pk2(y[0], y[1]); w.y = pk2(y[2], y[3]);
            *(GAS v2u*)(OUT + (size_t)(b * T + t0 + tt) * D + h * 64 + jq) = w;
        }
    };
    for (int ch = 0; ch < NCH; ch += 2) { do_chunk(ch, pf0); do_chunk(ch + 1, pf1); }
    __syncthreads();
}

constexpr int NPHASE = 19;
#ifndef PH_ONLY
#define PH_ONLY -1
#endif
#define PROBE_SCAN 0
#ifndef SCAN_SEL
#define SCAN_SEL 0
#endif
#define PH_ON(k) (PH_ONLY < 0 || PH_ONLY == (k))

template <int LAYER>
__device__ __forceinline__ void layer_phases(Frame& F, const Args& A_, const XcdBarrier& bar, const int lo, const int hi) {
#define IN(k) (PH_ON(k) && lo <= (k) && (k) < hi)
#define SEAM(k) do { if (lo <= (k) && (k) + 1 < hi) xcd_barrier(bar); } while (0)
    bf16* XN = (bf16*)(F.ws + WS_XN); bf16* PROJ = (bf16*)(F.ws + WS_PROJ);
    const int gw = F.vcu * NWAVES + F.wave, NGW = F.G * NWAVES;
    constexpr int pb = 1 + LAYER * 8;
    unsigned char* wmix = LAYER == 0 ? F.ws + WS_WS : F.ws + WS_W1;
    const float* xres = LAYER == 0 ? A_.in[0] : F.out;
    if (IN(pb)) {
        pg8::Gemm g{XN, (const bf16*)(wmix + MW_IN), D, D, D, nullptr}; pg8::StaticOrder S; S.init(M / 256, NPROJ / 256, F.G, (int)blockIdx.x);
        pg8::EpiBf16Plain E{PROJ, NPROJ};
        pg8::gemm_phase<pg8::EpiBf16Plain, pg8::StaticOrder, true, true, false>(F.lds, g, S, E);
    }
    SEAM(pb);
    if (IN(pb + 1)) {
        { const int job = F.vcu; if (job < 128) { if (SCAN_SEL != 2 && !(PADF & 2)) gdn_unit2(F, A_, LAYER, job); } else if (job < 256) { if (SCAN_SEL != 1 && !(PADF & 1)) rwkv_pair2(F, A_, LAYER, job - 128); } }
        if (F.vcu < 128 && !PADF) {
            __syncthreads();
            LAS float* scr = (LAS float*)(F.lds + F.wave * 16384);
            const int cw = F.vcu * NWAVES + F.wave, NCW = 128 * NWAVES;
            if constexpr (LAYER == 0) {
                for (int it = cw; it < MIXER_ITEMS + FFN_ITEMS / 3; it += NCW) {
                    if (it < MIXER_ITEMS) conv_mixer_item(F, A_, 1, F.ws + WS_W1, it, scr);
                    else conv_ffn_item(F, A_.in[22], A_.in[23], A_.in[24], (bf16*)(F.ws + WS_WS + FW_GU), (bf16*)(F.ws + WS_WS + FW_DN), it - MIXER_ITEMS + 2 * (FFN_ITEMS / 3), scr); }
                for (int it = cw; it < 2 * (FFN_ITEMS8 / 3); it += NCW)
                    conv_ffn_item_f8(F, A_.in[22], A_.in[23], A_.in[24], F.ws + WS_WS + FW_GU, nullptr, it);
                for (int it = cw; it < NE_EARLY * FFN_ITEMS8; it += NCW) { const int e = it / FFN_ITEMS8, r = it % FFN_ITEMS8;
                    conv_ffn_item_f8(F, A_.in[26] + (size_t)e * D * FF, A_.in[27] + (size_t)e * D * FF, A_.in[28] + (size_t)e * FF * D,
                                     F.ws + WS_WS + EW_GU + (size_t)e * NGU * D, F.ws + WS_WS + EW_DN + (size_t)e * D * FF, r); }
            } else {
                for (int it = cw + NE_EARLY * FFN_ITEMS8; it < NE * FFN_ITEMS8; it += NCW) { const int e = it / FFN_ITEMS8, r = it % FFN_ITEMS8;
                    conv_ffn_item_f8(F, A_.in[26] + (size_t)e * D * FF, A_.in[27] + (size_t)e * D * FF, A_.in[28] + (size_t)e * FF * D,
                                     F.ws + WS_WS + EW_GU + (size_t)e * NGU * D, F.ws + WS_WS + EW_DN + (size_t)e * D * FF, r); }
            }
        }
    }
    SEAM(pb + 1);
    if (IN(pb + 2)) {
        pg8::StaticOrder S; S.init(M / 256, D / 256, F.G, (int)blockIdx.x);
        { pg8::Gemm g{XN, (const bf16*)(wmix + MW_PA), D, 512, 512, nullptr}; pg8::EpiMerge<true> E{PROJ, PROJ + C_GA, NPROJ};
          pg8::gemm_phase<pg8::EpiMerge<true>, pg8::StaticOrder, true, true, false>(F.lds, g, S, E); }
        { pg8::Gemm g{XN + 512, (const bf16*)(wmix + MW_PB), D, 512, 512, nullptr}; pg8::EpiMerge<false> E{PROJ, PROJ + C_GB, NPROJ};
          pg8::gemm_phase<pg8::EpiMerge<false>, pg8::StaticOrder, true, true, false>(F.lds, g, S, E); }
    }
    SEAM(pb + 2);
    if (IN(pb + 3)) {
        pg8::Gemm g{PROJ, (const bf16*)(wmix + MW_OUT), NPROJ, D, D, nullptr}; pg8::StaticOrder S; S.init(M / 256, D / 256, F.G, (int)blockIdx.x);
        pg8::EpiResid E{xres, F.out, D};
        pg8::gemm_phase<pg8::EpiResid, pg8::StaticOrder, true, true, false>(F.lds, g, S, E);
    }
    SEAM(pb + 3);
    if constexpr (LAYER == 0) {
        if (IN(5)) norm_phase<1>(F, F.out, A_.in[21], nullptr, 0);
        SEAM(5);
        if (IN(6)) {
            pg8::Gemm g{XN, (const bf16*)(F.ws + WS_WS + FW_GU), D, D, D, nullptr}; pg8::StaticOrder S; S.init(M / 256, NGU / 256, F.G, (int)blockIdx.x);
            pg8::EpiSwigluI8<false> E{(unsigned char*)PROJ, FF, (const float*)(F.ws + WS_RS), I8_WS, 1.0f};
            pg8::gemm_phase<pg8::EpiSwigluI8<false>, pg8::StaticOrder, true, true, false, 2>(F.lds, g, S, E);
        }
        SEAM(6);
        if (IN(7)) {
            pg8::Gemm g{PROJ, (const bf16*)(F.ws + WS_WS + FW_DN), FF, FF, FF, nullptr}; pg8::StaticOrder S; S.init(M / 256, D / 256, F.G, (int)blockIdx.x);
            pg8::EpiResid E{F.out, F.out, D};
            pg8::gemm_phase<pg8::EpiResid, pg8::StaticOrder, true, true, false>(F.lds, g, S, E);
        }
        SEAM(7);
        if (IN(8)) norm_phase<0>(F, F.out, A_.in[1] + D, A_.in[2] + (size_t)D * INC + SRC_AB, INC);
        SEAM(8);
    } else {
        if (IN(13)) {
            norm_phase<2>(F, F.out, A_.in[21] + D, A_.in[25], 8);
        }
        SEAM(13);
        if (IN(14)) route_scatter(F);
        SEAM(14);
        const int* grp = (const int*)(F.ws + WS_GRP);
        if (IN(15)) {
            const int np = grp[16] / 256;
            pg8::Gemm g{XN, (const bf16*)(F.ws + WS_WS + EW_GU), D, D, D, (const int*)(F.ws + WS_LIST)}; pg8::MoeOrder S; S.init(grp, 0, np, NGU / 256, F.G, (int)blockIdx.x);
            pg8::EpiSwigluI8<true> E{(unsigned char*)PROJ, FF, (const float*)(F.ws + WS_RSL), I8_WS, F8_SH};
            pg8::gemm_phase<pg8::EpiSwigluI8<true>, pg8::MoeOrder, true, true, true, 2>(F.lds, g, S, E);
        }
        SEAM(15);
        if (IN(16)) {
            const int np = grp[16] / 256;
            pg8::Gemm g{PROJ, (const bf16*)(F.ws + WS_WS + EW_DN), FF, FF, FF, nullptr}; pg8::MoeOrder S; S.init(grp, 0, np, D / 256, F.G, (int)blockIdx.x);
            pg8::EpiMoeDown E{F.out, (const int*)(F.ws + WS_LIST), (const float*)(F.ws + WS_GATEL), XN, grp[8], 1.0f / (F8_SH * F8_SW)};
            pg8::gemm_phase<pg8::EpiMoeDown, pg8::MoeOrder, true, true, false, 1>(F.lds, g, S, E);
        }
        SEAM(16);
        if (IN(18)) norm_phase<3>(F, F.out, A_.in[29], nullptr, 0);
    }
}

__global__ void __launch_bounds__(NWAVES * 64, 2) trunk_fwd(Args A_) {
    extern __shared__ __attribute__((aligned(16))) unsigned char lds[];
    Frame F;
    F.lds = (LAS unsigned char*)lds;
    F.tid = threadIdx.x; F.lane = F.tid & 63; F.wave = __builtin_amdgcn_readfirstlane(F.tid >> 6);
    F.G = gridDim.x; { const int bx = blockIdx.x; F.vcu = (F.G % 8 == 0) ? (bx % 8) * (F.G / 8) + bx / 8 : bx; }
    F.out = A_.out; F.ws = A_.ws;
    unsigned* ctl = (unsigned*)(F.ws + WS_CTL);
    for (int u = F.tid; u < (LDS_BYTES - LDSCTL_OFF) / 4; u += NWAVES * 64) ((LAS unsigned*)(F.lds + LDSCTL_OFF))[u] = 0u;
    __syncthreads();
    XcdBarrier bar; bar.bar = ctl + CW_BAR + A_.li * XCD_BAR_WORDS; bar.x = 0; bar.st = nullptr;
    if (!MK_PER_PHASE) bar = xcd_barrier_post(ctl + CW_BAR + A_.li * XCD_BAR_WORDS, (volatile LAS unsigned*)(F.lds + MISC_OFF) + 8);
    const int lo = A_.ph_lo, hi = A_.ph_hi;
    if (IN(0)) {
        const int gw = F.vcu * NWAVES + F.wave, NGW = F.G * NWAVES;
        LAS float* scr = (LAS float*)(F.lds + F.wave * 16384);
        for (int it = gw; it < MIXER_ITEMS; it += NGW) conv_mixer_item(F, A_, 0, F.ws + WS_WS, it, scr);
        __syncthreads();
        norm_phase<0>(F, A_.in[0], A_.in[1], A_.in[2] + SRC_AB, INC);
    }
    SEAM(0);
    layer_phases<0>(F, A_, bar, lo, hi);
    layer_phases<1>(F, A_, bar, lo, hi);
#undef IN
#undef SEAM
}

extern "C" void kernel_launch(void* const* d_in, const int* in_sizes, int n_in, void* d_out, int out_size, void* d_ws, size_t ws_size, hipStream_t stream) {
    static int grid = 0;
    if (grid == 0) {
        if (n_in != 30 || in_sizes[0] != M * D || out_size != M * D || ws_size < WS_END) { fprintf(stderr, "kernel_launch: unexpected shapes / workspace (n_in %d, ws %zu, need %zu)\n", n_in, ws_size, (size_t)WS_END); grid = -1; return; }
        int dev = 0, cus = 0, per_cu = 0;
        if (hipGetDevice(&dev) != hipSuccess || hipDeviceGetAttribute(&cus, hipDeviceAttributeMultiprocessorCount, dev) != hipSuccess) { grid = -1; return; }
        if (hipFuncSetAttribute((const void*)trunk_fwd, hipFuncAttributeMaxDynamicSharedMemorySize, LDS_BYTES) != hipSuccess) { grid = -1; return; }
        if (hipOccupancyMaxActiveBlocksPerMultiprocessor(&per_cu, (const void*)trunk_fwd, NWAVES * 64, LDS_BYTES) != hipSuccess || per_cu < 1) { fprintf(stderr, "kernel_launch: occupancy query says %d\n", per_cu); }
        (void)hipGetLastError();
        grid = cus;
    }
    if (grid < 0) return;
    if (hipMemsetAsync((char*)d_ws + WS_CTL, 0, CTL_ZERO_BYTES, stream) != hipSuccess) return;
    Args a{};
    for (int i = 0; i < 30; ++i) a.in[i] = (const float*)d_in[i];
    a.out = (float*)d_out; a.ws = (unsigned char*)d_ws;
#if MK_PER_PHASE
    for (int p = 0; p < NPHASE; ++p) { a.ph_lo = p; a.ph_hi = p + 1; a.li = 0; hipLaunchKernelGGL(trunk_fwd, dim3(grid), dim3(NWAVES * 64), LDS_BYTES, stream, a); }
#elif PROBE_DUP >= 0
    a.ph_lo = 0; a.ph_hi = PROBE_DUP; a.li = 0; a.pad = 0; hipLaunchKernelGGL(trunk_fwd, dim3(grid), dim3(NWAVES * 64), LDS_BYTES, stream, a);
    a.ph_lo = PROBE_DUP; a.ph_hi = PROBE_DUP + 1; a.li = 1; a.pad = PROBE_SCAN; hipLaunchKernelGGL(trunk_fwd, dim3(grid), dim3(NWAVES * 64), LDS_BYTES, stream, a);
    a.ph_lo = PROBE_DUP; a.ph_hi = NPHASE; a.li = 2; a.pad = 0; hipLaunchKernelGGL(trunk_fwd, dim3(grid), dim3(NWAVES * 64), LDS_BYTES, stream, a);
#else
    a.ph_lo = 0; a.ph_hi = NPHASE; a.li = 0;
    hipLaunchKernelGGL(trunk_fwd, dim3(grid), dim3(NWAVES * 64), LDS_BYTES, stream, a);
#endif
}
```

```cpp
#include <hip/hip_runtime.h>
#include <cstdio>
#include <cstdint>
#pragma clang fp reassociate(on) contract(fast)

#ifndef MK_PER_PHASE
#define MK_PER_PHASE 0
#endif
#define PROBE_DUP -1
#define PADF (PROBE_DUP >= 0 ? A_.pad : 0)

#define GAS __attribute__((address_space(1)))
#define LAS __attribute__((address_space(3)))
typedef unsigned short bf16;
typedef unsigned v4u __attribute__((ext_vector_type(4)));
typedef unsigned v2u __attribute__((ext_vector_type(2)));
typedef float f32x4 __attribute__((ext_vector_type(4)));
typedef float f32x2 __attribute__((ext_vector_type(2)));
typedef short bf16x8 __attribute__((ext_vector_type(8)));
typedef GAS unsigned gu32;

constexpr int NWAVES = 8;
constexpr int BATCH = 32, T = 2048, D = 1024, M = BATCH * T;
constexpr int INC = 5896, NPROJ = 5888;
constexpr int C_R = 0, C_K = 512, C_V = 1024, C_WL = 1536, C_GQ = 1792, C_GK = 2304, C_GV = 2816, C_Z = 3328, C_GA = 3840, C_GB = 4864;
constexpr int SRC_AB = 3328;
constexpr int FF = 2816, NGU = 2 * FF, NE = 8;
constexpr int LISTCAP = 2 * M + 16 * 256;

constexpr size_t MiB = 1u << 20;
constexpr size_t WS_CTL = 0, CTL_ZERO_BYTES = 1 * MiB;
constexpr size_t WS_AB = 1 * MiB;
constexpr size_t WS_RE = 3 * MiB;
constexpr size_t WS_RG = WS_RE + (size_t)M * 4;
constexpr size_t WS_WGCNT = WS_RG + (size_t)M * 4;
constexpr size_t WS_GRP = WS_WGCNT + 256 * 16 * 4;
constexpr size_t WS_RS = 3 * MiB + 768 * 1024;
constexpr size_t WS_LIST = 4 * MiB;
constexpr size_t WS_GATEL = 5 * MiB;
constexpr size_t WS_RSL = 6 * MiB;
constexpr size_t WS_W1 = 8 * MiB;
constexpr size_t WS_WS = 24 * MiB;
constexpr size_t WS_XN = 156 * MiB;
constexpr size_t WS_PROJ = 284 * MiB;
constexpr size_t WS_END = WS_PROJ + (size_t)M * NPROJ * 2;
static_assert(WS_END == 1020 * MiB, "ws map");
static_assert((size_t)LISTCAP * NGU <= (size_t)M * NPROJ * 2, "moe hidden fits in the PROJ region");
constexpr size_t MW_IN = 0, MW_PA = MW_IN + (size_t)NPROJ * D * 2, MW_PB = MW_PA + (size_t)D * 512 * 2, MW_OUT = MW_PB + (size_t)D * 512 * 2, MW_END = MW_OUT + (size_t)D * D * 2;
constexpr size_t FW_GU = MW_END, FW_DN = FW_GU + (size_t)NGU * D * 2, FW_END = FW_DN + (size_t)D * FF * 2;
constexpr size_t EW_GU = 56 * MiB, EW_DN = EW_GU + (size_t)NE * NGU * D;
static_assert(WS_W1 + MW_END <= WS_WS && FW_END <= EW_GU && WS_WS + EW_DN + (size_t)NE * D * FF <= WS_XN, "weight map");
constexpr int NE_EARLY = 3;
constexpr int CW_BAR = 4096;

constexpr int RING_BYTES = 131072;
constexpr int LDSCTL_OFF = RING_BYTES, MISC_OFF = LDSCTL_OFF + 320;
constexpr int LDS_BYTES = 147456;

#define RLX_AGENT __ATOMIC_RELAXED, __HIP_MEMORY_SCOPE_AGENT
#define LDS_WAIT() asm volatile("s_waitcnt lgkmcnt(0)" ::: "memory")
#define VM_WAIT() asm volatile("s_waitcnt vmcnt(0)" ::: "memory")
__device__ __forceinline__ unsigned f2bf(float f) { return (unsigned)__builtin_bit_cast(unsigned short, (__bf16)f); }
typedef __bf16 bf16v2_t __attribute__((ext_vector_type(2)));
__device__ __forceinline__ unsigned pk2(float lo, float hi) { const f32x2 v = {lo, hi}; return __builtin_bit_cast(unsigned, __builtin_convertvector(v, bf16v2_t)); }
__device__ __forceinline__ float bf_lo(unsigned w) { return __builtin_bit_cast(float, w << 16); }
__device__ __forceinline__ float bf_hi(unsigned w) { return __builtin_bit_cast(float, w & 0xffff0000u); }
__device__ __forceinline__ float bf2f(bf16 v) { return __builtin_bit_cast(float, (unsigned)v << 16); }
__device__ __forceinline__ float sigmoidf_(float x) { return __builtin_amdgcn_rcpf(1.0f + __expf(-x)); }
__device__ __forceinline__ float softplusf_(float x) { return x > 20.f ? x : log1pf(__expf(x)); }
__device__ __forceinline__ unsigned f8x4(float a, float b, float c, float d) {
    a = __builtin_amdgcn_fmed3f(a, -448.f, 448.f); b = __builtin_amdgcn_fmed3f(b, -448.f, 448.f); c = __builtin_amdgcn_fmed3f(c, -448.f, 448.f); d = __builtin_amdgcn_fmed3f(d, -448.f, 448.f);
    int w = __builtin_amdgcn_cvt_pk_fp8_f32(a, b, 0, false); w = __builtin_amdgcn_cvt_pk_fp8_f32(c, d, w, true); return (unsigned)w; }
constexpr float F8_SX = 8.f, F8_SW = 256.f, F8_SH = 8.f;
constexpr float I8_WMAX = 4.0f * 0.03125f, I8_WS = I8_WMAX / 127.f, I8_WINV = 127.f / I8_WMAX;
__device__ __forceinline__ unsigned q8x4(float a, float b, float c, float d) {
    const float mg = 12582912.f;
    const unsigned ua = __builtin_bit_cast(unsigned, __builtin_amdgcn_fmed3f(a, -127.f, 127.f) + mg), ub = __builtin_bit_cast(unsigned, __builtin_amdgcn_fmed3f(b, -127.f, 127.f) + mg);
    const unsigned uc = __builtin_bit_cast(unsigned, __builtin_amdgcn_fmed3f(c, -127.f, 127.f) + mg), ud = __builtin_bit_cast(unsigned, __builtin_amdgcn_fmed3f(d, -127.f, 127.f) + mg);
    return (ua & 0xffu) | ((ub & 0xffu) << 8) | ((uc & 0xffu) << 16) | (ud << 24);
}

namespace pg8 {
constexpr int BM = 256, BK = 64, HALF = 128, HTB = HALF * BK * 2, STAGE_BYTES = 8 * HTB, NXCD = 8, WGM = 4;
__host__ __device__ __forceinline__ int lds_byte(int r, int c) { const int st = (r >> 4) * 2 + (c >> 5), rr = r & 15, cc = c & 31, ob = rr * 64 + cc * 2; return st * 1024 + (ob ^ (((ob >> 9) & 1) << 5)); }
__host__ __device__ __forceinline__ void stage_rc(int b, int& R, int& C) { const int st = b / 1024, sb = b % 1024, swz = sb ^ (((sb >> 9) & 1) << 5); R = (st >> 1) * 16 + swz / 64; C = (st & 1) * 32 + (swz % 64) / 2; }
__host__ __device__ __forceinline__ int perm32(int rho) { const int n = rho >> 4, i = rho & 15; return 8 * (i >> 2) + 4 * n + (i & 3); }

struct Unit { int pm, pn, pb; };
struct Gemm { const bf16* A; const bf16* Bt; int lda, ldb, K; const int* rows; };

struct StaticOrder {
    int nM, nN, nwg, G, c;
    __device__ void init(int nM_, int nN_, int G_, int c_) { nM = nM_; nN = nN_; nwg = nM * nN; G = G_; c = c_; }
    __device__ bool next(int i, Unit& u) const {
        const long L = (long)i * G + c; if (L >= nwg) return false;
        int wgid = (int)L; { const int q = nwg / NXCD, r = nwg % NXCD, xcd = wgid % NXCD, off = wgid / NXCD; wgid = (xcd < r ? xcd * (q + 1) : r * (q + 1) + (xcd - r) * q) + off; }
        const int nig = WGM * nN, gid = wgid / nig, fm = gid * WGM, gsz = (nM - fm) < WGM ? (nM - fm) : WGM;
        u.pm = fm + ((wgid % nig) % gsz); u.pn = (wgid % nig) / gsz; u.pb = u.pn; return true;
    }
};
struct MoeOrder {
    int nM, nN, nwg, G, c, p0; int gb[16];
    __device__ void init(const int* grp, int p0_, int nM_, int nN_, int G_, int c_) { p0 = p0_; nM = nM_; nN = nN_; nwg = nM * nN; G = G_; c = c_;
#pragma unroll
        for (int k = 0; k < 16; ++k) gb[k] = grp[k]; }
    __device__ bool next(int i, Unit& u) const {
        const long L = (long)i * G + c; if (L >= nwg) return false;
        int wgid = (int)L; { const int q = nwg / NXCD, r = nwg % NXCD, xcd = wgid % NXCD, off = wgid / NXCD; wgid = (xcd < r ? xcd * (q + 1) : r * (q + 1) + (xcd - r) * q) + off; }
        const int nig = WGM * nN, gid = wgid / nig, fm = gid * WGM, gsz = (nM - fm) < WGM ? (nM - fm) : WGM;
        u.pm = p0 + fm + ((wgid % nig) % gsz); u.pn = (wgid % nig) / gsz;
        const int rowpos = u.pm * BM; int g = 0;
#pragma unroll
        for (int k = 1; k < 16; ++k) g += (rowpos >= gb[k]) ? 1 : 0;
        u.pb = (g & 7) * nN + u.pn; return true;
    }
};

__device__ __forceinline__ unsigned cvt_pk_bf16(float lo, float hi) { unsigned r; asm volatile("v_cvt_pk_bf16_f32 %0, %1, %2" : "=v"(r) : "v"(lo), "v"(hi)); return r; }

struct EpiBf16Plain {
    static constexpr bool PERM = true;
    bf16* O; int ldc;
    __device__ __forceinline__ void operator()(const f32x4 (&acc)[2][2][4][2], const Unit& u, int wr, int wc, int fr, int fq) const {
        const int row0 = u.pm * BM + wr * 64 + fr, col0 = u.pn * BM + wc * 32 + 8 * fq;
#pragma unroll
        for (int ai = 0; ai < 2; ++ai)
#pragma unroll
            for (int m = 0; m < 4; ++m) { bf16* rowp = O + (size_t)(row0 + ai * HALF + m * 16) * ldc + col0;
#pragma unroll
                for (int bj = 0; bj < 2; ++bj) { const f32x4 v0 = acc[ai][bj][m][0], v1 = acc[ai][bj][m][1];
                    v4u w; w.x = cvt_pk_bf16(v0[0], v0[1]); w.y = cvt_pk_bf16(v0[2], v0[3]); w.z = cvt_pk_bf16(v1[0], v1[1]); w.w = cvt_pk_bf16(v1[2], v1[3]);
                    *(v4u*)(rowp + bj * HALF) = w; } }
    }
};
struct EpiBf16PlainS {
    static constexpr bool PERM = true;
    bf16* O; int ldc; const float* rs; float sw;
    __device__ __forceinline__ void operator()(const f32x4 (&acc)[2][2][4][2], const Unit& u, int wr, int wc, int fr, int fq) const {
        const int row0 = u.pm * BM + wr * 64 + fr, col0 = u.pn * BM + wc * 32 + 8 * fq;
        float c0[2][4];
#pragma unroll
        for (int ai = 0; ai < 2; ++ai)
#pragma unroll
            for (int m = 0; m < 4; ++m) c0[ai][m] = rs[row0 + ai * HALF + m * 16] * sw;
#pragma unroll
        for (int ai = 0; ai < 2; ++ai)
#pragma unroll
            for (int m = 0; m < 4; ++m) { bf16* rowp = O + (size_t)(row0 + ai * HALF + m * 16) * ldc + col0; const float cc = c0[ai][m];
#pragma unroll
                for (int bj = 0; bj < 2; ++bj) { const f32x4 v0 = acc[ai][bj][m][0] * cc, v1 = acc[ai][bj][m][1] * cc;
                    v4u w; w.x = cvt_pk_bf16(v0[0], v0[1]); w.y = cvt_pk_bf16(v0[2], v0[3]); w.z = cvt_pk_bf16(v1[0], v1[1]); w.w = cvt_pk_bf16(v1[2], v1[3]);
                    *(v4u*)(rowp + bj * HALF) = w; } }
    }
};
template <bool FIRST> struct EpiMerge {
    static constexpr bool PERM = true;
    bf16* Y; const bf16* Gt; int ldc;
    __device__ __forceinline__ void operator()(const f32x4 (&acc)[2][2][4][2], const Unit& u, int wr, int wc, int fr, int fq) const {
        const int row0 = u.pm * BM + wr * 64 + fr, col0 = u.pn * BM + wc * 32 + 8 * fq;
#pragma unroll
        for (int ai = 0; ai < 2; ++ai)
#pragma unroll
            for (int mp = 0; mp < 2; ++mp) {
                v4u gw[2][2], yw[2][2];
#pragma unroll
                for (int mm = 0; mm < 2; ++mm)
#pragma unroll
                    for (int bj = 0; bj < 2; ++bj) { const size_t ro = (size_t)(row0 + ai * HALF + (2 * mp + mm) * 16) * ldc + col0 + bj * HALF;
                        gw[mm][bj] = *(const v4u*)(Gt + ro); if (!FIRST) yw[mm][bj] = *(const v4u*)(Y + ro); }
#pragma unroll
                for (int mm = 0; mm < 2; ++mm)
#pragma unroll
                    for (int bj = 0; bj < 2; ++bj) { const int m = 2 * mp + mm; const size_t ro = (size_t)(row0 + ai * HALF + m * 16) * ldc + col0 + bj * HALF;
                        const f32x4 v0 = acc[ai][bj][m][0], v1 = acc[ai][bj][m][1]; const v4u g4 = gw[mm][bj];
                        auto mg2 = [](unsigned gw2, float a0, float a1) { const f32x2 t = (f32x2){bf_lo(gw2), bf_hi(gw2)} * (f32x2){-1.44269504089f, -1.44269504089f};
                            f32x2 e; e[0] = __builtin_amdgcn_exp2f(t[0]); e[1] = __builtin_amdgcn_exp2f(t[1]); const f32x2 d = e + (f32x2){1.0f, 1.0f};
                            f32x2 r; r[0] = __builtin_amdgcn_rcpf(d[0]); r[1] = __builtin_amdgcn_rcpf(d[1]); return r * (f32x2){a0, a1}; };
                        f32x2 o[4];
                        o[0] = mg2(g4.x, v0[0], v0[1]); o[1] = mg2(g4.y, v0[2], v0[3]); o[2] = mg2(g4.z, v1[0], v1[1]); o[3] = mg2(g4.w, v1[2], v1[3]);
                        if (!FIRST) { const v4u y4 = yw[mm][bj];
                            o[0] += (f32x2){bf_lo(y4.x), bf_hi(y4.x)}; o[1] += (f32x2){bf_lo(y4.y), bf_hi(y4.y)}; o[2] += (f32x2){bf_lo(y4.z), bf_hi(y4.z)}; o[3] += (f32x2){bf_lo(y4.w), bf_hi(y4.w)}; }
                        v4u w; w.x = cvt_pk_bf16(o[0][0], o[0][1]); w.y = cvt_pk_bf16(o[1][0], o[1][1]); w.z = cvt_pk_bf16(o[2][0], o[2][1]); w.w = cvt_pk_bf16(o[3][0], o[3][1]);
                        *(v4u*)(Y + ro) = w; }
            }
    }
};
struct EpiResid {
    static constexpr bool PERM = false;
    const float* base; float* out; int ldc;
    __device__ __forceinline__ void operator()(const f32x4 (&acc)[2][2][4][2], const Unit& u, int wr, int wc, int fr, int fq) const {
        const int row0 = u.pm * BM + wr * 64 + fr, col0 = u.pn * BM + wc * 32 + 4 * fq;
        f32x4 bs[2][2][2][2];
#define ER_LOAD(q, slot) do { _Pragma("unroll") for (int mm = 0; mm < 2; ++mm) _Pragma("unroll") for (int bj = 0; bj < 2; ++bj) _Pragma("unroll") for (int n = 0; n < 2; ++n) \
            bs[slot][mm][bj][n] = *(const f32x4*)(base + (size_t)(row0 + ((q) >> 1) * HALF + (2 * ((q) & 1) + mm) * 16) * ldc + col0 + bj * HALF + n * 16); } while (0)
#define ER_STORE(q, slot) do { _Pragma("unroll") for (int mm = 0; mm < 2; ++mm) _Pragma("unroll") for (int bj = 0; bj < 2; ++bj) _Pragma("unroll") for (int n = 0; n < 2; ++n) \
            *(f32x4*)(out + (size_t)(row0 + ((q) >> 1) * HALF + (2 * ((q) & 1) + mm) * 16) * ldc + col0 + bj * HALF + n * 16) = bs[slot][mm][bj][n] + acc[(q) >> 1][bj][2 * ((q) & 1) + mm][n]; } while (0)
        ER_LOAD(0, 0); ER_LOAD(1, 1); ER_STORE(0, 0); ER_LOAD(2, 0); ER_STORE(1, 1); ER_LOAD(3, 1); ER_STORE(2, 0); ER_STORE(3, 1);
#undef ER_LOAD
#undef ER_STORE
    }
};
__device__ __forceinline__ f32x2 silu_mul2(const f32x2 g, const f32x2 up, float c1, float lc, float kinv) {
    const f32x2 a = g * (f32x2){c1, c1} + (f32x2){lc, lc};
    f32x2 e; e[0] = __builtin_amdgcn_exp2f(a[0]); e[1] = __builtin_amdgcn_exp2f(a[1]);
    const f32x2 d = e + (f32x2){kinv, kinv};
    f32x2 r; r[0] = __builtin_amdgcn_rcpf(d[0]); r[1] = __builtin_amdgcn_rcpf(d[1]);
    return (g * up) * r;
}
struct EpiSwiglu {
    static constexpr bool PERM = true;
    bf16* H; int ldc;
    __device__ __forceinline__ void operator()(const f32x4 (&acc)[2][2][4][2], const Unit& u, int wr, int wc, int fr, int fq) const {
        const int row0 = u.pm * BM + wr * 64 + fr, col0 = u.pn * HALF + wc * 32 + 8 * fq;
#pragma unroll
        for (int ai = 0; ai < 2; ++ai)
#pragma unroll
            for (int m = 0; m < 4; ++m) { bf16* rowp = H + (size_t)(row0 + ai * HALF + m * 16) * ldc + col0;
                f32x2 o[4];
#pragma unroll
                for (int n = 0; n < 2; ++n)
#pragma unroll
                    for (int jp = 0; jp < 2; ++jp) { const f32x4 g4 = acc[ai][0][m][n], u4 = acc[ai][1][m][n];
                        o[n * 2 + jp] = silu_mul2((f32x2){g4[2 * jp], g4[2 * jp + 1]}, (f32x2){u4[2 * jp], u4[2 * jp + 1]}, -1.44269504089f, 0.f, 1.0f); }
                v4u w; w.x = cvt_pk_bf16(o[0][0], o[0][1]); w.y = cvt_pk_bf16(o[1][0], o[1][1]); w.z = cvt_pk_bf16(o[2][0], o[2][1]); w.w = cvt_pk_bf16(o[3][0], o[3][1]);
                *(v4u*)rowp = w; }
    }
};
struct EpiSwigluF8 {
    static constexpr bool PERM = true;
    unsigned char* H; int ldc; float insc, osc;
    __device__ __forceinline__ void operator()(const f32x4 (&acc)[2][2][4][2], const Unit& u, int wr, int wc, int fr, int fq) const {
        const int row0 = u.pm * BM + wr * 64 + fr, col0 = u.pn * HALF + wc * 32 + 8 * fq;
#pragma unroll
        for (int ai = 0; ai < 2; ++ai)
#pragma unroll
            for (int m = 0; m < 4; ++m) { unsigned char* rowp = H + (size_t)(row0 + ai * HALF + m * 16) * ldc + col0;
                const float c2 = insc * insc * osc, c1 = -1.44269504089f * insc, lc = -__builtin_log2f(c2), kinv = 1.0f / c2;
                f32x2 o[4];
#pragma unroll
                for (int n = 0; n < 2; ++n)
#pragma unroll
                    for (int jp = 0; jp < 2; ++jp) { const f32x4 g4 = acc[ai][0][m][n], u4 = acc[ai][1][m][n];
                        o[n * 2 + jp] = silu_mul2((f32x2){g4[2 * jp], g4[2 * jp + 1]}, (f32x2){u4[2 * jp], u4[2 * jp + 1]}, c1, lc, kinv); }
                v2u w; w.x = f8x4(o[0][0], o[0][1], o[1][0], o[1][1]); w.y = f8x4(o[2][0], o[2][1], o[3][0], o[3][1]);
                *(v2u*)rowp = w; }
    }
};
template <bool OUTF8> struct EpiSwigluI8 {
    static constexpr bool PERM = true;
    unsigned char* H; int ldc; const float* rs; float sw, osc;
    __device__ __forceinline__ void operator()(const f32x4 (&acc)[2][2][4][2], const Unit& u, int wr, int wc, int fr, int fq) const {
        const int row0 = u.pm * BM + wr * 64 + fr, col0 = u.pn * HALF + wc * 32 + 8 * fq;
        float c0[2][4];
#pragma unroll
        for (int ai = 0; ai < 2; ++ai)
#pragma unroll
            for (int m = 0; m < 4; ++m) c0[ai][m] = rs[row0 + ai * HALF + m * 16] * sw;
#pragma unroll
        for (int ai = 0; ai < 2; ++ai)
#pragma unroll
            for (int m = 0; m < 4; ++m) { unsigned char* rowp = H + ((size_t)(row0 + ai * HALF + m * 16) * ldc + col0) * (OUTF8 ? 1 : 2);
                const float cc = c0[ai][m], c2 = cc * cc * osc, c1 = -1.44269504089f * cc, lc = -__builtin_amdgcn_logf(c2), kinv = __builtin_amdgcn_rcpf(c2);
                f32x2 o[4];
#pragma unroll
                for (int n = 0; n < 2; ++n)
#pragma unroll
                    for (int jp = 0; jp < 2; ++jp) { const f32x4 g4 = acc[ai][0][m][n], u4 = acc[ai][1][m][n];
                        o[n * 2 + jp] = silu_mul2((f32x2){g4[2 * jp], g4[2 * jp + 1]}, (f32x2){u4[2 * jp], u4[2 * jp + 1]}, c1, lc, kinv); }
                if constexpr (OUTF8) { v2u w; w.x = f8x4(o[0][0], o[0][1], o[1][0], o[1][1]); w.y = f8x4(o[2][0], o[2][1], o[3][0], o[3][1]); *(v2u*)rowp = w; }
                else { v4u w; w.x = cvt_pk_bf16(o[0][0], o[0][1]); w.y = cvt_pk_bf16(o[1][0], o[1][1]); w.z = cvt_pk_bf16(o[2][0], o[2][1]); w.w = cvt_pk_bf16(o[3][0], o[3][1]); *(v4u*)rowp = w; } }
    }
};
struct EpiMoeDown {
    static constexpr bool PERM = false;
    float* out; const int* list; const float* gatel; bf16* tmp; int split; float sc;
    __device__ __forceinline__ void operator()(const f32x4 (&acc)[2][2][4][2], const Unit& u, int wr, int wc, int fr, int fq) const {
        const int row0 = u.pm * BM + wr * 64 + fr, col0 = u.pn * BM + wc * 32 + 4 * fq;
        int tok[2][4]; float gt[2][4];
#pragma unroll
        for (int ai = 0; ai < 2; ++ai)
#pragma unroll
            for (int m = 0; m < 4; ++m) { const int p = row0 + ai * HALF + m * 16; tok[ai][m] = list[p]; gt[ai][m] = gatel[p] * sc; }
        if (u.pm * BM >= split) {
#pragma unroll
            for (int ai = 0; ai < 2; ++ai)
#pragma unroll
                for (int m = 0; m < 4; ++m) { const int tk = tok[ai][m]; const float g = gt[ai][m];
                    if (tk >= 0) { bf16* rowp = tmp + (size_t)tk * D + col0;
#pragma unroll
                        for (int bj = 0; bj < 2; ++bj)
#pragma unroll
                            for (int n = 0; n < 2; ++n) { const f32x4 o = acc[ai][bj][m][n] * g; v2u w; w.x = cvt_pk_bf16(o[0], o[1]); w.y = cvt_pk_bf16(o[2], o[3]); *(v2u*)(rowp + bj * HALF + n * 16) = w; } } }
            return;
        }
#pragma unroll
        for (int ai = 0; ai < 2; ++ai)
#pragma unroll
            for (int mp = 0; mp < 2; ++mp) {
                f32x4 bs[2][2][2];
#pragma unroll
                for (int mm = 0; mm < 2; ++mm) { const int tk = tok[ai][2 * mp + mm]; const float* rowp = out + (size_t)(tk < 0 ? 0 : tk) * D + col0;
#pragma unroll
                    for (int bj = 0; bj < 2; ++bj)
#pragma unroll
                        for (int n = 0; n < 2; ++n) bs[mm][bj][n] = *(const f32x4*)(rowp + bj * HALF + n * 16); }
#pragma unroll
                for (int mm = 0; mm < 2; ++mm) { const int tk = tok[ai][2 * mp + mm]; const float g = gt[ai][2 * mp + mm];
                    if (tk >= 0) { float* rowp = out + (size_t)tk * D + col0;
#pragma unroll
                        for (int bj = 0; bj < 2; ++bj)
#pragma unroll
                            for (int n = 0; n < 2; ++n) *(f32x4*)(rowp + bj * HALF + n * 16) = bs[mm][bj][n] + acc[ai][bj][2 * mp + mm][n] * g; } }
            }
    }
};

typedef int v4i_t __attribute__((ext_vector_type(4)));
typedef int v8i_t __attribute__((ext_vector_type(8)));
__device__ __forceinline__ v8i_t cat8(const bf16x8 a, const bf16x8 b) { return __builtin_shufflevector(__builtin_bit_cast(v4i_t, a), __builtin_bit_cast(v4i_t, b), 0, 1, 2, 3, 4, 5, 6, 7); }
template <class Epi, class Sched, bool ALIGN_EPI, bool SP2, bool GATHER, int PREC = 0>
__device__ __forceinline__ void gemm_phase(LAS unsigned char* lds, const Gemm g, const Sched& S, const Epi& E) {
    constexpr bool F8 = PREC == 1, I8 = PREC == 2;
    constexpr unsigned EB = PREC ? 1u : 2u;
    const int tid = threadIdx.x, wid = __builtin_amdgcn_readfirstlane(tid >> 6), lane = tid & 63, wr = wid >> 2, wc = wid & 3, fr = lane & 15, fq = lane >> 4;
    const int K = g.K, nt = K / (PREC ? 2 * BK : BK);
    unsigned voffA[2], voffB[2]; int stR[2], stC[2];
#pragma unroll
    for (int i = 0; i < 2; ++i) { int R, C; stage_rc(tid * 16 + i * 8192, R, C); const int Rb = Epi::PERM ? ((R & ~31) + perm32(R & 31)) : R;
        voffA[i] = (unsigned)(R * g.lda) * EB + (unsigned)C * 2u; voffB[i] = (unsigned)(Rb * g.ldb) * EB + (unsigned)C * 2u; stR[i] = R; stC[i] = C; }
    const size_t kstep = (size_t)(BK * 2);
    const size_t hstepA = (size_t)HALF * g.lda * EB, tstepA = 2 * hstepA, hstepB = (size_t)HALF * g.ldb * EB, tstepB = 2 * hstepB;
    const unsigned ldsw = (unsigned)wid * 1024u;
    const int aoff = lds_byte(wr * 64 + fr, fq * 8), boff = lds_byte(wc * 32 + fr, fq * 8);
    unsigned gAc[2][2], gAn[2][2];
#define PG8_SA(b, h) (((b) * 2 + (h)) * HTB)
#define PG8_SB(b, h) ((4 + (b) * 2 + (h)) * HTB)
#define PG8_GLDS(src, bufoff, i) __builtin_amdgcn_global_load_lds((const unsigned*)(src), (LAS unsigned*)(lds + (bufoff) + ldsw + (i) * 8192), 16, 0, 0)
#define PG8_STAGE_B(bufoff, gbase) do { _Pragma("unroll") for (int _i = 0; _i < 2; ++_i) PG8_GLDS((const char*)(gbase) + voffB[_i], bufoff, _i); } while (0)
#define PG8_STAGE_A(bufoff, h, NX, kb) do { \
        if constexpr (GATHER) { _Pragma("unroll") for (int _i = 0; _i < 2; ++_i) { const unsigned _o = (NX) ? gAn[h][_i] : gAc[h][_i]; PG8_GLDS((const char*)g.A + _o + (kb), bufoff, _i); } } \
        else { const char* _b = ((NX) ? nA : cA) + (h) * hstepA + (kb); _Pragma("unroll") for (int _i = 0; _i < 2; ++_i) PG8_GLDS(_b + voffA[_i], bufoff, _i); } } while (0)
#define PG8_LDA(dst, b, h) do { _Pragma("unroll") for (int m = 0; m < 4; ++m) _Pragma("unroll") for (int k = 0; k < 2; ++k) dst[m][k] = *(const LAS bf16x8*)(lds + PG8_SA(b, h) + aoff + m * 2048 + k * 1024); } while (0)
#define PG8_LDB(dst, b, h) do { _Pragma("unroll") for (int n = 0; n < 2; ++n) _Pragma("unroll") for (int k = 0; k < 2; ++k) dst[n][k] = *(const LAS bf16x8*)(lds + PG8_SB(b, h) + boff + n * 2048 + k * 1024); } while (0)
#define PG8_MMA(ai, bj, At, Bt) do { __builtin_amdgcn_s_setprio(1); _Pragma("unroll") for (int m = 0; m < 4; ++m) _Pragma("unroll") for (int n = 0; n < 2; ++n) { \
        if constexpr (F8) asm("v_mfma_f32_16x16x128_f8f6f4 %0, %1, %2, %0" : "+v"(acc[ai][bj][m][n]) : "v"(cat8(Bt[n][0], Bt[n][1])), "v"(cat8(At[m][0], At[m][1]))); \
        else if constexpr (I8) { _Pragma("unroll") for (int k = 0; k < 2; ++k) acc[ai][bj][m][n] = __builtin_bit_cast(f32x4, __builtin_amdgcn_mfma_i32_16x16x64_i8(__builtin_bit_cast(v4i_t, Bt[n][k]), __builtin_bit_cast(v4i_t, At[m][k]), __builtin_bit_cast(v4i_t, acc[ai][bj][m][n]), 0, 0, 0)); } \
        else { _Pragma("unroll") for (int k = 0; k < 2; ++k) acc[ai][bj][m][n] = __builtin_amdgcn_mfma_f32_16x16x32_bf16(Bt[n][k], At[m][k], acc[ai][bj][m][n], 0, 0, 0); } } __builtin_amdgcn_s_setprio(0); } while (0)
#define PG8_WAIT_V(n) asm volatile("s_waitcnt vmcnt(" #n ")" ::: "memory")
#define PG8_WAIT_L(n) asm volatile("s_waitcnt lgkmcnt(" #n ")" ::: "memory")
#define PG8_BAR __builtin_amdgcn_s_barrier()
#define PG8_SCHED __builtin_amdgcn_sched_barrier(0)
#define PG8_GOFF(dst, unit) do { _Pragma("unroll") for (int _h = 0; _h < 2; ++_h) _Pragma("unroll") for (int _i = 0; _i < 2; ++_i) { int _t = g.rows[(unit).pm * BM + _h * HALF + stR[_i]]; _t = _t < 0 ? 0 : _t; \
        dst[_h][_i] = (unsigned)_t * ((unsigned)g.lda * EB) + (unsigned)(stC[_i] * 2); } } while (0)
    Unit cur, nxt; int ui = 0;
    if (!S.next(0, cur)) return;
    f32x4 acc[2][2][4][2];
#pragma unroll
    for (int a = 0; a < 2; ++a)
#pragma unroll
        for (int b = 0; b < 2; ++b)
#pragma unroll
            for (int m = 0; m < 4; ++m)
#pragma unroll
                for (int n = 0; n < 2; ++n) acc[a][b][m][n] = (f32x4){0.f, 0.f, 0.f, 0.f};
    bf16x8 At[4][2], B0[2][2], B1[2][2];
    const char* cA = (const char*)g.A + (size_t)cur.pm * tstepA; const char* cB = (const char*)g.Bt + (size_t)cur.pb * tstepB;
    const char* nA = cA;
    if constexpr (GATHER) { PG8_GOFF(gAc, cur); _Pragma("unroll") for (int _h = 0; _h < 2; ++_h) _Pragma("unroll") for (int _i = 0; _i < 2; ++_i) gAn[_h][_i] = gAc[_h][_i]; }
    if constexpr (SP2) {
        PG8_STAGE_B(PG8_SB(0, 0), cB); PG8_STAGE_B(PG8_SB(0, 1), cB + hstepB); PG8_STAGE_A(PG8_SA(0, 0), 0, false, 0); PG8_STAGE_A(PG8_SA(0, 1), 1, false, 0);
        if (wr == 1) PG8_BAR;
        PG8_WAIT_V(2); PG8_BAR;
        PG8_STAGE_B(PG8_SB(1, 0), cB + kstep); PG8_STAGE_A(PG8_SA(1, 0), 0, false, kstep); PG8_STAGE_B(PG8_SB(1, 1), cB + hstepB + kstep);
        PG8_WAIT_V(6); PG8_BAR;
    } else {
        PG8_STAGE_B(PG8_SB(0, 0), cB); PG8_STAGE_A(PG8_SA(0, 0), 0, false, 0); PG8_STAGE_B(PG8_SB(0, 1), cB + hstepB); PG8_STAGE_A(PG8_SA(0, 1), 1, false, 0);
        if (wr == 1) PG8_BAR;
        PG8_WAIT_V(4); PG8_BAR;
        PG8_STAGE_B(PG8_SB(1, 0), cB + kstep); PG8_STAGE_A(PG8_SA(1, 0), 0, false, kstep); PG8_STAGE_B(PG8_SB(1, 1), cB + hstepB + kstep);
        PG8_WAIT_V(6); PG8_BAR;
    }
    for (;;) {
        const bool has_next = S.next(ui + 1, nxt);
        nA = has_next ? (const char*)g.A + (size_t)nxt.pm * tstepA : cA; const char* nB = has_next ? (const char*)g.Bt + (size_t)nxt.pb * tstepB : cB;
        if constexpr (GATHER) { if (has_next) PG8_GOFF(gAn, nxt); }
        for (int t = 0; t < nt; t += 2) {
            const bool last = (t == nt - 2);
            const size_t k1 = (size_t)(t + 1) * kstep;
            const size_t k2 = last ? 0 : (size_t)(t + 2) * kstep, k3 = k2 + kstep;
            const char* b2 = last ? nB : cB + (size_t)(t + 2) * kstep; const char* b3 = b2 + kstep;
            if constexpr (SP2) {
            PG8_LDB(B0, 0, 0); PG8_LDB(B1, 0, 1); PG8_SCHED; PG8_LDA(At, 0, 0); PG8_STAGE_A(PG8_SA(1, 1), 1, false, k1);
            PG8_WAIT_V(8); PG8_WAIT_L(0); PG8_BAR; PG8_MMA(0, 0, At, B0); PG8_MMA(0, 1, At, B1); PG8_BAR; PG8_SCHED;
            PG8_LDA(At, 0, 1); PG8_STAGE_B(PG8_SB(0, 0), b2); PG8_STAGE_B(PG8_SB(0, 1), b2 + hstepB); PG8_STAGE_A(PG8_SA(0, 0), 0, last, k2);
            PG8_WAIT_V(8); PG8_WAIT_L(0); PG8_BAR; PG8_MMA(1, 0, At, B0); PG8_MMA(1, 1, At, B1); PG8_BAR; PG8_SCHED;
            PG8_LDB(B0, 1, 0); PG8_LDB(B1, 1, 1); PG8_SCHED; PG8_LDA(At, 1, 0); PG8_STAGE_A(PG8_SA(0, 1), 1, last, k2);
            PG8_WAIT_V(8); PG8_WAIT_L(0); PG8_BAR; PG8_MMA(0, 0, At, B0); PG8_MMA(0, 1, At, B1); PG8_BAR; PG8_SCHED;
            PG8_LDA(At, 1, 1); PG8_STAGE_B(PG8_SB(1, 0), b3); PG8_STAGE_B(PG8_SB(1, 1), b3 + hstepB); PG8_STAGE_A(PG8_SA(1, 0), 0, last, k3);
            PG8_WAIT_V(8); PG8_WAIT_L(0); PG8_BAR; PG8_MMA(1, 0, At, B0); PG8_MMA(1, 1, At, B1); PG8_BAR; PG8_SCHED;
            } else {
            PG8_LDB(B0, 0, 0); PG8_SCHED; PG8_LDA(At, 0, 0); PG8_STAGE_A(PG8_SA(1, 1), 1, false, k1);
            PG8_WAIT_L(8); PG8_BAR; PG8_WAIT_L(0); PG8_MMA(0, 0, At, B0); PG8_BAR; PG8_SCHED;
            PG8_LDB(B1, 0, 1); PG8_STAGE_B(PG8_SB(0, 0), b2);
            PG8_BAR; PG8_WAIT_L(0); PG8_MMA(0, 1, At, B1); PG8_BAR;
            PG8_LDA(At, 0, 1); PG8_STAGE_A(PG8_SA(0, 0), 0, last, k2);
            PG8_BAR; PG8_WAIT_L(0); PG8_MMA(1, 0, At, B0); PG8_BAR; PG8_SCHED;
            PG8_STAGE_B(PG8_SB(0, 1), b2 + hstepB);
            PG8_WAIT_V(6); PG8_BAR; PG8_MMA(1, 1, At, B1); PG8_BAR;
            PG8_LDB(B0, 1, 0); PG8_SCHED; PG8_LDA(At, 1, 0); PG8_STAGE_A(PG8_SA(0, 1), 1, last, k2);
            PG8_WAIT_L(8); PG8_BAR; PG8_WAIT_L(0); PG8_MMA(0, 0, At, B0); PG8_BAR; PG8_SCHED;
            PG8_LDB(B1, 1, 1); PG8_STAGE_B(PG8_SB(1, 0), b3);
            PG8_BAR; PG8_WAIT_L(0); PG8_MMA(0, 1, At, B1); PG8_BAR;
            PG8_LDA(At, 1, 1); PG8_STAGE_A(PG8_SA(1, 0), 0, last, k3);
            PG8_BAR; PG8_WAIT_L(0); PG8_MMA(1, 0, At, B0); PG8_BAR; PG8_SCHED;
            PG8_STAGE_B(PG8_SB(1, 1), b3 + hstepB);
            PG8_WAIT_V(6); PG8_BAR; PG8_MMA(1, 1, At, B1); PG8_BAR;
            }
        }
        if constexpr (F8) { asm volatile("s_nop 15\n\ts_nop 15" ::: "memory"); PG8_SCHED; }
        if constexpr (ALIGN_EPI) { if (wr == 0) PG8_BAR; }
        if constexpr (I8) {
#pragma unroll
            for (int a = 0; a < 2; ++a)
#pragma unroll
                for (int b = 0; b < 2; ++b)
#pragma unroll
                    for (int m = 0; m < 4; ++m)
#pragma unroll
                        for (int n = 0; n < 2; ++n) acc[a][b][m][n] = __builtin_convertvector(__builtin_bit_cast(v4i_t, acc[a][b][m][n]), f32x4); }
        E(acc, cur, wr, wc, fr, fq);
        if (!has_next) break;
#pragma unroll
        for (int a = 0; a < 2; ++a)
#pragma unroll
            for (int b = 0; b < 2; ++b)
#pragma unroll
                for (int m = 0; m < 4; ++m)
#pragma unroll
                    for (int n = 0; n < 2; ++n) acc[a][b][m][n] = (f32x4){0.f, 0.f, 0.f, 0.f};
        cur = nxt; cA = nA; cB = nB; ++ui;
        if constexpr (GATHER) { _Pragma("unroll") for (int _h = 0; _h < 2; ++_h) _Pragma("unroll") for (int _i = 0; _i < 2; ++_i) gAc[_h][_i] = gAn[_h][_i]; }
        if constexpr (ALIGN_EPI) { if (wr == 1) PG8_BAR; }
    }
    PG8_WAIT_V(0);
    if constexpr (!ALIGN_EPI) { if (wr == 0) PG8_BAR; }
    PG8_BAR;
#undef PG8_SA
#undef PG8_SB
#undef PG8_GLDS
#undef PG8_STAGE_A
#undef PG8_STAGE_B
#undef PG8_LDA
#undef PG8_LDB
#undef PG8_MMA
#undef PG8_WAIT_V
#undef PG8_WAIT_L
#undef PG8_BAR
#undef PG8_SCHED
#undef PG8_GOFF
}
}

#define XB_TMO      128
#define XB_XCNT(j)  (256  + 64 * (j))
#define XB_XSUB(j)  (1280 + 64 * (j))
#define XB_XGEN(j)  (2304 + 64 * (j))
#define XB_TOP      3328
#define XB_TOPGEN   3392
#define XCD_BAR_WORDS 3456
#define XB_SPIN_CAP (1u << 18)
__device__ __forceinline__ unsigned xb_ld(unsigned* p)              { return __hip_atomic_load(p, __ATOMIC_RELAXED, __HIP_MEMORY_SCOPE_AGENT); }
__device__ __forceinline__ unsigned xb_add(unsigned* p, unsigned v) { return __hip_atomic_fetch_add(p, v, __ATOMIC_RELAXED, __HIP_MEMORY_SCOPE_AGENT); }
__device__ __forceinline__ unsigned xb_xcc_id() { return (unsigned)__builtin_amdgcn_s_getreg((3 << 11) | 20) & 0xFu; }
#define XB_SPIN(cond, bar) do { unsigned _sp = 0; while (cond) { __builtin_amdgcn_s_sleep(1); \
    if ((++_sp & 255u) == 0u) { if (xb_ld(&(bar)[XB_TMO])) break; if (_sp > XB_SPIN_CAP) { atomicAdd(&(bar)[XB_TMO], 1u); break; } } } } while (0)
struct XcdBarrier { unsigned* bar; unsigned x; volatile LAS unsigned* st; };
__device__ __forceinline__ XcdBarrier xcd_barrier_post(unsigned* bar, volatile LAS unsigned* st) {
    XcdBarrier b; b.bar = bar; b.x = xb_xcc_id(); b.st = st;
    if (threadIdx.x == 0) (void)xb_add(&bar[XB_XCNT(b.x)], 1u);
    return b;
}
__device__ __forceinline__ void xcd_barrier_complete(unsigned* bar, unsigned x, unsigned& nloc, unsigned& nx) {
    const unsigned G = gridDim.x * gridDim.y * gridDim.z;
    unsigned sum, cnt, mine, sp = 0u;
    for (;;) {
        sum = 0u; cnt = 0u; mine = 0u;
#pragma unroll
        for (unsigned j = 0; j < 16; ++j) { const unsigned c = xb_ld(&bar[XB_XCNT(j)]); sum += c; cnt += (c > 0u) ? 1u : 0u; mine = (j == x) ? c : mine; }
        if (sum == G) break;
        __builtin_amdgcn_s_sleep(1);
        if ((++sp & 255u) == 0u) { if (xb_ld(&bar[XB_TMO])) break; if (sp > XB_SPIN_CAP) { atomicAdd(&bar[XB_TMO], 1u); break; } }
    }
    nloc = mine > 0u ? mine : 1u; nx = cnt > 0u ? cnt : 1u;
}
__device__ __forceinline__ void xcd_barrier(const XcdBarrier& b) {
    asm volatile("s_waitcnt vmcnt(0)" ::: "memory");
    __syncthreads();
    if (threadIdx.x == 0) {
        unsigned* bar = b.bar;
        __builtin_amdgcn_s_waitcnt(0);
        unsigned nloc = b.st[0], nx = b.st[1];
        if (nloc == 0u) { xcd_barrier_complete(bar, b.x, nloc, nx); b.st[0] = nloc; b.st[1] = nx; }
        const unsigned old = xb_add(&bar[XB_XSUB(b.x)], 1u);
        const unsigned gen = old / nloc;
        if (old + 1u == (gen + 1u) * nloc) {
            __builtin_amdgcn_fence(__ATOMIC_RELEASE, "agent");
            asm volatile("s_waitcnt vmcnt(0)" ::: "memory");
            const unsigned og = xb_add(&bar[XB_TOP], 1u);
            const unsigned tg = og / nx;
            if (og + 1u == (tg + 1u) * nx) xb_add(&bar[XB_TOPGEN], 1u);
            else XB_SPIN(xb_ld(&bar[XB_TOPGEN]) == tg, bar);
            __builtin_amdgcn_fence(__ATOMIC_ACQUIRE, "agent");
            xb_add(&bar[XB_XGEN(b.x)], 1u);
            asm volatile("s_waitcnt vmcnt(0)" ::: "memory");
        } else {
            XB_SPIN(xb_ld(&bar[XB_XGEN(b.x)]) == gen, bar);
            __builtin_amdgcn_fence(__ATOMIC_ACQUIRE, "agent");
            asm volatile("s_waitcnt vmcnt(0)" ::: "memory");
        }
    }
    __syncthreads();
}

struct Frame {
    LAS unsigned char* lds;
    int tid, lane, wave, vcu, G;
    float* out; unsigned char* ws;
};
struct Args { const float* in[30]; float* out; unsigned char* ws; int ph_lo, ph_hi, li, pad; };
template <int CTRL> __device__ __forceinline__ float dpp_mov(float v) { return __builtin_bit_cast(float, __builtin_amdgcn_update_dpp(0, __builtin_bit_cast(int, v), CTRL, 0xf, 0xf, true)); }
__device__ __forceinline__ float sum8(float v) { v += dpp_mov<0xB1>(v); v += dpp_mov<0x4E>(v); v += dpp_mov<0x141>(v); return v; }
__device__ __forceinline__ float sum16(float v) { v = sum8(v); v += dpp_mov<0x140>(v); return v; }
__device__ __forceinline__ float wave_sum(float v) {
    v = sum16(v);
    const int iv = __builtin_bit_cast(int, v);
    return (__builtin_bit_cast(float, __builtin_amdgcn_readlane(iv, 0)) + __builtin_bit_cast(float, __builtin_amdgcn_readlane(iv, 16))) +
           (__builtin_bit_cast(float, __builtin_amdgcn_readlane(iv, 32)) + __builtin_bit_cast(float, __builtin_amdgcn_readlane(iv, 48)));
}

__device__ __forceinline__ float wave_max(float v) {
    v = fmaxf(v, dpp_mov<0xB1>(v)); v = fmaxf(v, dpp_mov<0x4E>(v)); v = fmaxf(v, dpp_mov<0x141>(v)); v = fmaxf(v, dpp_mov<0x140>(v));
    const int iv = __builtin_bit_cast(int, v);
    return fmaxf(fmaxf(__builtin_bit_cast(float, __builtin_amdgcn_readlane(iv, 0)), __builtin_bit_cast(float, __builtin_amdgcn_readlane(iv, 16))),
                 fmaxf(__builtin_bit_cast(float, __builtin_amdgcn_readlane(iv, 32)), __builtin_bit_cast(float, __builtin_amdgcn_readlane(iv, 48))));
}
__device__ __forceinline__ float reduce8(const float (&a)[8], int lane) {
    const bool b0 = lane & 1, b1 = lane & 2, b2 = lane & 4;
    float b[4], c[2];
#pragma unroll
    for (int m = 0; m < 4; ++m) { const float keep = b0 ? a[2 * m + 1] : a[2 * m], send = b0 ? a[2 * m] : a[2 * m + 1]; b[m] = keep + dpp_mov<0xB1>(send); }
#pragma unroll
    for (int m = 0; m < 2; ++m) { const float keep = b1 ? b[2 * m + 1] : b[2 * m], send = b1 ? b[2 * m] : b[2 * m + 1]; c[m] = keep + dpp_mov<0x4E>(send); }
    float d;
    { const float keep = b2 ? c[1] : c[0], send = b2 ? c[0] : c[1]; d = keep + dpp_mov<0x124>(send); }
    d += dpp_mov<0x128>(d);
    { const unsigned u = __builtin_bit_cast(unsigned, d); const auto r = __builtin_amdgcn_permlane16_swap(u, u, false, false); d = __builtin_bit_cast(float, (unsigned)r[0]) + __builtin_bit_cast(float, (unsigned)r[1]); }
    { const unsigned u = __builtin_bit_cast(unsigned, d); const auto r = __builtin_amdgcn_permlane32_swap(u, u, false, false); d = __builtin_bit_cast(float, (unsigned)r[0]) + __builtin_bit_cast(float, (unsigned)r[1]); }
    return d;
}

__device__ __forceinline__ void tr_item(const float* W, int ldw, int k0, int srccol0, bf16* WT, int K, int dstrow0, LAS float* scr, int lane) {
    (void)scr;
    const int kr = lane >> 3, nq = lane & 7;
    const float* src = W + (size_t)(k0 + 8 * kr) * ldw + srccol0 + 4 * nq;
    f32x4 x[8];
#pragma unroll
    for (int b = 0; b < 8; ++b) x[b] = *(const GAS f32x4*)(src + (size_t)b * ldw);
    bf16* dst = WT + (size_t)(dstrow0 + 4 * nq) * K + k0 + 8 * kr;
#pragma unroll
    for (int q = 0; q < 4; ++q) { v4u o; o.x = pk2(x[0][q], x[1][q]); o.y = pk2(x[2][q], x[3][q]); o.z = pk2(x[4][q], x[5][q]); o.w = pk2(x[6][q], x[7][q]);
        *(GAS v4u*)(dst + (size_t)q * K) = o; }
}
__device__ __forceinline__ void tr_item_f8(const float* W, int ldw, int k0, int srccol0, unsigned char* WT, int K, int dstrow0, int lane, float sc) {
    const int kr = lane >> 3, nq = lane & 7;
    const float* src = W + (size_t)(k0 + 4 * kr) * ldw + srccol0 + 4 * nq;
    f32x4 x[4][4];
#pragma unroll
    for (int a = 0; a < 4; ++a)
#pragma unroll
        for (int b = 0; b < 4; ++b) x[a][b] = *(const GAS f32x4*)(src + (size_t)(32 * a + b) * ldw);
    unsigned char* dst = WT + (size_t)(dstrow0 + 4 * nq) * K + k0 + 4 * kr;
#pragma unroll
    for (int a = 0; a < 4; ++a)
#pragma unroll
        for (int q = 0; q < 4; ++q)
            *(GAS unsigned*)(dst + (size_t)q * K + 32 * a) = f8x4(x[a][0][q] * sc, x[a][1][q] * sc, x[a][2][q] * sc, x[a][3][q] * sc);
}
__device__ __forceinline__ void tr_item_i8(const float* W, int ldw, int k0, int srccol0, unsigned char* WT, int K, int dstrow0, int lane) {
    const int kr = lane >> 3, nq = lane & 7;
    const float* src = W + (size_t)(k0 + 4 * kr) * ldw + srccol0 + 4 * nq;
    f32x4 x[4][4];
#pragma unroll
    for (int a = 0; a < 4; ++a)
#pragma unroll
        for (int b = 0; b < 4; ++b) x[a][b] = *(const GAS f32x4*)(src + (size_t)(32 * a + b) * ldw);
    unsigned char* dst = WT + (size_t)(dstrow0 + 4 * nq) * K + k0 + 4 * kr;
#pragma unroll
    for (int a = 0; a < 4; ++a)
#pragma unroll
        for (int q = 0; q < 4; ++q)
            *(GAS unsigned*)(dst + (size_t)q * K + 32 * a) = q8x4(x[a][0][q] * I8_WINV, x[a][1][q] * I8_WINV, x[a][2][q] * I8_WINV, x[a][3][q] * I8_WINV);
}
__device__ __forceinline__ void conv_mixer_item(Frame& F, const Args& A_, int l, unsigned char* dst, int r, LAS float* scr) {
    constexpr int I_IN = 8 * (NPROJ / 32), I_P = 8 * 32, I_O = 16 * 32;
    if (r < I_IN) { const int kb = r / (NPROJ / 32), nb = r % (NPROJ / 32); tr_item_i8(A_.in[2] + (size_t)l * D * INC, INC, kb * 128, nb * 32 + (nb >= 104 ? 8 : 0), dst + MW_IN, D, nb * 32, F.lane); return; } r -= I_IN;
    if (r < I_P) { const int kb = r / 32, nb = r % 32; tr_item(A_.in[14] + (size_t)l * 512 * D, D, kb * 64, nb * 32, (bf16*)(dst + MW_PA), 512, nb * 32, scr, F.lane); return; } r -= I_P;
    if (r < I_P) { const int kb = r / 32, nb = r % 32; tr_item(A_.in[19] + (size_t)l * 512 * D, D, kb * 64, nb * 32, (bf16*)(dst + MW_PB), 512, nb * 32, scr, F.lane); return; } r -= I_P;
    { const int kb = r / 32, nb = r % 32; tr_item(A_.in[20] + (size_t)l * D * D, D, kb * 64, nb * 32, (bf16*)(dst + MW_OUT), D, nb * 32, scr, F.lane); }
}
constexpr int MIXER_ITEMS = 8 * (NPROJ / 32) + 2 * 8 * 32 + 16 * 32;
constexpr int FFN_ITEMS = 3 * 16 * (FF / 32);
__device__ __forceinline__ void conv_ffn_item(Frame& F, const float* wg, const float* wu, const float* wd, bf16* gu, bf16* dn, int r, LAS float* scr) {
    constexpr int I_G = 16 * (FF / 32);
    if (r < I_G) { const int kb = r / (FF / 32), nb = r % (FF / 32), n0 = nb * 32; tr_item(wg, FF, kb * 64, n0, gu, D, (n0 / 128) * 256 + (n0 % 128), scr, F.lane); return; } r -= I_G;
    if (r < I_G) { const int kb = r / (FF / 32), nb = r % (FF / 32), n0 = nb * 32; tr_item(wu, FF, kb * 64, n0, gu, D, (n0 / 128) * 256 + 128 + (n0 % 128), scr, F.lane); return; } r -= I_G;
    { const int kb = r / 32, nb = r % 32; tr_item(wd, D, kb * 64, nb * 32, dn, FF, nb * 32, scr, F.lane); }
}

constexpr int FFN_ITEMS8 = 3 * 8 * (FF / 32);
__device__ __forceinline__ void conv_ffn_item_f8(Frame& F, const float* wg, const float* wu, const float* wd, unsigned char* gu, unsigned char* dn, int r) {
    constexpr int I_G = 8 * (FF / 32);
    static_assert((FF / 128) * (D / 32) == I_G, "down items");
    if (r < I_G) { const int kb = r / (FF / 32), nb = r % (FF / 32), n0 = nb * 32; tr_item_i8(wg, FF, kb * 128, n0, gu, D, (n0 / 128) * 256 + (n0 % 128), F.lane); return; } r -= I_G;
    if (r < I_G) { const int kb = r / (FF / 32), nb = r % (FF / 32), n0 = nb * 32; tr_item_i8(wu, FF, kb * 128, n0, gu, D, (n0 / 128) * 256 + 128 + (n0 % 128), F.lane); return; } r -= I_G;
    { const int kb = r / 32, nb = r % 32; tr_item_f8(wd, D, kb * 128, nb * 32, dn, FF, nb * 32, F.lane, F8_SW); }
}

template <int MODE>
__device__ __forceinline__ void norm_phase(Frame& F, const float* xin, const float* gain, const float* w8src, int w8ld) {
    bf16* XN = (bf16*)(F.ws + WS_XN);
    f32x4 gv[4];
#pragma unroll
    for (int j = 0; j < 4; ++j) { gv[j] = *(const f32x4*)(gain + 4 * F.lane + 256 * j); }
    float w8[4][4][8];
    if constexpr (MODE == 0 || MODE == 2) {
#pragma unroll
        for (int j = 0; j < 4; ++j)
#pragma unroll
            for (int q = 0; q < 4; ++q) { const float* s = w8src + (size_t)(4 * F.lane + 256 * j + q) * w8ld; const f32x4 a = *(const f32x4*)s, b = *(const f32x4*)(s + 4);
                w8[j][q][0] = a[0]; w8[j][q][1] = a[1]; w8[j][q][2] = a[2]; w8[j][q][3] = a[3]; w8[j][q][4] = b[0]; w8[j][q][5] = b[1]; w8[j][q][6] = b[2]; w8[j][q][7] = b[3]; }
    }
    LAS int* cnt = (LAS int*)(F.lds);
    for (int p = F.vcu; p < M / 256; p += F.G) {
        if constexpr (MODE == 2) { if (F.tid < 16) cnt[F.tid] = 0; __syncthreads(); }
        f32x4 nx[4][4];
#pragma unroll
        for (int r = 0; r < 4; ++r) { const GAS f32x4* xr = (const GAS f32x4*)(xin + (size_t)(p * 256 + r * 8 + F.wave) * D) + F.lane;
#pragma unroll
            for (int j = 0; j < 4; ++j) nx[r][j] = __builtin_nontemporal_load(&xr[64 * j]); }
#pragma unroll 4
        for (int i = 0; i < 32; ++i) {
            const int m = p * 256 + i * 8 + F.wave;
            f32x4 v[4]; float s = 0.f;
            if constexpr (MODE == 3) {
                const GAS v2u* tr = (const GAS v2u*)(XN + (size_t)m * D) + F.lane;
#pragma unroll
                for (int j = 0; j < 4; ++j) { const v2u t2 = __builtin_nontemporal_load(&tr[64 * j]); nx[i & 3][j] += (f32x4){bf_lo(t2.x), bf_hi(t2.x), bf_lo(t2.y), bf_hi(t2.y)}; } }
#pragma unroll
            for (int j = 0; j < 4; ++j) { v[j] = nx[i & 3][j]; s += (v[j].x * v[j].x + v[j].y * v[j].y) + (v[j].z * v[j].z + v[j].w * v[j].w); }
            if (i + 4 < 32) { const GAS f32x4* xr = (const GAS f32x4*)(xin + (size_t)(m + 32) * D) + F.lane;
#pragma unroll
                for (int j = 0; j < 4; ++j) nx[i & 3][j] = __builtin_nontemporal_load(&xr[64 * j]); }
            const float rstd = 1.0f / sqrtf(wave_sum(s) * (1.f / D) + 1e-6f);
#pragma unroll
            for (int j = 0; j < 4; ++j) v[j] = v[j] * rstd * gv[j];
            if constexpr (MODE == 3) { GAS f32x4* o = (GAS f32x4*)(F.out + (size_t)m * D) + F.lane;
#pragma unroll
                for (int j = 0; j < 4; ++j) __builtin_nontemporal_store(v[j], &o[64 * j]);
            } else if constexpr (MODE == 0 || MODE == 1 || MODE == 2) {
                float am = 0.f;
#pragma unroll
                for (int j = 0; j < 4; ++j) am = fmaxf(fmaxf(am, fmaxf(fabsf(v[j].x), fabsf(v[j].y))), fmaxf(fabsf(v[j].z), fabsf(v[j].w)));
                am = fmaxf(wave_max(am), 1e-20f);
                const float qi = 127.f * __builtin_amdgcn_rcpf(am);
                if (F.lane == 0) ((float*)(F.ws + WS_RS))[m] = am * (1.f / 127.f);
                GAS unsigned* o4 = (GAS unsigned*)((unsigned char*)XN + (size_t)m * D) + F.lane;
#pragma unroll
                for (int j = 0; j < 4; ++j) o4[64 * j] = q8x4(v[j].x * qi, v[j].y * qi, v[j].z * qi, v[j].w * qi);
            } else { GAS v2u* o8 = (GAS v2u*)(XN + (size_t)m * D) + F.lane;
#pragma unroll
                for (int j = 0; j < 4; ++j) { v2u w; w.x = pk2(v[j].x, v[j].y); w.y = pk2(v[j].z, v[j].w); o8[64 * j] = w; } }
            if constexpr (MODE == 0 || MODE == 2) {
                f32x2 pa2[4];
#pragma unroll
                for (int e2 = 0; e2 < 4; ++e2) pa2[e2] = (f32x2){0.f, 0.f};
#pragma unroll
                for (int j = 0; j < 4; ++j)
#pragma unroll
                    for (int q = 0; q < 4; ++q) { const float vv = v[j][q]; const f32x2 v2 = {vv, vv};
#pragma unroll
                        for (int e2 = 0; e2 < 4; ++e2) pa2[e2] += v2 * (f32x2){w8[j][q][2 * e2], w8[j][q][2 * e2 + 1]}; }
                const float pa[8] = {pa2[0][0], pa2[0][1], pa2[1][0], pa2[1][1], pa2[2][0], pa2[2][1], pa2[3][0], pa2[3][1]};
                const float tot = reduce8(pa, F.lane);
                if constexpr (MODE == 0) { if (F.lane < 8) ((float*)(F.ws + WS_AB))[(size_t)m * 8 + F.lane] = tot; }
                else {
                    float pr[8];
#pragma unroll
                    for (int e = 0; e < 8; ++e) pr[e] = __builtin_bit_cast(float, __builtin_amdgcn_readlane(__builtin_bit_cast(int, tot), e));
                    float b1 = pr[0]; int e1 = 0;
#pragma unroll
                    for (int e = 1; e < 8; ++e) if (pr[e] > b1) { b1 = pr[e]; e1 = e; }
                    float b2 = -3.0e38f; int e2 = 0;
#pragma unroll
                    for (int e = 0; e < 8; ++e) if (e != e1 && pr[e] > b2) { b2 = pr[e]; e2 = e; }
                    const float g1 = 1.0f / (1.0f + __expf(b2 - b1));
                    if (F.lane == 0) { ((int*)(F.ws + WS_RE))[m] = e1 | (e2 << 4); ((float*)(F.ws + WS_RG))[m] = g1; __hip_atomic_fetch_add(&cnt[e1], 1, __ATOMIC_RELAXED, __HIP_MEMORY_SCOPE_WORKGROUP); __hip_atomic_fetch_add(&cnt[8 + e2], 1, __ATOMIC_RELAXED, __HIP_MEMORY_SCOPE_WORKGROUP); }
                }
            }
        }
        if constexpr (MODE == 2) { __syncthreads(); if (F.tid < 16) ((int*)(F.ws + WS_WGCNT))[p * 16 + F.tid] = cnt[F.tid]; __syncthreads(); }
    }
}

__device__ __forceinline__ void route_scatter(Frame& F) {
    LAS int* sh = (LAS int*)F.lds;
    const int* wgcnt = (const int*)(F.ws + WS_WGCNT);
    int* list = (int*)(F.ws + WS_LIST); float* gatel = (float*)(F.ws + WS_GATEL); int* grp = (int*)(F.ws + WS_GRP); float* rsl = (float*)(F.ws + WS_RSL); const float* rsv = (const float*)(F.ws + WS_RS);
    const int* re = (const int*)(F.ws + WS_RE); const float* rg = (const float*)(F.ws + WS_RG);
    for (int p = F.vcu; p < M / 256; p += F.G) {
        __syncthreads();
        { const int g = F.tid & 15, part = F.tid >> 4; int tot = 0, pre = 0;
#pragma unroll
          for (int j = 0; j < 8; ++j) { const int q = part * 8 + j; const int c = wgcnt[q * 16 + g]; pre += (q < p) ? c : 0; tot += c; }
          sh[128 + part * 16 + g] = tot; sh[128 + 512 + part * 16 + g] = pre; }
        __syncthreads();
        if (F.tid < 16) { int tot = 0, pre = 0; for (int q = 0; q < 32; ++q) { tot += sh[128 + q * 16 + F.tid]; pre += sh[128 + 512 + q * 16 + F.tid]; } sh[F.tid] = tot; sh[16 + F.tid] = pre; }
        __syncthreads();
        if (F.tid == 0) { int b = 0; for (int g = 0; g < 16; ++g) { sh[32 + g] = b; b += (sh[g] + 255) & ~255; } sh[48] = b; }
        __syncthreads();
        if (p == 0) {
            if (F.tid <= 16) grp[F.tid] = sh[32 + F.tid];
            if (F.tid < 16) grp[17 + F.tid] = sh[F.tid];
            for (int g = 0; g < 16; ++g) { const int lo = sh[32 + g] + sh[g], hi = sh[32 + g + 1]; for (int q = lo + F.tid; q < hi; q += NWAVES * 64) { list[q] = -1; gatel[q] = 0.f; rsl[q] = 0.f; } }
        }
        int e1 = 0, e2 = 0; float g1 = 0.f; int r1 = 0, r2 = 0;
        if (F.tid < 256) {
            const int m = p * 256 + F.tid; const int ee = re[m]; e1 = ee & 15; e2 = ee >> 4; g1 = rg[m];
#pragma unroll
            for (int e = 0; e < 8; ++e) {
                const unsigned long long m1 = __ballot(e1 == e), m2 = __ballot(e2 == e); const unsigned long long lt = (1ull << F.lane) - 1ull;
                if (e1 == e) r1 = __popcll(m1 & lt); if (e2 == e) r2 = __popcll(m2 & lt);
                if (F.lane == 0) { sh[64 + F.wave * 16 + e] = __popcll(m1); sh[64 + F.wave * 16 + 8 + e] = __popcll(m2); }
            }
        }
        __syncthreads();
        if (F.tid < 256) {
            const int m = p * 256 + F.tid; int o1 = sh[32 + e1] + sh[16 + e1] + r1, o2 = sh[32 + 8 + e2] + sh[16 + 8 + e2] + r2;
            for (int w = 0; w < F.wave; ++w) { o1 += sh[64 + w * 16 + e1]; o2 += sh[64 + w * 16 + 8 + e2]; }
            const float sm = rsv[m];
            list[o1] = m; gatel[o1] = g1; rsl[o1] = sm; list[o2] = m; gatel[o2] = 1.0f - g1; rsl[o2] = sm;
        }
    }
}

constexpr int CH = 16, NCH = T / CH;
constexpr int RW_BYTES = 60736;
static_assert(2 * RW_BYTES <= RING_BYTES, "rwkv lds");
constexpr int XA_PITCH = 528;

typedef short bf16x4 __attribute__((ext_vector_type(4)));
#define MFMA32(a, b, c) __builtin_amdgcn_mfma_f32_16x16x32_bf16(a, b, c, 0, 0, 0)
#define MFMA16(a, b, c) __builtin_amdgcn_mfma_f32_16x16x16bf16_1k(a, b, c, 0, 0, 0)
__device__ __forceinline__ unsigned cvt2(float a, float b) { const f32x2 v = {a, b}; const bf16v2_t r = __builtin_convertvector(v, bf16v2_t); return __builtin_bit_cast(unsigned, r); }
__device__ __forceinline__ bf16x4 pack4(float a, float b, float c, float d) { v2u w; w.x = cvt2(a, b); w.y = cvt2(c, d); return __builtin_bit_cast(bf16x4, w); }
__device__ __forceinline__ bf16x8 pack8(const f32x4 a, const f32x4 b) { v4u w; w.x = cvt2(a[0], a[1]); w.y = cvt2(a[2], a[3]); w.z = cvt2(b[0], b[1]); w.w = cvt2(b[2], b[3]); return __builtin_bit_cast(bf16x8, w); }
#define WAVE_LDS_FENCE() asm volatile("s_waitcnt lgkmcnt(0)" ::: "memory")
constexpr int G2_KI = 0, G2_QI = 17408, G2_KT = 34816, G2_VT = 53248, G2_GR = 71680, G2_BE = 71936, G2_GC = 72192, G2_NM = 72448, G2_TI = 76544, G2_O = 79104, G2_CW = G2_O + 64 * 528, G2_BYTES = G2_CW + 4 * 384 * 4;
constexpr int G2_IP = 272, G2_TP = 144, G2_TIP = 40, G2_OP = 132;
static_assert(G2_BYTES <= RING_BYTES, "gdn lds");
constexpr int GB = 64, NGB = T / GB;

__device__ __forceinline__ void gdn_unit2(Frame& F, const Args& A_, int layer, int u) {
    const int b = u >> 2, h = u & 3, tid = F.tid, lane = F.lane, w = F.wave, c = lane & 15, g = lane >> 4;
    LAS unsigned char* L = F.lds;
    LAS float* GR = (LAS float*)(L + G2_GR); LAS float* BE = (LAS float*)(L + G2_BE); LAS float* GC = (LAS float*)(L + G2_GC); LAS float* NM = (LAS float*)(L + G2_NM); LAS float* Om = (LAS float*)(L + G2_O);
    const bf16* PROJ = (const bf16*)(F.ws + WS_PROJ);
    bf16* OUT = (bf16*)(F.ws + WS_XN);
    const float* AB = (const float*)(F.ws + WS_AB);
    const int part = g, cg = c;
    const int colbase = (part == 0 ? C_GQ : (part == 1 ? C_GK : C_GV)) + h * 128 + 8 * cg;
    LAS float* CW = (LAS float*)(L + G2_CW);
    for (int idx = tid; idx < 4 * 384; idx += NWAVES * 64) { const int j = idx / 384, cc = idx % 384; CW[idx] = A_.in[15][(size_t)layer * 4 * 1536 + j * 1536 + (cc >> 7) * 512 + h * 128 + (cc & 127)]; }
    const int cwoff = (part < 3 ? part : 0) * 128 + 8 * cg;
    __syncthreads();
    const float nexpa = -__expf(A_.in[16][layer * 4 + h]), dtb = A_.in[17][layer * 4 + h];
    const int d0 = (8 * cg) & 31, pc0 = (8 * cg & ~31) + 8 * ((d0 >> 2) & 3) + 4 * (d0 >> 4);
    const int ptok = tid >> 3, pch = (tid & 7) * 16;
    f32x4 S[8];
#pragma unroll
    for (int m = 0; m < 8; ++m) S[m] = (f32x4){0.f, 0.f, 0.f, 0.f};
    v4u pre[11]; v4u zpre[2]; float abpre[2];
    auto prefetch = [&](int bt) {
        const int tb = bt * GB;
#pragma unroll
        for (int i = 0; i < 11; ++i) { const int tok = tb + 8 * w - 3 + i; pre[i] = (v4u){0u, 0u, 0u, 0u};
            if (part < 3 && tok >= 0) pre[i] = *(const GAS v4u*)(PROJ + (size_t)(b * T + tok) * NPROJ + colbase); }
        abpre[0] = 0.f; abpre[1] = 0.f;
        if (part == 3 && cg < 8) { const float* ab = AB + (size_t)(b * T + tb + 8 * w + cg) * 8; abpre[0] = ab[h]; abpre[1] = ab[4 + h]; }
    };
    prefetch(0);
    for (int bt = 0; bt < NGB; ++bt) {
        const int tb = bt * GB;
        if (!(PADF & 4)) {
            unsigned ktp[8][4];
            float xr[4][8];
#pragma unroll
            for (int i = 0; i < 3; ++i) { xr[i][0] = bf_lo(pre[i].x); xr[i][1] = bf_hi(pre[i].x); xr[i][2] = bf_lo(pre[i].y); xr[i][3] = bf_hi(pre[i].y); xr[i][4] = bf_lo(pre[i].z); xr[i][5] = bf_hi(pre[i].z); xr[i][6] = bf_lo(pre[i].w); xr[i][7] = bf_hi(pre[i].w); }
            float yprev[8];
#pragma unroll
            for (int tk = 0; tk < 8; ++tk) {
                const v4u pw = pre[tk + 3];
                xr[3][0] = bf_lo(pw.x); xr[3][1] = bf_hi(pw.x); xr[3][2] = bf_lo(pw.y); xr[3][3] = bf_hi(pw.y); xr[3][4] = bf_lo(pw.z); xr[3][5] = bf_hi(pw.z); xr[3][6] = bf_lo(pw.w); xr[3][7] = bf_hi(pw.w);
                float y[8]; float ss = 0.f;
#pragma unroll
                for (int e = 0; e < 8; ++e) y[e] = 0.f;
#pragma unroll
                for (int j = 0; j < 4; ++j) { const f32x4 wa = *(const LAS f32x4*)(CW + j * 384 + cwoff), wb = *(const LAS f32x4*)(CW + j * 384 + cwoff + 4);
#pragma unroll
                    for (int e = 0; e < 4; ++e) { y[e] += wa[e] * xr[j][e]; y[4 + e] += wb[e] * xr[j][4 + e]; } }
#pragma unroll
                for (int e = 0; e < 8; ++e) { const float a = y[e]; y[e] = a * sigmoidf_(a); ss += y[e] * y[e]; }
                ss = sum16(ss);
                const float sc = part == 2 ? 1.0f : (__builtin_amdgcn_rsqf(ss + 1e-6f)) * (part == 0 ? 0.08838834764831845f : 1.0f);
#pragma unroll
                for (int e = 0; e < 8; ++e) y[e] *= sc;
                const int trow = 8 * w + tk;
                if (part < 2) { LAS unsigned char* img = L + (part == 0 ? G2_QI : G2_KI) + trow * G2_IP;
                    v2u a0; a0.x = pg8::cvt_pk_bf16(y[0], y[1]); a0.y = pg8::cvt_pk_bf16(y[2], y[3]); v2u a1; a1.x = pg8::cvt_pk_bf16(y[4], y[5]); a1.y = pg8::cvt_pk_bf16(y[6], y[7]);
                    *(LAS v2u*)(img + pc0 * 2) = a0; *(LAS v2u*)(img + (pc0 + 8) * 2) = a1; }
                if (tk & 1) {
#pragma unroll
                    for (int e = 0; e < 8; ++e) ktp[e][tk >> 1] = pg8::cvt_pk_bf16(yprev[e], y[e]); }
#pragma unroll
                for (int e = 0; e < 8; ++e) yprev[e] = y[e];
#pragma unroll
                for (int e = 0; e < 8; ++e) { xr[0][e] = xr[1][e]; xr[1][e] = xr[2][e]; xr[2][e] = xr[3][e]; }
            }
            if (part == 1 || part == 2) { LAS unsigned char* timg = L + (part == 1 ? G2_KT : G2_VT);
#pragma unroll
                for (int e = 0; e < 8; ++e) { v4u o; o.x = ktp[e][0]; o.y = ktp[e][1]; o.z = ktp[e][2]; o.w = ktp[e][3]; *(LAS v4u*)(timg + (8 * cg + e) * G2_TP + (8 * w) * 2) = o; } }
            if (part == 3 && cg < 8) { GR[8 * w + cg] = nexpa * softplusf_(abpre[0] + dtb); BE[8 * w + cg] = sigmoidf_(abpre[1]); }
        }
        __syncthreads();
        if (bt + 1 < NGB) prefetch(bt + 1);
        { const bf16* zp = PROJ + (size_t)(b * T + tb + ptok) * NPROJ + C_Z + h * 128 + pch; zpre[0] = *(const GAS v4u*)zp; zpre[1] = *(const GAS v4u*)(zp + 8); }
        if (w < 4 && !(PADF & 8)) {
            const int i = w;
            float gv = GR[16 * i + c];
#pragma unroll
            for (int o = 1; o < 16; o <<= 1) { const float t_ = __shfl_up(gv, o, 16); if (c >= o) gv += t_; }
            if (g == 0) GC[16 * i + c] = gv;
            f32x4 acc = (f32x4){0.f, 0.f, 0.f, 0.f};
            const LAS unsigned char* rowK = L + G2_KI + (16 * i + c) * G2_IP + g * 16;
#pragma unroll
            for (int s = 0; s < 4; ++s) { const bf16x8 f = *(const LAS bf16x8*)(rowK + 64 * s); acc = MFMA32(f, f, acc); }
            WAVE_LDS_FENCE();
            const f32x4 gct = *(const LAS f32x4*)(GC + 16 * i + 4 * g), bet = *(const LAS f32x4*)(BE + 16 * i + 4 * g);
#pragma unroll
            for (int r = 0; r < 4; ++r) { const int t_ = 4 * g + r; NM[i * 256 + t_ * 16 + c] = (c < t_) ? -bet[r] * acc[r] * __expf(fminf(gct[r] - gv, 0.f)) : 0.f; }
            WAVE_LDS_FENCE();
            float Tc[16];
#pragma unroll
            for (int t_ = 0; t_ < 16; ++t_) { float a = (t_ == c) ? 1.f : 0.f;
#pragma unroll
                for (int q4 = 0; q4 * 4 < t_; ++q4) { const f32x4 n4 = *(const LAS f32x4*)(NM + i * 256 + t_ * 16 + 4 * q4);
#pragma unroll
                    for (int e = 0; e < 4; ++e) if (4 * q4 + e < t_) a += n4[e] * Tc[4 * q4 + e]; }
                Tc[t_] = a; }
            if (g == 0) {
#pragma unroll
                for (int t_ = 0; t_ < 16; ++t_) *(LAS bf16*)(L + G2_TI + i * (16 * G2_TIP) + t_ * G2_TIP + c * 2) = (bf16)f2bf(Tc[t_]); }
        }
        __syncthreads();
#pragma unroll 1
        for (int i = (PADF & 16) ? 4 : 0; i < 4; ++i) {
            const LAS unsigned char* rowK = L + G2_KI + (16 * i + c) * G2_IP + g * 16; const LAS unsigned char* rowQ = L + G2_QI + (16 * i + c) * G2_IP + g * 16;
            bf16x8 kf[4], qf[4];
#pragma unroll
            for (int s = 0; s < 4; ++s) { kf[s] = *(const LAS bf16x8*)(rowK + 64 * s); qf[s] = *(const LAS bf16x8*)(rowQ + 64 * s); }
            const float gcc = GC[16 * i + c], gl = GC[16 * i + 15];
            const f32x4 gcr = *(const LAS f32x4*)(GC + 16 * i + 4 * g), ber = *(const LAS f32x4*)(BE + 16 * i + 4 * g);
            const v2u vw = *(const LAS v2u*)(L + G2_VT + (16 * w + c) * G2_TP + (16 * i + 4 * g) * 2);
            const bf16x4 tf = *(const LAS bf16x4*)(L + G2_TI + i * (16 * G2_TIP) + c * G2_TIP + g * 8);
            f32x4 dq = (f32x4){0.f, 0.f, 0.f, 0.f};
#pragma unroll
            for (int s = 0; s < 4; ++s) dq = MFMA32(kf[s], qf[s], dq);
            bf16x8 Sb[4];
#pragma unroll
            for (int s = 0; s < 4; ++s) Sb[s] = pack8(S[2 * s], S[2 * s + 1]);
            f32x4 y = (f32x4){0.f, 0.f, 0.f, 0.f}, qs = y;
#pragma unroll
            for (int s = 0; s < 4; ++s) y = MFMA32(kf[s], Sb[s], y);
#pragma unroll
            for (int s = 0; s < 4; ++s) qs = MFMA32(qf[s], Sb[s], qs);
            float qa[4], egr[4], xv[4];
            const float vv[4] = {bf_lo(vw.x), bf_hi(vw.x), bf_lo(vw.y), bf_hi(vw.y)};
#pragma unroll
            for (int r = 0; r < 4; ++r) { qa[r] = (4 * g + r <= c) ? dq[r] * __expf(fminf(gcc - gcr[r], 0.f)) : 0.f; egr[r] = __expf(gcr[r]); xv[r] = ber[r] * (vv[r] - egr[r] * y[r]); qs[r] *= egr[r]; }
            const f32x4 vn = MFMA16(tf, pack4(xv[0], xv[1], xv[2], xv[3]), ((f32x4){0.f, 0.f, 0.f, 0.f}));
            const f32x4 o = MFMA16(pack4(qa[0], qa[1], qa[2], qa[3]), pack4(vn[0], vn[1], vn[2], vn[3]), qs);
#pragma unroll
            for (int r = 0; r < 4; ++r) Om[(16 * i + 4 * g + r) * G2_OP + 16 * w + c] = o[r];
            const float egl = __expf(gl);
            const bf16x4 vsb = pack4(vn[0] * __expf(gl - gcr[0]), vn[1] * __expf(gl - gcr[1]), vn[2] * __expf(gl - gcr[2]), vn[3] * __expf(gl - gcr[3]));
#pragma unroll
            for (int m = 0; m < 8; ++m) { const bf16x4 kt = *(const LAS bf16x4*)(L + G2_KT + (16 * m + c) * G2_TP + (16 * i + 4 * g) * 2); S[m] = MFMA16(kt, vsb, S[m] * egl); }
        }
        __syncthreads();
        if (!(PADF & 32)) {
            f32x4 o4[4]; float ss = 0.f;
#pragma unroll
            for (int q = 0; q < 4; ++q) { o4[q] = *(const LAS f32x4*)(Om + ptok * G2_OP + pch + 4 * q); ss += (o4[q][0] * o4[q][0] + o4[q][1] * o4[q][1]) + (o4[q][2] * o4[q][2] + o4[q][3] * o4[q][3]); }
            ss = sum8(ss);
            const float rs = __builtin_amdgcn_rsqf(ss * (1.f / 128.f) + 1e-6f);
            const float* gp = A_.in[18] + layer * 128 + pch;
            const unsigned zz[8] = {zpre[0].x, zpre[0].y, zpre[0].z, zpre[0].w, zpre[1].x, zpre[1].y, zpre[1].z, zpre[1].w};
            unsigned ow[8];
#pragma unroll
            for (int q = 0; q < 4; ++q) { const f32x4 gq = *(const f32x4*)(gp + 4 * q);
                const float za = bf_lo(zz[2 * q]), zb = bf_hi(zz[2 * q]), zc = bf_lo(zz[2 * q + 1]), zd = bf_hi(zz[2 * q + 1]);
                ow[2 * q] = pk2(o4[q][0] * rs * gq[0] * za * sigmoidf_(za), o4[q][1] * rs * gq[1] * zb * sigmoidf_(zb));
                ow[2 * q + 1] = pk2(o4[q][2] * rs * gq[2] * zc * sigmoidf_(zc), o4[q][3] * rs * gq[3] * zd * sigmoidf_(zd)); }
            bf16* op = OUT + (size_t)(b * T + tb + ptok) * D + 512 + h * 128 + pch;
            *(GAS v4u*)op = (v4u){ow[0], ow[1], ow[2], ow[3]}; *(GAS v4u*)(op + 8) = (v4u){ow[4], ow[5], ow[6], ow[7]};
        }
    }
    __syncthreads();
}

constexpr int R2_AI = 0, R2_BI = 2304, R2_KI = 4608, R2_RI = 6912, R2_VI = 9216, R2_W15 = 16896;
constexpr int R2_IP = 144, R2_TP = 40;
constexpr int R3_XA = 0, R3_R = 8448, R3_KM = 12544, R3_V = 16640, R3_LW = 20736, R3_AV = 24832, R3_G = 28928, R3_O = 33024, R3_BON = 37120, R3_MU = 37184, R3_IMG = 38976;
static_assert(R3_IMG + R2_W15 + 256 <= RW_BYTES && R3_R + 32768 <= RW_BYTES, "rwkv lds map");
__device__ __forceinline__ float fast_tanh(float x) { const float e = __expf(2.0f * x); return 1.0f - 2.0f * __builtin_amdgcn_rcpf(e + 1.0f); }
__device__ __forceinline__ float fast_softplus(float x) { return x > 20.f ? x : __logf(1.0f + __expf(x)); }
__device__ __forceinline__ bf16x4 pack4v(const f32x4 v) { return pack4(v[0], v[1], v[2], v[3]); }

__device__ __forceinline__ void rwkv_pair2(Frame& F, const Args& A_, int layer, int pairidx) {
    const int half = F.wave >> 2, wq = F.wave & 3, ht = F.tid & 255, lane = F.lane, c = lane & 15, g = lane >> 4;
    const int h = 2 * (pairidx & 3) + half, b = pairidx >> 2;
    LAS unsigned char* L = F.lds + half * RW_BYTES;
    LAS float* Rm = (LAS float*)(L + R3_R); LAS float* KM = (LAS float*)(L + R3_KM); LAS float* Vm = (LAS float*)(L + R3_V); LAS float* LW = (LAS float*)(L + R3_LW);
    LAS float* AV = (LAS float*)(L + R3_AV); LAS float* Gm = (LAS float*)(L + R3_G);
    LAS float* Om = (LAS float*)(L + R3_O); LAS float* BON = (LAS float*)(L + R3_BON); LAS float* MU = (LAS float*)(L + R3_MU);
    LAS unsigned char* IM = L + R3_IMG;
    const bf16* PROJ = (const bf16*)(F.ws + WS_PROJ);
    bf16* OUT = (bf16*)(F.ws + WS_XN);
    const int jc = 16 * wq + c, kg = g, hj = h * 64 + jc;
    bf16x8 bd[2], bi[2], bg[4];
    {
        const float* Wd = A_.in[5] + (size_t)layer * 64 * 512 + h * 64; const float* Wi = A_.in[7] + (size_t)layer * 64 * 512 + h * 64; const float* Wg = A_.in[8] + (size_t)layer * 128 * 512 + h * 64;
        LAS bf16* WT = (LAS bf16*)(L + R3_R);
#pragma unroll 1
        for (int idx = ht; idx < 4096; idx += 256) { const int k = idx >> 6, j = idx & 63; WT[j * 64 + k] = (bf16)f2bf(Wd[(size_t)k * 512 + j]); WT[4096 + j * 64 + k] = (bf16)f2bf(Wi[(size_t)k * 512 + j]); }
#pragma unroll 1
        for (int idx = ht; idx < 8192; idx += 256) { const int k = idx >> 6, j = idx & 63; WT[8192 + j * 128 + k] = (bf16)f2bf(Wg[(size_t)k * 512 + j]); }
        __syncthreads();
#pragma unroll
        for (int s = 0; s < 2; ++s) { bd[s] = *(const LAS bf16x8*)(WT + jc * 64 + 32 * s + 8 * kg); bi[s] = *(const LAS bf16x8*)(WT + 4096 + jc * 64 + 32 * s + 8 * kg); }
#pragma unroll
        for (int s = 0; s < 4; ++s) bg[s] = *(const LAS bf16x8*)(WT + 8192 + jc * 128 + 32 * s + 8 * kg);
        __syncthreads();
    }
    const float w0c = A_.in[4][layer * 512 + hj], a0c = A_.in[6][layer * 512 + hj];
    const int tid = F.tid;
    const int atok = tid >> 5, apc = tid & 31;
    int bun[2], btok[2], bpc[2]; bool bval[2];
#pragma unroll
    for (int j = 0; j < 2; ++j) { const int idx = tid + 512 * j; bval[j] = idx < 768; const int ii = bval[j] ? idx : 0; bun[j] = ii / 384; const int rem = ii - 384 * bun[j]; btok[j] = rem / 24; bpc[j] = rem - 24 * btok[j]; }
    f32x4 amu[2], bmu[2][2];
    { const float* mup = A_.in[3] + layer * 1792;
      amu[0] = *(const f32x4*)(mup + C_WL + 8 * apc); amu[1] = *(const f32x4*)(mup + C_WL + 8 * apc + 4);
#pragma unroll
      for (int j = 0; j < 2; ++j) { const int hh = 2 * (pairidx & 3) + bun[j]; const int col = (bpc[j] < 8 ? C_R : (bpc[j] < 16 ? C_K : C_V)) + hh * 64 + 8 * (bpc[j] & 7);
          bmu[j][0] = *(const f32x4*)(mup + col); bmu[j][1] = *(const f32x4*)(mup + col + 4); } }
    const bool a_th = apc < 8, a_id = apc >= 8 && apc < 16;
    constexpr size_t CHB = (size_t)CH * NPROJ * 2;
    const size_t aoff = ((size_t)(b * T + atok) * NPROJ + C_WL + 8 * apc) * 2;
    size_t boff[2]; unsigned bdst[2];
#pragma unroll
    for (int j = 0; j < 2; ++j) { const int hh = 2 * (pairidx & 3) + bun[j]; const int col = (bpc[j] < 8 ? C_R : (bpc[j] < 16 ? C_K : C_V)) + hh * 64 + 8 * (bpc[j] & 7);
        boff[j] = ((size_t)(b * T + btok[j]) * NPROJ + col) * 2;
        bdst[j] = (unsigned)(bun[j] * RW_BYTES + (bpc[j] < 8 ? R3_R : (bpc[j] < 16 ? R3_KM : R3_V)) + (btok[j] * 64 + 8 * (bpc[j] & 7)) * 4); }
    const unsigned adst = (unsigned)(R3_XA + atok * XA_PITCH + apc * 16);
    const int tt = ht >> 4, jq = (ht & 15) * 4;
    const f32x4 kkv = *(const f32x4*)(A_.in[9] + layer * 512 + h * 64 + jq), kav = *(const f32x4*)(A_.in[10] + layer * 512 + h * 64 + jq), rkv = *(const f32x4*)(A_.in[11] + layer * 512 + h * 64 + jq);
    const f32x4 lgv = *(const f32x4*)(A_.in[12] + layer * 512 + h * 64 + jq), lbv = *(const f32x4*)(A_.in[13] + layer * 512 + h * 64 + jq);
    const int pimg = (jq & ~31) + 8 * (((jq & 31) >> 2) & 3) + 4 * ((jq & 31) >> 4);
    bf16x4 ltri;
#pragma unroll
    for (int j = 0; j < 4; ++j) ltri[j] = (4 * g + j <= c) ? (short)0x3F80 : (short)0;
    f32x4 P[4];
#pragma unroll
    for (int m = 0; m < 4; ++m) P[m] = (f32x4){0.f, 0.f, 0.f, 0.f};
    struct PF { v4u acur, aprv, bcur[2], bprv[2]; };
    PF pf0, pf1;
    auto prefetch = [&](int ch, PF& q_) {
        const char* base = (const char*)PROJ + (size_t)ch * CHB;
        { const bool first = (ch == 0 && atok == 0); const char* p = base + aoff; q_.acur = *(const GAS v4u*)p; q_.aprv = *(const GAS v4u*)(first ? p : p - NPROJ * 2); }
#pragma unroll
        for (int j = 0; j < 2; ++j) { const bool first = (ch == 0 && btok[j] == 0); const char* p = base + boff[j]; q_.bcur[j] = *(const GAS v4u*)p; q_.bprv[j] = *(const GAS v4u*)(first ? p : p - NPROJ * 2); }
    };
    prefetch(0, pf0); prefetch(1, pf1);
    auto do_chunk = [&](const int ch, PF& q_) __attribute__((always_inline)) {
        const int t0 = ch * CH;
        v4u acur = q_.acur, aprv = q_.aprv, bcur[2] = {q_.bcur[0], q_.bcur[1]}, bprv[2] = {q_.bprv[0], q_.bprv[1]};
        if (ch == 0) {
            if (atok == 0) aprv = (v4u){0u, 0u, 0u, 0u};
#pragma unroll
            for (int j = 0; j < 2; ++j) if (btok[j] == 0) bprv[j] = (v4u){0u, 0u, 0u, 0u};
        }
        if (!(PADF & 64)) {
#define RW_UNPACK(W_, X_) const float X_[8] = {bf_lo((W_)[0]), bf_hi((W_)[0]), bf_lo((W_)[1]), bf_hi((W_)[1]), bf_lo((W_)[2]), bf_hi((W_)[2]), bf_lo((W_)[3]), bf_hi((W_)[3])}
            { RW_UNPACK(acur, xc); RW_UNPACK(aprv, xp);
              const float be = a_th ? 2.f : 1.f, ga = a_th ? -1.f : 0.f;
              float y[8];
#pragma unroll
              for (int e = 0; e < 8; ++e) { const float val = xc[e] + (xp[e] - xc[e]) * (e < 4 ? amu[0][e] : amu[1][e - 4]); const float sg = __builtin_amdgcn_rcpf(1.0f + __expf(-be * val)); y[e] = a_id ? val : be * sg + ga; }
              v4u o; o.x = pk2(y[0], y[1]); o.y = pk2(y[2], y[3]); o.z = pk2(y[4], y[5]); o.w = pk2(y[6], y[7]);
              *(LAS v4u*)(F.lds + adst) = o; }
#pragma unroll
            for (int j = 0; j < 2; ++j) if (bval[j]) { RW_UNPACK(bcur[j], xc); RW_UNPACK(bprv[j], xp);
                float val[8];
#pragma unroll
                for (int e = 0; e < 8; ++e) val[e] = xc[e] + (xp[e] - xc[e]) * (e < 4 ? bmu[j][0][e] : bmu[j][1][e - 4]);
                LAS float* dst = (LAS float*)(F.lds + bdst[j]);
                *(LAS f32x4*)dst = (f32x4){val[0], val[1], val[2], val[3]}; *(LAS f32x4*)(dst + 4) = (f32x4){val[4], val[5], val[6], val[7]}; }
#undef RW_UNPACK
        }
        if (ch + 2 < NCH) prefetch(ch + 2, q_);
        __syncthreads();
        if (!(PADF & 128)) {
            f32x4 ad = (f32x4){0.f, 0.f, 0.f, 0.f}, aa = ad, ag = ad;
            const LAS unsigned char* xa = F.lds + R3_XA + c * XA_PITCH + kg * 16;
#pragma unroll
            for (int s = 0; s < 2; ++s) ad = MFMA32(*(const LAS bf16x8*)(xa + s * 64), bd[s], ad);
#pragma unroll
            for (int s = 0; s < 2; ++s) aa = MFMA32(*(const LAS bf16x8*)(xa + 128 + s * 64), bi[s], aa);
#pragma unroll
            for (int s = 0; s < 4; ++s) ag = MFMA32(*(const LAS bf16x8*)(xa + 256 + s * 64), bg[s], ag);
            f32x4 lwv;
#pragma unroll
            for (int r = 0; r < 4; ++r) { const int t = 4 * kg + r;
                lwv[r] = -0.60653065971f * sigmoidf_(w0c + ad[r]);
                AV[t * 64 + jc] = sigmoidf_(a0c + aa[r]); Gm[t * 64 + jc] = ag[r]; }
            { const bf16x4 hi = pack4v(lwv); const v2u hw = __builtin_bit_cast(v2u, hi);
              const f32x4 lo = lwv - (f32x4){bf_lo(hw.x), bf_hi(hw.x), bf_lo(hw.y), bf_hi(hw.y)};
              f32x4 cs = MFMA16(ltri, hi, ((f32x4){0.f, 0.f, 0.f, 0.f})); cs = MFMA16(ltri, pack4v(lo), cs);
#pragma unroll
              for (int r = 0; r < 4; ++r) LW[(4 * kg + r) * 64 + jc] = cs[r]; }
        }
        __syncthreads();
        if (!(PADF & 256)) {
            const f32x4 k4 = *(const LAS f32x4*)(KM + tt * 64 + jq), a4 = *(const LAS f32x4*)(AV + tt * 64 + jq), r4 = *(const LAS f32x4*)(Rm + tt * 64 + jq), v4 = *(const LAS f32x4*)(Vm + tt * 64 + jq);
            const f32x4 cl = *(const LAS f32x4*)(LW + tt * 64 + jq);
            f32x4 clp = *(const LAS f32x4*)(LW + (tt > 0 ? tt - 1 : 0) * 64 + jq); if (tt == 0) clp = (f32x4){0.f, 0.f, 0.f, 0.f};
            const f32x4 kr = k4 * kkv; float ss = (kr[0] * kr[0] + kr[1] * kr[1]) + (kr[2] * kr[2] + kr[3] * kr[3]);
            ss = sum16(ss);
            const float inv = __builtin_amdgcn_rsqf(ss + 1e-6f);
            const f32x4 kk = kr * inv; const f32x4 km = k4 * (1.0f + (a4 - 1.0f) * kav);
            float bo = (r4[0] * km[0] * rkv[0] + r4[1] * km[1] * rkv[1]) + (r4[2] * km[2] * rkv[2] + r4[3] * km[3] * rkv[3]);
            bo = sum16(bo);
            if ((ht & 15) == 0) BON[tt] = bo;
            f32x4 wt, wi, wp;
#pragma unroll
            for (int e = 0; e < 4; ++e) { wt[e] = __expf(cl[e]); wi[e] = __expf(-cl[e]); wp[e] = __expf(clp[e]); }
            const f32x4 at = -kk * wp, bt = kk * a4 * wi, kt = km * wi, rt = r4 * wt;
            LAS unsigned char* irow = IM + tt * R2_IP + pimg * 2;
            { v2u w; w.x = pk2(at[0], at[1]); w.y = pk2(at[2], at[3]); *(LAS v2u*)(irow + R2_AI) = w; }
            { v2u w; w.x = pk2(bt[0], bt[1]); w.y = pk2(bt[2], bt[3]); *(LAS v2u*)(irow + R2_BI) = w; }
            { v2u w; w.x = pk2(kt[0], kt[1]); w.y = pk2(kt[2], kt[3]); *(LAS v2u*)(irow + R2_KI) = w; }
            { v2u w; w.x = pk2(rt[0], rt[1]); w.y = pk2(rt[2], rt[3]); *(LAS v2u*)(irow + R2_RI) = w; }
            { v2u w; w.x = pk2(v4[0], v4[1]); w.y = pk2(v4[2], v4[3]); *(LAS v2u*)(IM + R2_VI + tt * R2_IP + jq * 2) = w; }
            if (tt == 15) *(LAS f32x4*)(IM + R2_W15 + jq * 4) = wt;
        }
        __syncthreads();
        if (!(PADF & 512)) {
            bf16x8 af[2], bf_[2], kf[2], rf[2];
#pragma unroll
            for (int s = 0; s < 2; ++s) { const LAS unsigned char* p = IM + c * R2_IP + 64 * s + 16 * g;
                af[s] = *(const LAS bf16x8*)(p + R2_AI); bf_[s] = *(const LAS bf16x8*)(p + R2_BI); kf[s] = *(const LAS bf16x8*)(p + R2_KI); rf[s] = *(const LAS bf16x8*)(p + R2_RI); }
            const unsigned trb = (unsigned)(size_t)IM + (unsigned)((4 * g + ((lane >> 2) & 3)) * R2_IP + 16 * (lane & 3));
            const unsigned trv = (unsigned)(size_t)IM + (unsigned)(R2_VI + (4 * g + ((lane >> 2) & 3)) * R2_IP + 8 * (lane & 3) + 32 * wq);
            bf16x4 vt, btm[4], ktm[4];
            asm volatile("ds_read_b64_tr_b16 %0, %9\n\tds_read_b64_tr_b16 %1, %10 offset:%11\n\tds_read_b64_tr_b16 %2, %10 offset:%12\n\tds_read_b64_tr_b16 %3, %10 offset:%13\n\tds_read_b64_tr_b16 %4, %10 offset:%14\n\t"
                         "ds_read_b64_tr_b16 %5, %10 offset:%15\n\tds_read_b64_tr_b16 %6, %10 offset:%16\n\tds_read_b64_tr_b16 %7, %10 offset:%17\n\tds_read_b64_tr_b16 %8, %10 offset:%18\n\ts_waitcnt lgkmcnt(0)"
                         : "=&v"(vt), "=&v"(btm[0]), "=&v"(btm[1]), "=&v"(btm[2]), "=&v"(btm[3]), "=&v"(ktm[0]), "=&v"(ktm[1]), "=&v"(ktm[2]), "=&v"(ktm[3])
                         : "v"(trv), "v"(trb), "i"(R2_BI + 0), "i"(R2_BI + 8), "i"(R2_BI + 64), "i"(R2_BI + 72), "i"(R2_KI + 0), "i"(R2_KI + 8), "i"(R2_KI + 64), "i"(R2_KI + 72) : "memory");
            __builtin_amdgcn_sched_barrier(0);
            const f32x4 zero = (f32x4){0.f, 0.f, 0.f, 0.f};
            f32x4 X0 = zero, Y0 = zero, Dka = zero, Dbr = zero, Dkr = zero;
#pragma unroll
            for (int s = 0; s < 2; ++s) { X0 = MFMA32(af[s], bf_[s], X0); Y0 = MFMA32(bf_[s], af[s], Y0); Dka = MFMA32(kf[s], af[s], Dka); Dbr = MFMA32(bf_[s], rf[s], Dbr); Dkr = MFMA32(kf[s], rf[s], Dkr); }
            f32x4 idn;
#pragma unroll
            for (int r = 0; r < 4; ++r) { const int row = 4 * g + r; idn[r] = (row == c) ? 1.f : 0.f;
                X0[r] = (c < row) ? X0[r] : 0.f;
                Y0[r] = (row < c) ? Y0[r] : 0.f;
                Dka[r] = (row < c) ? Dka[r] : 0.f;
                Dbr[r] = (row <= c) ? Dbr[r] : 0.f; Dkr[r] = (row <= c) ? Dkr[r] : 0.f; }
            const bf16x4 x0b = pack4v(X0), y0b = pack4v(Y0);
            const f32x4 X1 = MFMA16(y0b, x0b, zero), Y1 = MFMA16(x0b, y0b, zero);
            const bf16x4 x1b = pack4v(X1), y1b = pack4v(Y1);
            const f32x4 X2 = MFMA16(y1b, x1b, zero), Y2 = MFMA16(x1b, y1b, zero);
            const bf16x4 x2b = pack4v(X2), y2b = pack4v(Y2);
            const f32x4 X3 = MFMA16(y2b, x2b, zero);
            f32x4 U = Y0 + idn;
            U = MFMA16(pack4v(X1 + idn), pack4v(U), zero);
            U = MFMA16(pack4v(X2 + idn), pack4v(U), zero);
            U = MFMA16(pack4v(X3 + idn), pack4v(U), zero);
            bf16x8 Pb[2];
#pragma unroll
            for (int s = 0; s < 2; ++s) Pb[s] = pack8(P[2 * s], P[2 * s + 1]);
            f32x4 X = zero, O = zero;
#pragma unroll
            for (int s = 0; s < 2; ++s) { X = MFMA32(af[s], Pb[s], X); O = MFMA32(rf[s], Pb[s], O); }
            X = MFMA16(pack4v(Dka), vt, X);
            const f32x4 Z = MFMA16(pack4v(U), pack4v(X), zero);
            const bf16x4 zb = pack4v(Z);
            O = MFMA16(pack4v(Dbr), zb, O);
            O = MFMA16(pack4v(Dkr), vt, O);
#pragma unroll
            for (int r = 0; r < 4; ++r) Om[(4 * g + r) * 64 + 16 * wq + c] = O[r];
#pragma unroll
            for (int m = 0; m < 4; ++m) {
                const f32x4 w15 = *(const LAS f32x4*)(IM + R2_W15 + (16 * m + 4 * g) * 4);
                f32x4 pm = MFMA16(btm[m], zb, P[m]); pm = MFMA16(ktm[m], vt, pm); P[m] = pm * w15; }
        }
        __syncthreads();
        if (!(PADF & 1024)) {
            const f32x4 o4 = *(const LAS f32x4*)(Om + tt * 64 + jq);
            float s1 = sum16((o4[0] + o4[1]) + (o4[2] + o4[3]));
            const float mean = s1 * (1.f / 64.f); const f32x4 d4 = o4 - mean;
            float s2 = sum16((d4[0] * d4[0] + d4[1] * d4[1]) + (d4[2] * d4[2] + d4[3] * d4[3]));
            const float rs = __builtin_amdgcn_rsqf(s2 * (1.f / 64.f) + 64e-5f);
            f32x4 v4;
            { const v2u vw = *(const LAS v2u*)(IM + R2_VI + tt * R2_IP + jq * 2); v4 = (f32x4){bf_lo(vw.x), bf_hi(vw.x), bf_lo(vw.y), bf_hi(vw.y)}; }
            const f32x4 g4 = *(const LAS f32x4*)(Gm + tt * 64 + jq);
            const f32x4 y = ((d4 * rs) * lgv + lbv + v4 * BON[tt]) * g4;
            v2u w; w.x = pk2(y[0], y[1]); w.y = pk2(y[2], y[3]);
            *(GAS v2u*)(OUT + (size_t)(b * T + t0 + tt) * D + h * 64 + jq) = w;
        }
    };
    for (int ch = 0; ch < NCH; ch += 2) { do_chunk(ch, pf0); do_chunk(ch + 1, pf1); }
    __syncthreads();
}

constexpr int NPHASE = 19;
#ifndef PH_ONLY
#define PH_ONLY -1
#endif
#define PROBE_SCAN 0
#ifndef SCAN_SEL
#define SCAN_SEL 0
#endif
#define PH_ON(k) (PH_ONLY < 0 || PH_ONLY == (k))

template <int LAYER>
__device__ __forceinline__ void layer_phases(Frame& F, const Args& A_, const XcdBarrier& bar, const int lo, const int hi) {
#define IN(k) (PH_ON(k) && lo <= (k) && (k) < hi)
#define SEAM(k) do { if (lo <= (k) && (k) + 1 < hi) xcd_barrier(bar); } while (0)
    bf16* XN = (bf16*)(F.ws + WS_XN); bf16* PROJ = (bf16*)(F.ws + WS_PROJ);
    const int gw = F.vcu * NWAVES + F.wave, NGW = F.G * NWAVES;
    constexpr int pb = 1 + LAYER * 8;
    unsigned char* wmix = LAYER == 0 ? F.ws + WS_WS : F.ws + WS_W1;
    const float* xres = LAYER == 0 ? A_.in[0] : F.out;
    if (IN(pb)) {
        pg8::Gemm g{XN, (const bf16*)(wmix + MW_IN), D, D, D, nullptr}; pg8::StaticOrder S; S.init(M / 256, NPROJ / 256, F.G, (int)blockIdx.x);
        pg8::EpiBf16PlainS E{PROJ, NPROJ, (const float*)(F.ws + WS_RS), I8_WS};
        pg8::gemm_phase<pg8::EpiBf16PlainS, pg8::StaticOrder, true, true, false, 2>(F.lds, g, S, E);
    }
    SEAM(pb);
    if (IN(pb + 1)) {
        { const int job = F.vcu; if (job < 128) { if (SCAN_SEL != 2 && !(PADF & 2)) gdn_unit2(F, A_, LAYER, job); } else if (job < 256) { if (SCAN_SEL != 1 && !(PADF & 1)) rwkv_pair2(F, A_, LAYER, job - 128); } }
        if (F.vcu < 128 && !PADF) {
            __syncthreads();
            LAS float* scr = (LAS float*)(F.lds + F.wave * 16384);
            const int cw = F.vcu * NWAVES + F.wave, NCW = 128 * NWAVES;
            if constexpr (LAYER == 0) {
                for (int it = cw; it < MIXER_ITEMS + FFN_ITEMS / 3; it += NCW) {
                    if (it < MIXER_ITEMS) conv_mixer_item(F, A_, 1, F.ws + WS_W1, it, scr);
                    else conv_ffn_item(F, A_.in[22], A_.in[23], A_.in[24], (bf16*)(F.ws + WS_WS + FW_GU), (bf16*)(F.ws + WS_WS + FW_DN), it - MIXER_ITEMS + 2 * (FFN_ITEMS / 3), scr); }
                for (int it = cw; it < 2 * (FFN_ITEMS8 / 3); it += NCW)
                    conv_ffn_item_f8(F, A_.in[22], A_.in[23], A_.in[24], F.ws + WS_WS + FW_GU, nullptr, it);
                for (int it = cw; it < NE_EARLY * FFN_ITEMS8; it += NCW) { const int e = it / FFN_ITEMS8, r = it % FFN_ITEMS8;
                    conv_ffn_item_f8(F, A_.in[26] + (size_t)e * D * FF, A_.in[27] + (size_t)e * D * FF, A_.in[28] + (size_t)e * FF * D,
                                     F.ws + WS_WS + EW_GU + (size_t)e * NGU * D, F.ws + WS_WS + EW_DN + (size_t)e * D * FF, r); }
            } else {
                for (int it = cw + NE_EARLY * FFN_ITEMS8; it < NE * FFN_ITEMS8; it += NCW) { const int e = it / FFN_ITEMS8, r = it % FFN_ITEMS8;
                    conv_ffn_item_f8(F, A_.in[26] + (size_t)e * D * FF, A_.in[27] + (size_t)e * D * FF, A_.in[28] + (size_t)e * FF * D,
                                     F.ws + WS_WS + EW_GU + (size_t)e * NGU * D, F.ws + WS_WS + EW_DN + (size_t)e * D * FF, r); }
            }
        }
    }
    SEAM(pb + 1);
    if (IN(pb + 2)) {
        pg8::StaticOrder S; S.init(M / 256, D / 256, F.G, (int)blockIdx.x);
        { pg8::Gemm g{XN, (const bf16*)(wmix + MW_PA), D, 512, 512, nullptr}; pg8::EpiMerge<true> E{PROJ, PROJ + C_GA, NPROJ};
          pg8::gemm_phase<pg8::EpiMerge<true>, pg8::StaticOrder, true, true, false>(F.lds, g, S, E); }
        { pg8::Gemm g{XN + 512, (const bf16*)(wmix + MW_PB), D, 512, 512, nullptr}; pg8::EpiMerge<false> E{PROJ, PROJ + C_GB, NPROJ};
          pg8::gemm_phase<pg8::EpiMerge<false>, pg8::StaticOrder, true, true, false>(F.lds, g, S, E); }
    }
    SEAM(pb + 2);
    if (IN(pb + 3)) {
        pg8::Gemm g{PROJ, (const bf16*)(wmix + MW_OUT), NPROJ, D, D, nullptr}; pg8::StaticOrder S; S.init(M / 256, D / 256, F.G, (int)blockIdx.x);
        pg8::EpiResid E{xres, F.out, D};
        pg8::gemm_phase<pg8::EpiResid, pg8::StaticOrder, true, true, false>(F.lds, g, S, E);
    }
    SEAM(pb + 3);
    if constexpr (LAYER == 0) {
        if (IN(5)) norm_phase<1>(F, F.out, A_.in[21], nullptr, 0);
        SEAM(5);
        if (IN(6)) {
            pg8::Gemm g{XN, (const bf16*)(F.ws + WS_WS + FW_GU), D, D, D, nullptr}; pg8::StaticOrder S; S.init(M / 256, NGU / 256, F.G, (int)blockIdx.x);
            pg8::EpiSwigluI8<false> E{(unsigned char*)PROJ, FF, (const float*)(F.ws + WS_RS), I8_WS, 1.0f};
            pg8::gemm_phase<pg8::EpiSwigluI8<false>, pg8::StaticOrder, true, true, false, 2>(F.lds, g, S, E);
        }
        SEAM(6);
        if (IN(7)) {
            pg8::Gemm g{PROJ, (const bf16*)(F.ws + WS_WS + FW_DN), FF, FF, FF, nullptr}; pg8::StaticOrder S; S.init(M / 256, D / 256, F.G, (int)blockIdx.x);
            pg8::EpiResid E{F.out, F.out, D};
            pg8::gemm_phase<pg8::EpiResid, pg8::StaticOrder, true, true, false>(F.lds, g, S, E);
        }
        SEAM(7);
        if (IN(8)) norm_phase<0>(F, F.out, A_.in[1] + D, A_.in[2] + (size_t)D * INC + SRC_AB, INC);
        SEAM(8);
    } else {
        if (IN(13)) {
            norm_phase<2>(F, F.out, A_.in[21] + D, A_.in[25], 8);
        }
        SEAM(13);
        if (IN(14)) route_scatter(F);
        SEAM(14);
        const int* grp = (const int*)(F.ws + WS_GRP);
        if (IN(15)) {
            const int np = grp[16] / 256;
            pg8::Gemm g{XN, (const bf16*)(F.ws + WS_WS + EW_GU), D, D, D, (const int*)(F.ws + WS_LIST)}; pg8::MoeOrder S; S.init(grp, 0, np, NGU / 256, F.G, (int)blockIdx.x);
            pg8::EpiSwigluI8<true> E{(unsigned char*)PROJ, FF, (const float*)(F.ws + WS_RSL), I8_WS, F8_SH};
            pg8::gemm_phase<pg8::EpiSwigluI8<true>, pg8::MoeOrder, true, true, true, 2>(F.lds, g, S, E);
        }
        SEAM(15);
        if (IN(16)) {
            const int np = grp[16] / 256;
            pg8::Gemm g{PROJ, (const bf16*)(F.ws + WS_WS + EW_DN), FF, FF, FF, nullptr}; pg8::MoeOrder S; S.init(grp, 0, np, D / 256, F.G, (int)blockIdx.x);
            pg8::EpiMoeDown E{F.out, (const int*)(F.ws + WS_LIST), (const float*)(F.ws + WS_GATEL), XN, grp[8], 1.0f / (F8_SH * F8_SW)};
            pg8::gemm_phase<pg8::EpiMoeDown, pg8::MoeOrder, true, true, false, 1>(F.lds, g, S, E);
        }
        SEAM(16);
        if (IN(18)) norm_phase<3>(F, F.out, A_.in[29], nullptr, 0);
    }
}

__global__ void __launch_bounds__(NWAVES * 64, 2) trunk_fwd(Args A_) {
    extern __shared__ __attribute__((aligned(16))) unsigned char lds[];
    Frame F;
    F.lds = (LAS unsigned char*)lds;
    F.tid = threadIdx.x; F.lane = F.tid & 63; F.wave = __builtin_amdgcn_readfirstlane(F.tid >> 6);
    F.G = gridDim.x; { const int bx = blockIdx.x; F.vcu = (F.G % 8 == 0) ? (bx % 8) * (F.G / 8) + bx / 8 : bx; }
    F.out = A_.out; F.ws = A_.ws;
    unsigned* ctl = (unsigned*)(F.ws + WS_CTL);
    for (int u = F.tid; u < (LDS_BYTES - LDSCTL_OFF) / 4; u += NWAVES * 64) ((LAS unsigned*)(F.lds + LDSCTL_OFF))[u] = 0u;
    __syncthreads();
    XcdBarrier bar; bar.bar = ctl + CW_BAR + A_.li * XCD_BAR_WORDS; bar.x = 0; bar.st = nullptr;
    if (!MK_PER_PHASE) bar = xcd_barrier_post(ctl + CW_BAR + A_.li * XCD_BAR_WORDS, (volatile LAS unsigned*)(F.lds + MISC_OFF) + 8);
    const int lo = A_.ph_lo, hi = A_.ph_hi;
    if (IN(0)) {
        const int gw = F.vcu * NWAVES + F.wave, NGW = F.G * NWAVES;
        LAS float* scr = (LAS float*)(F.lds + F.wave * 16384);
        for (int it = gw; it < MIXER_ITEMS; it += NGW) conv_mixer_item(F, A_, 0, F.ws + WS_WS, it, scr);
        __syncthreads();
        norm_phase<0>(F, A_.in[0], A_.in[1], A_.in[2] + SRC_AB, INC);
    }
    SEAM(0);
    layer_phases<0>(F, A_, bar, lo, hi);
    layer_phases<1>(F, A_, bar, lo, hi);
#undef IN
#undef SEAM
}

extern "C" void kernel_launch(void* const* d_in, const int* in_sizes, int n_in, void* d_out, int out_size, void* d_ws, size_t ws_size, hipStream_t stream) {
    static int grid = 0;
    if (grid == 0) {
        if (n_in != 30 || in_sizes[0] != M * D || out_size != M * D || ws_size < WS_END) { fprintf(stderr, "kernel_launch: unexpected shapes / workspace (n_in %d, ws %zu, need %zu)\n", n_in, ws_size, (size_t)WS_END); grid = -1; return; }
        int dev = 0, cus = 0, per_cu = 0;
        if (hipGetDevice(&dev) != hipSuccess || hipDeviceGetAttribute(&cus, hipDeviceAttributeMultiprocessorCount, dev) != hipSuccess) { grid = -1; return; }
        if (hipFuncSetAttribute((const void*)trunk_fwd, hipFuncAttributeMaxDynamicSharedMemorySize, LDS_BYTES) != hipSuccess) { grid = -1; return; }
        if (hipOccupancyMaxActiveBlocksPerMultiprocessor(&per_cu, (const void*)trunk_fwd, NWAVES * 64, LDS_BYTES) != hipSuccess || per_cu < 1) { fprintf(stderr, "kernel_launch: occupancy query says %d\n", per_cu); }
        (void)hipGetLastError();
        grid = cus;
    }
    if (grid < 0) return;
    if (hipMemsetAsync((char*)d_ws + WS_CTL, 0, CTL_ZERO_BYTES, stream) != hipSuccess) return;
    Args a{};
    for (int i = 0; i < 30; ++i) a.in[i] = (const float*)d_in[i];
    a.out = (float*)d_out; a.ws = (unsigned char*)d_ws;
#if MK_PER_PHASE
    for (int p = 0; p < NPHASE; ++p) { a.ph_lo = p; a.ph_hi = p + 1; a.li = 0; hipLaunchKernelGGL(trunk_fwd, dim3(grid), dim3(NWAVES * 64), LDS_BYTES, stream, a); }
#elif PROBE_DUP >= 0
    a.ph_lo = 0; a.ph_hi = PROBE_DUP; a.li = 0; a.pad = 0; hipLaunchKernelGGL(trunk_fwd, dim3(grid), dim3(NWAVES * 64), LDS_BYTES, stream, a);
    a.ph_lo = PROBE_DUP; a.ph_hi = PROBE_DUP + 1; a.li = 1; a.pad = PROBE_SCAN; hipLaunchKernelGGL(trunk_fwd, dim3(grid), dim3(NWAVES * 64), LDS_BYTES, stream, a);
    a.ph_lo = PROBE_DUP; a.ph_hi = NPHASE; a.li = 2; a.pad = 0; hipLaunchKernelGGL(trunk_fwd, dim3(grid), dim3(NWAVES * 64), LDS_BYTES, stream, a);
#else
    a.ph_lo = 0; a.ph_hi = NPHASE; a.li = 0;
    hipLaunchKernelGGL(trunk_fwd, dim3(grid), dim3(NWAVES * 64), LDS_BYTES, stream, a);
#endif
}
```

```cpp
#include <hip/hip_runtime.h>
#include <cstdio>
#include <cstdint>
#pragma clang fp reassociate(on) contract(fast)

#ifndef MK_PER_PHASE
#define MK_PER_PHASE 0
#endif
#define PROBE_DUP -1
#define PADF (PROBE_DUP >= 0 ? A_.pad : 0)

#define GAS __attribute__((address_space(1)))
#define LAS __attribute__((address_space(3)))
typedef unsigned short bf16;
typedef unsigned v4u __attribute__((ext_vector_type(4)));
typedef unsigned v2u __attribute__((ext_vector_type(2)));
typedef float f32x4 __attribute__((ext_vector_type(4)));
typedef float f32x2 __attribute__((ext_vector_type(2)));
typedef short bf16x8 __attribute__((ext_vector_type(8)));
typedef GAS unsigned gu32;

constexpr int NWAVES = 8;
constexpr int BATCH = 32, T = 2048, D = 1024, M = BATCH * T;
constexpr int INC = 5896, NPROJ = 5888;
constexpr int C_R = 0, C_K = 512, C_V = 1024, C_WL = 1536, C_GQ = 1792, C_GK = 2304, C_GV = 2816, C_Z = 3328, C_GA = 3840, C_GB = 4864;
constexpr int SRC_AB = 3328;
constexpr int FF = 2816, NGU = 2 * FF, NE = 8;
constexpr int LISTCAP = 2 * M + 16 * 256;

constexpr size_t MiB = 1u << 20;
constexpr size_t WS_CTL = 0, CTL_ZERO_BYTES = 1 * MiB;
constexpr size_t WS_AB = 1 * MiB;
constexpr size_t WS_RE = 3 * MiB;
constexpr size_t WS_RG = WS_RE + (size_t)M * 4;
constexpr size_t WS_WGCNT = WS_RG + (size_t)M * 4;
constexpr size_t WS_GRP = WS_WGCNT + 256 * 16 * 4;
constexpr size_t WS_RS = 3 * MiB + 768 * 1024;
constexpr size_t WS_LIST = 4 * MiB;
constexpr size_t WS_GATEL = 5 * MiB;
constexpr size_t WS_RSL = 6 * MiB;
constexpr size_t WS_W1 = 8 * MiB;
constexpr size_t WS_WS = 24 * MiB;
constexpr size_t WS_XN = 156 * MiB;
constexpr size_t WS_PROJ = 284 * MiB;
constexpr size_t WS_END = WS_PROJ + (size_t)M * NPROJ * 2;
constexpr size_t WS_TMP0 = WS_PROJ + 400 * MiB;
static_assert(WS_END == 1020 * MiB, "ws map");
static_assert((size_t)LISTCAP * NGU <= (size_t)M * NPROJ * 2, "moe hidden fits in the PROJ region");
constexpr size_t MW_IN = 0, MW_PA = MW_IN + (size_t)NPROJ * D * 2, MW_PB = MW_PA + (size_t)D * 512 * 2, MW_OUT = MW_PB + (size_t)D * 512 * 2, MW_END = MW_OUT + (size_t)D * D * 2;
constexpr size_t FW_GU = MW_END, FW_DN = FW_GU + (size_t)NGU * D * 2, FW_END = FW_DN + (size_t)D * FF * 2;
constexpr size_t EW_GU = 56 * MiB, EW_DN = EW_GU + (size_t)NE * NGU * D;
static_assert(WS_W1 + MW_END <= WS_WS && FW_END <= EW_GU && WS_WS + EW_DN + (size_t)NE * D * FF <= WS_XN, "weight map");
constexpr int NE_EARLY = 3;
constexpr int CW_BAR = 4096;

constexpr int RING_BYTES = 131072;
constexpr int LDSCTL_OFF = RING_BYTES, MISC_OFF = LDSCTL_OFF + 320;
constexpr int LDS_BYTES = 147456;

#define RLX_AGENT __ATOMIC_RELAXED, __HIP_MEMORY_SCOPE_AGENT
#define LDS_WAIT() asm volatile("s_waitcnt lgkmcnt(0)" ::: "memory")
#define VM_WAIT() asm volatile("s_waitcnt vmcnt(0)" ::: "memory")
__device__ __forceinline__ unsigned f2bf(float f) { return (unsigned)__builtin_bit_cast(unsigned short, (__bf16)f); }
typedef __bf16 bf16v2_t __attribute__((ext_vector_type(2)));
__device__ __forceinline__ unsigned pk2(float lo, float hi) { const f32x2 v = {lo, hi}; return __builtin_bit_cast(unsigned, __builtin_convertvector(v, bf16v2_t)); }
__device__ __forceinline__ float bf_lo(unsigned w) { return __builtin_bit_cast(float, w << 16); }
__device__ __forceinline__ float bf_hi(unsigned w) { return __builtin_bit_cast(float, w & 0xffff0000u); }
__device__ __forceinline__ float bf2f(bf16 v) { return __builtin_bit_cast(float, (unsigned)v << 16); }
__device__ __forceinline__ float sigmoidf_(float x) { return __builtin_amdgcn_rcpf(1.0f + __expf(-x)); }
__device__ __forceinline__ float softplusf_(float x) { return x > 20.f ? x : log1pf(__expf(x)); }
__device__ __forceinline__ unsigned f8x4(float a, float b, float c, float d) {
    a = __builtin_amdgcn_fmed3f(a, -448.f, 448.f); b = __builtin_amdgcn_fmed3f(b, -448.f, 448.f); c = __builtin_amdgcn_fmed3f(c, -448.f, 448.f); d = __builtin_amdgcn_fmed3f(d, -448.f, 448.f);
    int w = __builtin_amdgcn_cvt_pk_fp8_f32(a, b, 0, false); w = __builtin_amdgcn_cvt_pk_fp8_f32(c, d, w, true); return (unsigned)w; }
constexpr float F8_SX = 8.f, F8_SW = 256.f, F8_SH = 8.f;
constexpr float I8_WMAX = 4.0f * 0.03125f, I8_WS = I8_WMAX / 127.f, I8_WINV = 127.f / I8_WMAX;
__device__ __forceinline__ unsigned q8x4(float a, float b, float c, float d) {
    const float mg = 12582912.f;
    const unsigned ua = __builtin_bit_cast(unsigned, __builtin_amdgcn_fmed3f(a, -127.f, 127.f) + mg), ub = __builtin_bit_cast(unsigned, __builtin_amdgcn_fmed3f(b, -127.f, 127.f) + mg);
    const unsigned uc = __builtin_bit_cast(unsigned, __builtin_amdgcn_fmed3f(c, -127.f, 127.f) + mg), ud = __builtin_bit_cast(unsigned, __builtin_amdgcn_fmed3f(d, -127.f, 127.f) + mg);
    return (ua & 0xffu) | ((ub & 0xffu) << 8) | ((uc & 0xffu) << 16) | (ud << 24);
}

namespace pg8 {
constexpr int BM = 256, BK = 64, HALF = 128, HTB = HALF * BK * 2, STAGE_BYTES = 8 * HTB, NXCD = 8, WGM = 4;
__host__ __device__ __forceinline__ int lds_byte(int r, int c) { const int st = (r >> 4) * 2 + (c >> 5), rr = r & 15, cc = c & 31, ob = rr * 64 + cc * 2; return st * 1024 + (ob ^ (((ob >> 9) & 1) << 5)); }
__host__ __device__ __forceinline__ void stage_rc(int b, int& R, int& C) { const int st = b / 1024, sb = b % 1024, swz = sb ^ (((sb >> 9) & 1) << 5); R = (st >> 1) * 16 + swz / 64; C = (st & 1) * 32 + (swz % 64) / 2; }
__host__ __device__ __forceinline__ int perm32(int rho) { const int n = rho >> 4, i = rho & 15; return 8 * (i >> 2) + 4 * n + (i & 3); }

struct Unit { int pm, pn, pb; };
struct Gemm { const bf16* A; const bf16* Bt; int lda, ldb, K; const int* rows; };

struct StaticOrder {
    int nM, nN, nwg, G, c;
    __device__ void init(int nM_, int nN_, int G_, int c_) { nM = nM_; nN = nN_; nwg = nM * nN; G = G_; c = c_; }
    __device__ bool next(int i, Unit& u) const {
        const long L = (long)i * G + c; if (L >= nwg) return false;
        int wgid = (int)L; { const int q = nwg / NXCD, r = nwg % NXCD, xcd = wgid % NXCD, off = wgid / NXCD; wgid = (xcd < r ? xcd * (q + 1) : r * (q + 1) + (xcd - r) * q) + off; }
        const int nig = WGM * nN, gid = wgid / nig, fm = gid * WGM, gsz = (nM - fm) < WGM ? (nM - fm) : WGM;
        u.pm = fm + ((wgid % nig) % gsz); u.pn = (wgid % nig) / gsz; u.pb = u.pn; return true;
    }
};
struct MoeOrder {
    int nM, nN, nwg, G, c, p0; int gb[16];
    __device__ void init(const int* grp, int p0_, int nM_, int nN_, int G_, int c_) { p0 = p0_; nM = nM_; nN = nN_; nwg = nM * nN; G = G_; c = c_;
#pragma unroll
        for (int k = 0; k < 16; ++k) gb[k] = grp[k]; }
    __device__ bool next(int i, Unit& u) const {
        const long L = (long)i * G + c; if (L >= nwg) return false;
        int wgid = (int)L; { const int q = nwg / NXCD, r = nwg % NXCD, xcd = wgid % NXCD, off = wgid / NXCD; wgid = (xcd < r ? xcd * (q + 1) : r * (q + 1) + (xcd - r) * q) + off; }
        const int nig = WGM * nN, gid = wgid / nig, fm = gid * WGM, gsz = (nM - fm) < WGM ? (nM - fm) : WGM;
        u.pm = p0 + fm + ((wgid % nig) % gsz); u.pn = (wgid % nig) / gsz;
        const int rowpos = u.pm * BM; int g = 0;
#pragma unroll
        for (int k = 1; k < 16; ++k) g += (rowpos >= gb[k]) ? 1 : 0;
        u.pb = (g & 7) * nN + u.pn; return true;
    }
};

__device__ __forceinline__ unsigned cvt_pk_bf16(float lo, float hi) { unsigned r; asm volatile("v_cvt_pk_bf16_f32 %0, %1, %2" : "=v"(r) : "v"(lo), "v"(hi)); return r; }

struct EpiBf16Plain {
    static constexpr bool PERM = true;
    bf16* O; int ldc;
    __device__ __forceinline__ void operator()(const f32x4 (&acc)[2][2][4][2], const Unit& u, int wr, int wc, int fr, int fq) const {
        const int row0 = u.pm * BM + wr * 64 + fr, col0 = u.pn * BM + wc * 32 + 8 * fq;
#pragma unroll
        for (int ai = 0; ai < 2; ++ai)
#pragma unroll
            for (int m = 0; m < 4; ++m) { bf16* rowp = O + (size_t)(row0 + ai * HALF + m * 16) * ldc + col0;
#pragma unroll
                for (int bj = 0; bj < 2; ++bj) { const f32x4 v0 = acc[ai][bj][m][0], v1 = acc[ai][bj][m][1];
                    v4u w; w.x = cvt_pk_bf16(v0[0], v0[1]); w.y = cvt_pk_bf16(v0[2], v0[3]); w.z = cvt_pk_bf16(v1[0], v1[1]); w.w = cvt_pk_bf16(v1[2], v1[3]);
                    *(v4u*)(rowp + bj * HALF) = w; } }
    }
};
struct EpiBf16PlainS {
    static constexpr bool PERM = true;
    bf16* O; int ldc; const float* rs; float sw;
    __device__ __forceinline__ void operator()(const f32x4 (&acc)[2][2][4][2], const Unit& u, int wr, int wc, int fr, int fq) const {
        const int row0 = u.pm * BM + wr * 64 + fr, col0 = u.pn * BM + wc * 32 + 8 * fq;
        float c0[2][4];
#pragma unroll
        for (int ai = 0; ai < 2; ++ai)
#pragma unroll
            for (int m = 0; m < 4; ++m) c0[ai][m] = rs[row0 + ai * HALF + m * 16] * sw;
#pragma unroll
        for (int ai = 0; ai < 2; ++ai)
#pragma unroll
            for (int m = 0; m < 4; ++m) { bf16* rowp = O + (size_t)(row0 + ai * HALF + m * 16) * ldc + col0; const float cc = c0[ai][m];
#pragma unroll
                for (int bj = 0; bj < 2; ++bj) { const f32x4 v0 = acc[ai][bj][m][0] * cc, v1 = acc[ai][bj][m][1] * cc;
                    v4u w; w.x = cvt_pk_bf16(v0[0], v0[1]); w.y = cvt_pk_bf16(v0[2], v0[3]); w.z = cvt_pk_bf16(v1[0], v1[1]); w.w = cvt_pk_bf16(v1[2], v1[3]);
                    *(v4u*)(rowp + bj * HALF) = w; } }
    }
};
template <bool FIRST> struct EpiMerge {
    static constexpr bool PERM = true;
    bf16* Y; const bf16* Gt; int ldc;
    __device__ __forceinline__ void operator()(const f32x4 (&acc)[2][2][4][2], const Unit& u, int wr, int wc, int fr, int fq) const {
        const int row0 = u.pm * BM + wr * 64 + fr, col0 = u.pn * BM + wc * 32 + 8 * fq;
#pragma unroll
        for (int ai = 0; ai < 2; ++ai)
#pragma unroll
            for (int mp = 0; mp < 2; ++mp) {
                v4u gw[2][2], yw[2][2];
#pragma unroll
                for (int mm = 0; mm < 2; ++mm)
#pragma unroll
                    for (int bj = 0; bj < 2; ++bj) { const size_t ro = (size_t)(row0 + ai * HALF + (2 * mp + mm) * 16) * ldc + col0 + bj * HALF;
                        gw[mm][bj] = *(const v4u*)(Gt + ro); if (!FIRST) yw[mm][bj] = *(const v4u*)(Y + ro); }
#pragma unroll
                for (int mm = 0; mm < 2; ++mm)
#pragma unroll
                    for (int bj = 0; bj < 2; ++bj) { const int m = 2 * mp + mm; const size_t ro = (size_t)(row0 + ai * HALF + m * 16) * ldc + col0 + bj * HALF;
                        const f32x4 v0 = acc[ai][bj][m][0], v1 = acc[ai][bj][m][1]; const v4u g4 = gw[mm][bj];
                        auto mg2 = [](unsigned gw2, float a0, float a1) { const f32x2 t = (f32x2){bf_lo(gw2), bf_hi(gw2)} * (f32x2){-1.44269504089f, -1.44269504089f};
                            f32x2 e; e[0] = __builtin_amdgcn_exp2f(t[0]); e[1] = __builtin_amdgcn_exp2f(t[1]); const f32x2 d = e + (f32x2){1.0f, 1.0f};
                            f32x2 r; r[0] = __builtin_amdgcn_rcpf(d[0]); r[1] = __builtin_amdgcn_rcpf(d[1]); return r * (f32x2){a0, a1}; };
                        f32x2 o[4];
                        o[0] = mg2(g4.x, v0[0], v0[1]); o[1] = mg2(g4.y, v0[2], v0[3]); o[2] = mg2(g4.z, v1[0], v1[1]); o[3] = mg2(g4.w, v1[2], v1[3]);
                        if (!FIRST) { const v4u y4 = yw[mm][bj];
                            o[0] += (f32x2){bf_lo(y4.x), bf_hi(y4.x)}; o[1] += (f32x2){bf_lo(y4.y), bf_hi(y4.y)}; o[2] += (f32x2){bf_lo(y4.z), bf_hi(y4.z)}; o[3] += (f32x2){bf_lo(y4.w), bf_hi(y4.w)}; }
                        v4u w; w.x = cvt_pk_bf16(o[0][0], o[0][1]); w.y = cvt_pk_bf16(o[1][0], o[1][1]); w.z = cvt_pk_bf16(o[2][0], o[2][1]); w.w = cvt_pk_bf16(o[3][0], o[3][1]);
                        *(v4u*)(Y + ro) = w; }
            }
    }
};
struct EpiResid {
    static constexpr bool PERM = false;
    const float* base; float* out; int ldc;
    __device__ __forceinline__ void operator()(const f32x4 (&acc)[2][2][4][2], const Unit& u, int wr, int wc, int fr, int fq) const {
        const int row0 = u.pm * BM + wr * 64 + fr, col0 = u.pn * BM + wc * 32 + 4 * fq;
        f32x4 bs[2][2][2][2];
#define ER_LOAD(q, slot) do { _Pragma("unroll") for (int mm = 0; mm < 2; ++mm) _Pragma("unroll") for (int bj = 0; bj < 2; ++bj) _Pragma("unroll") for (int n = 0; n < 2; ++n) \
            bs[slot][mm][bj][n] = *(const f32x4*)(base + (size_t)(row0 + ((q) >> 1) * HALF + (2 * ((q) & 1) + mm) * 16) * ldc + col0 + bj * HALF + n * 16); } while (0)
#define ER_STORE(q, slot) do { _Pragma("unroll") for (int mm = 0; mm < 2; ++mm) _Pragma("unroll") for (int bj = 0; bj < 2; ++bj) _Pragma("unroll") for (int n = 0; n < 2; ++n) \
            *(f32x4*)(out + (size_t)(row0 + ((q) >> 1) * HALF + (2 * ((q) & 1) + mm) * 16) * ldc + col0 + bj * HALF + n * 16) = bs[slot][mm][bj][n] + acc[(q) >> 1][bj][2 * ((q) & 1) + mm][n]; } while (0)
        ER_LOAD(0, 0); ER_LOAD(1, 1); ER_STORE(0, 0); ER_LOAD(2, 0); ER_STORE(1, 1); ER_LOAD(3, 1); ER_STORE(2, 0); ER_STORE(3, 1);
#undef ER_LOAD
#undef ER_STORE
    }
};
struct EpiResidS {
    static constexpr bool PERM = false;
    const float* base; float* out; int ldc; float sc;
    __device__ __forceinline__ void operator()(const f32x4 (&acc)[2][2][4][2], const Unit& u, int wr, int wc, int fr, int fq) const {
        const int row0 = u.pm * BM + wr * 64 + fr, col0 = u.pn * BM + wc * 32 + 4 * fq;
        f32x4 bs[2][2][2][2];
#define ER_LOAD(q, slot) do { _Pragma("unroll") for (int mm = 0; mm < 2; ++mm) _Pragma("unroll") for (int bj = 0; bj < 2; ++bj) _Pragma("unroll") for (int n = 0; n < 2; ++n) \
            bs[slot][mm][bj][n] = *(const f32x4*)(base + (size_t)(row0 + ((q) >> 1) * HALF + (2 * ((q) & 1) + mm) * 16) * ldc + col0 + bj * HALF + n * 16); } while (0)
#define ER_STORE(q, slot) do { _Pragma("unroll") for (int mm = 0; mm < 2; ++mm) _Pragma("unroll") for (int bj = 0; bj < 2; ++bj) _Pragma("unroll") for (int n = 0; n < 2; ++n) \
            *(f32x4*)(out + (size_t)(row0 + ((q) >> 1) * HALF + (2 * ((q) & 1) + mm) * 16) * ldc + col0 + bj * HALF + n * 16) = bs[slot][mm][bj][n] + acc[(q) >> 1][bj][2 * ((q) & 1) + mm][n] * sc; } while (0)
        ER_LOAD(0, 0); ER_LOAD(1, 1); ER_STORE(0, 0); ER_LOAD(2, 0); ER_STORE(1, 1); ER_LOAD(3, 1); ER_STORE(2, 0); ER_STORE(3, 1);
#undef ER_LOAD
#undef ER_STORE
    }
};
__device__ __forceinline__ f32x2 silu_mul2(const f32x2 g, const f32x2 up, float c1, float lc, float kinv) {
    const f32x2 a = g * (f32x2){c1, c1} + (f32x2){lc, lc};
    f32x2 e; e[0] = __builtin_amdgcn_exp2f(a[0]); e[1] = __builtin_amdgcn_exp2f(a[1]);
    const f32x2 d = e + (f32x2){kinv, kinv};
    f32x2 r; r[0] = __builtin_amdgcn_rcpf(d[0]); r[1] = __builtin_amdgcn_rcpf(d[1]);
    return (g * up) * r;
}
struct EpiSwiglu {
    static constexpr bool PERM = true;
    bf16* H; int ldc;
    __device__ __forceinline__ void operator()(const f32x4 (&acc)[2][2][4][2], const Unit& u, int wr, int wc, int fr, int fq) const {
        const int row0 = u.pm * BM + wr * 64 + fr, col0 = u.pn * HALF + wc * 32 + 8 * fq;
#pragma unroll
        for (int ai = 0; ai < 2; ++ai)
#pragma unroll
            for (int m = 0; m < 4; ++m) { bf16* rowp = H + (size_t)(row0 + ai * HALF + m * 16) * ldc + col0;
                f32x2 o[4];
#pragma unroll
                for (int n = 0; n < 2; ++n)
#pragma unroll
                    for (int jp = 0; jp < 2; ++jp) { const f32x4 g4 = acc[ai][0][m][n], u4 = acc[ai][1][m][n];
                        o[n * 2 + jp] = silu_mul2((f32x2){g4[2 * jp], g4[2 * jp + 1]}, (f32x2){u4[2 * jp], u4[2 * jp + 1]}, -1.44269504089f, 0.f, 1.0f); }
                v4u w; w.x = cvt_pk_bf16(o[0][0], o[0][1]); w.y = cvt_pk_bf16(o[1][0], o[1][1]); w.z = cvt_pk_bf16(o[2][0], o[2][1]); w.w = cvt_pk_bf16(o[3][0], o[3][1]);
                *(v4u*)rowp = w; }
    }
};
struct EpiSwigluF8 {
    static constexpr bool PERM = true;
    unsigned char* H; int ldc; float insc, osc;
    __device__ __forceinline__ void operator()(const f32x4 (&acc)[2][2][4][2], const Unit& u, int wr, int wc, int fr, int fq) const {
        const int row0 = u.pm * BM + wr * 64 + fr, col0 = u.pn * HALF + wc * 32 + 8 * fq;
#pragma unroll
        for (int ai = 0; ai < 2; ++ai)
#pragma unroll
            for (int m = 0; m < 4; ++m) { unsigned char* rowp = H + (size_t)(row0 + ai * HALF + m * 16) * ldc + col0;
                const float c2 = insc * insc * osc, c1 = -1.44269504089f * insc, lc = -__builtin_log2f(c2), kinv = 1.0f / c2;
                f32x2 o[4];
#pragma unroll
                for (int n = 0; n < 2; ++n)
#pragma unroll
                    for (int jp = 0; jp < 2; ++jp) { const f32x4 g4 = acc[ai][0][m][n], u4 = acc[ai][1][m][n];
                        o[n * 2 + jp] = silu_mul2((f32x2){g4[2 * jp], g4[2 * jp + 1]}, (f32x2){u4[2 * jp], u4[2 * jp + 1]}, c1, lc, kinv); }
                v2u w; w.x = f8x4(o[0][0], o[0][1], o[1][0], o[1][1]); w.y = f8x4(o[2][0], o[2][1], o[3][0], o[3][1]);
                *(v2u*)rowp = w; }
    }
};
template <bool OUTF8> struct EpiSwigluI8 {
    static constexpr bool PERM = true;
    unsigned char* H; int ldc; const float* rs; float sw, osc;
    __device__ __forceinline__ void operator()(const f32x4 (&acc)[2][2][4][2], const Unit& u, int wr, int wc, int fr, int fq) const {
        const int row0 = u.pm * BM + wr * 64 + fr, col0 = u.pn * HALF + wc * 32 + 8 * fq;
        float c0[2][4];
#pragma unroll
        for (int ai = 0; ai < 2; ++ai)
#pragma unroll
            for (int m = 0; m < 4; ++m) c0[ai][m] = rs[row0 + ai * HALF + m * 16] * sw;
#pragma unroll
        for (int ai = 0; ai < 2; ++ai)
#pragma unroll
            for (int m = 0; m < 4; ++m) { unsigned char* rowp = H + ((size_t)(row0 + ai * HALF + m * 16) * ldc + col0) * (OUTF8 ? 1 : 2);
                const float cc = c0[ai][m], c2 = cc * cc * osc, c1 = -1.44269504089f * cc, lc = -__builtin_amdgcn_logf(c2), kinv = __builtin_amdgcn_rcpf(c2);
                f32x2 o[4];
#pragma unroll
                for (int n = 0; n < 2; ++n)
#pragma unroll
                    for (int jp = 0; jp < 2; ++jp) { const f32x4 g4 = acc[ai][0][m][n], u4 = acc[ai][1][m][n];
                        o[n * 2 + jp] = silu_mul2((f32x2){g4[2 * jp], g4[2 * jp + 1]}, (f32x2){u4[2 * jp], u4[2 * jp + 1]}, c1, lc, kinv); }
                if constexpr (OUTF8) { v2u w; w.x = f8x4(o[0][0], o[0][1], o[1][0], o[1][1]); w.y = f8x4(o[2][0], o[2][1], o[3][0], o[3][1]); *(v2u*)rowp = w; }
                else { v4u w; w.x = cvt_pk_bf16(o[0][0], o[0][1]); w.y = cvt_pk_bf16(o[1][0], o[1][1]); w.z = cvt_pk_bf16(o[2][0], o[2][1]); w.w = cvt_pk_bf16(o[3][0], o[3][1]); *(v4u*)rowp = w; } }
    }
};
struct EpiMoeDown {
    static constexpr bool PERM = true;
    bf16* tmp0; const int* list; const float* gatel; bf16* tmp1; int split; float sc;
    __device__ __forceinline__ void operator()(const f32x4 (&acc)[2][2][4][2], const Unit& u, int wr, int wc, int fr, int fq) const {
        const int row0 = u.pm * BM + wr * 64 + fr, col0 = u.pn * BM + wc * 32 + 8 * fq;
        bf16* tmp = (u.pm * BM >= split) ? tmp1 : tmp0;
        int tok[2][4]; float gt[2][4];
#pragma unroll
        for (int ai = 0; ai < 2; ++ai)
#pragma unroll
            for (int m = 0; m < 4; ++m) { const int p = row0 + ai * HALF + m * 16; tok[ai][m] = list[p]; gt[ai][m] = gatel[p] * sc; }
#pragma unroll
        for (int ai = 0; ai < 2; ++ai)
#pragma unroll
            for (int m = 0; m < 4; ++m) { const int tk = tok[ai][m]; const float g = gt[ai][m];
                if (tk >= 0) { bf16* rowp = tmp + (size_t)tk * D + col0;
#pragma unroll
                    for (int bj = 0; bj < 2; ++bj) { const f32x4 v0 = acc[ai][bj][m][0] * g, v1 = acc[ai][bj][m][1] * g;
                        v4u w; w.x = cvt_pk_bf16(v0[0], v0[1]); w.y = cvt_pk_bf16(v0[2], v0[3]); w.z = cvt_pk_bf16(v1[0], v1[1]); w.w = cvt_pk_bf16(v1[2], v1[3]);
                        *(v4u*)(rowp + bj * HALF) = w; } } }
    }
};

typedef int v4i_t __attribute__((ext_vector_type(4)));
typedef int v8i_t __attribute__((ext_vector_type(8)));
__device__ __forceinline__ v8i_t cat8(const bf16x8 a, const bf16x8 b) { return __builtin_shufflevector(__builtin_bit_cast(v4i_t, a), __builtin_bit_cast(v4i_t, b), 0, 1, 2, 3, 4, 5, 6, 7); }
template <class Epi, class Sched, bool ALIGN_EPI, bool SP2, bool GATHER, int PREC = 0>
__device__ __forceinline__ void gemm_phase(LAS unsigned char* lds, const Gemm g, const Sched& S, const Epi& E) {
    constexpr bool F8 = PREC == 1, I8 = PREC == 2;
    constexpr unsigned EB = PREC ? 1u : 2u;
    const int tid = threadIdx.x, wid = __builtin_amdgcn_readfirstlane(tid >> 6), lane = tid & 63, wr = wid >> 2, wc = wid & 3, fr = lane & 15, fq = lane >> 4;
    const int K = g.K, nt = K / (PREC ? 2 * BK : BK);
    unsigned voffA[2], voffB[2]; int stR[2], stC[2];
#pragma unroll
    for (int i = 0; i < 2; ++i) { int R, C; stage_rc(tid * 16 + i * 8192, R, C); const int Rb = Epi::PERM ? ((R & ~31) + perm32(R & 31)) : R;
        voffA[i] = (unsigned)(R * g.lda) * EB + (unsigned)C * 2u; voffB[i] = (unsigned)(Rb * g.ldb) * EB + (unsigned)C * 2u; stR[i] = R; stC[i] = C; }
    const size_t kstep = (size_t)(BK * 2);
    const size_t hstepA = (size_t)HALF * g.lda * EB, tstepA = 2 * hstepA, hstepB = (size_t)HALF * g.ldb * EB, tstepB = 2 * hstepB;
    const unsigned ldsw = (unsigned)wid * 1024u;
    const int aoff = lds_byte(wr * 64 + fr, fq * 8), boff = lds_byte(wc * 32 + fr, fq * 8);
    unsigned gAc[2][2], gAn[2][2];
#define PG8_SA(b, h) (((b) * 2 + (h)) * HTB)
#define PG8_SB(b, h) ((4 + (b) * 2 + (h)) * HTB)
#define PG8_GLDS(src, bufoff, i) __builtin_amdgcn_global_load_lds((const unsigned*)(src), (LAS unsigned*)(lds + (bufoff) + ldsw + (i) * 8192), 16, 0, 0)
#define PG8_STAGE_B(bufoff, gbase) do { _Pragma("unroll") for (int _i = 0; _i < 2; ++_i) PG8_GLDS((const char*)(gbase) + voffB[_i], bufoff, _i); } while (0)
#define PG8_STAGE_A(bufoff, h, NX, kb) do { \
        if constexpr (GATHER) { _Pragma("unroll") for (int _i = 0; _i < 2; ++_i) { const unsigned _o = (NX) ? gAn[h][_i] : gAc[h][_i]; PG8_GLDS((const char*)g.A + _o + (kb), bufoff, _i); } } \
        else { const char* _b = ((NX) ? nA : cA) + (h) * hstepA + (kb); _Pragma("unroll") for (int _i = 0; _i < 2; ++_i) PG8_GLDS(_b + voffA[_i], bufoff, _i); } } while (0)
#define PG8_LDA(dst, b, h) do { _Pragma("unroll") for (int m = 0; m < 4; ++m) _Pragma("unroll") for (int k = 0; k < 2; ++k) dst[m][k] = *(const LAS bf16x8*)(lds + PG8_SA(b, h) + aoff + m * 2048 + k * 1024); } while (0)
#define PG8_LDB(dst, b, h) do { _Pragma("unroll") for (int n = 0; n < 2; ++n) _Pragma("unroll") for (int k = 0; k < 2; ++k) dst[n][k] = *(const LAS bf16x8*)(lds + PG8_SB(b, h) + boff + n * 2048 + k * 1024); } while (0)
#define PG8_MMA(ai, bj, At, Bt) do { __builtin_amdgcn_s_setprio(1); _Pragma("unroll") for (int m = 0; m < 4; ++m) _Pragma("unroll") for (int n = 0; n < 2; ++n) { \
        if constexpr (F8) asm("v_mfma_f32_16x16x128_f8f6f4 %0, %1, %2, %0" : "+v"(acc[ai][bj][m][n]) : "v"(cat8(Bt[n][0], Bt[n][1])), "v"(cat8(At[m][0], At[m][1]))); \
        else if constexpr (I8) { _Pragma("unroll") for (int k = 0; k < 2; ++k) acc[ai][bj][m][n] = __builtin_bit_cast(f32x4, __builtin_amdgcn_mfma_i32_16x16x64_i8(__builtin_bit_cast(v4i_t, Bt[n][k]), __builtin_bit_cast(v4i_t, At[m][k]), __builtin_bit_cast(v4i_t, acc[ai][bj][m][n]), 0, 0, 0)); } \
        else { _Pragma("unroll") for (int k = 0; k < 2; ++k) acc[ai][bj][m][n] = __builtin_amdgcn_mfma_f32_16x16x32_bf16(Bt[n][k], At[m][k], acc[ai][bj][m][n], 0, 0, 0); } } __builtin_amdgcn_s_setprio(0); } while (0)
#define PG8_WAIT_V(n) asm volatile("s_waitcnt vmcnt(" #n ")" ::: "memory")
#define PG8_WAIT_L(n) asm volatile("s_waitcnt lgkmcnt(" #n ")" ::: "memory")
#define PG8_BAR __builtin_amdgcn_s_barrier()
#define PG8_SCHED __builtin_amdgcn_sched_barrier(0)
#define PG8_GOFF(dst, unit) do { _Pragma("unroll") for (int _h = 0; _h < 2; ++_h) _Pragma("unroll") for (int _i = 0; _i < 2; ++_i) { int _t = g.rows[(unit).pm * BM + _h * HALF + stR[_i]]; _t = _t < 0 ? 0 : _t; \
        dst[_h][_i] = (unsigned)_t * ((unsigned)g.lda * EB) + (unsigned)(stC[_i] * 2); } } while (0)
    Unit cur, nxt; int ui = 0;
    if (!S.next(0, cur)) return;
    f32x4 acc[2][2][4][2];
#pragma unroll
    for (int a = 0; a < 2; ++a)
#pragma unroll
        for (int b = 0; b < 2; ++b)
#pragma unroll
            for (int m = 0; m < 4; ++m)
#pragma unroll
                for (int n = 0; n < 2; ++n) acc[a][b][m][n] = (f32x4){0.f, 0.f, 0.f, 0.f};
    bf16x8 At[4][2], B0[2][2], B1[2][2];
    const char* cA = (const char*)g.A + (size_t)cur.pm * tstepA; const char* cB = (const char*)g.Bt + (size_t)cur.pb * tstepB;
    const char* nA = cA;
    if constexpr (GATHER) { PG8_GOFF(gAc, cur); _Pragma("unroll") for (int _h = 0; _h < 2; ++_h) _Pragma("unroll") for (int _i = 0; _i < 2; ++_i) gAn[_h][_i] = gAc[_h][_i]; }
    if constexpr (SP2) {
        PG8_STAGE_B(PG8_SB(0, 0), cB); PG8_STAGE_B(PG8_SB(0, 1), cB + hstepB); PG8_STAGE_A(PG8_SA(0, 0), 0, false, 0); PG8_STAGE_A(PG8_SA(0, 1), 1, false, 0);
        if (wr == 1) PG8_BAR;
        PG8_WAIT_V(2); PG8_BAR;
        PG8_STAGE_B(PG8_SB(1, 0), cB + kstep); PG8_STAGE_A(PG8_SA(1, 0), 0, false, kstep); PG8_STAGE_B(PG8_SB(1, 1), cB + hstepB + kstep);
        PG8_WAIT_V(6); PG8_BAR;
    } else {
        PG8_STAGE_B(PG8_SB(0, 0), cB); PG8_STAGE_A(PG8_SA(0, 0), 0, false, 0); PG8_STAGE_B(PG8_SB(0, 1), cB + hstepB); PG8_STAGE_A(PG8_SA(0, 1), 1, false, 0);
        if (wr == 1) PG8_BAR;
        PG8_WAIT_V(4); PG8_BAR;
        PG8_STAGE_B(PG8_SB(1, 0), cB + kstep); PG8_STAGE_A(PG8_SA(1, 0), 0, false, kstep); PG8_STAGE_B(PG8_SB(1, 1), cB + hstepB + kstep);
        PG8_WAIT_V(6); PG8_BAR;
    }
    for (;;) {
        const bool has_next = S.next(ui + 1, nxt);
        nA = has_next ? (const char*)g.A + (size_t)nxt.pm * tstepA : cA; const char* nB = has_next ? (const char*)g.Bt + (size_t)nxt.pb * tstepB : cB;
        if constexpr (GATHER) { if (has_next) PG8_GOFF(gAn, nxt); }
        for (int t = 0; t < nt; t += 2) {
            const bool last = (t == nt - 2);
            const size_t k1 = (size_t)(t + 1) * kstep;
            const size_t k2 = last ? 0 : (size_t)(t + 2) * kstep, k3 = k2 + kstep;
            const char* b2 = last ? nB : cB + (size_t)(t + 2) * kstep; const char* b3 = b2 + kstep;
            if constexpr (SP2) {
            PG8_LDB(B0, 0, 0); PG8_LDB(B1, 0, 1); PG8_SCHED; PG8_LDA(At, 0, 0); PG8_STAGE_A(PG8_SA(1, 1), 1, false, k1);
            PG8_WAIT_V(8); PG8_WAIT_L(0); PG8_BAR; PG8_MMA(0, 0, At, B0); PG8_MMA(0, 1, At, B1); PG8_BAR; PG8_SCHED;
            PG8_LDA(At, 0, 1); PG8_STAGE_B(PG8_SB(0, 0), b2); PG8_STAGE_B(PG8_SB(0, 1), b2 + hstepB); PG8_STAGE_A(PG8_SA(0, 0), 0, last, k2);
            PG8_WAIT_V(8); PG8_WAIT_L(0); PG8_BAR; PG8_MMA(1, 0, At, B0); PG8_MMA(1, 1, At, B1); PG8_BAR; PG8_SCHED;
            PG8_LDB(B0, 1, 0); PG8_LDB(B1, 1, 1); PG8_SCHED; PG8_LDA(At, 1, 0); PG8_STAGE_A(PG8_SA(0, 1), 1, last, k2);
            PG8_WAIT_V(8); PG8_WAIT_L(0); PG8_BAR; PG8_MMA(0, 0, At, B0); PG8_MMA(0, 1, At, B1); PG8_BAR; PG8_SCHED;
            PG8_LDA(At, 1, 1); PG8_STAGE_B(PG8_SB(1, 0), b3); PG8_STAGE_B(PG8_SB(1, 1), b3 + hstepB); PG8_STAGE_A(PG8_SA(1, 0), 0, last, k3);
            PG8_WAIT_V(8); PG8_WAIT_L(0); PG8_BAR; PG8_MMA(1, 0, At, B0); PG8_MMA(1, 1, At, B1); PG8_BAR; PG8_SCHED;
            } else {
            PG8_LDB(B0, 0, 0); PG8_SCHED; PG8_LDA(At, 0, 0); PG8_STAGE_A(PG8_SA(1, 1), 1, false, k1);
            PG8_WAIT_L(8); PG8_BAR; PG8_WAIT_L(0); PG8_MMA(0, 0, At, B0); PG8_BAR; PG8_SCHED;
            PG8_LDB(B1, 0, 1); PG8_STAGE_B(PG8_SB(0, 0), b2);
            PG8_BAR; PG8_WAIT_L(0); PG8_MMA(0, 1, At, B1); PG8_BAR;
            PG8_LDA(At, 0, 1); PG8_STAGE_A(PG8_SA(0, 0), 0, last, k2);
            PG8_BAR; PG8_WAIT_L(0); PG8_MMA(1, 0, At, B0); PG8_BAR; PG8_SCHED;
            PG8_STAGE_B(PG8_SB(0, 1), b2 + hstepB);
            PG8_WAIT_V(6); PG8_BAR; PG8_MMA(1, 1, At, B1); PG8_BAR;
            PG8_LDB(B0, 1, 0); PG8_SCHED; PG8_LDA(At, 1, 0); PG8_STAGE_A(PG8_SA(0, 1), 1, last, k2);
            PG8_WAIT_L(8); PG8_BAR; PG8_WAIT_L(0); PG8_MMA(0, 0, At, B0); PG8_BAR; PG8_SCHED;
            PG8_LDB(B1, 1, 1); PG8_STAGE_B(PG8_SB(1, 0), b3);
            PG8_BAR; PG8_WAIT_L(0); PG8_MMA(0, 1, At, B1); PG8_BAR;
            PG8_LDA(At, 1, 1); PG8_STAGE_A(PG8_SA(1, 0), 0, last, k3);
            PG8_BAR; PG8_WAIT_L(0); PG8_MMA(1, 0, At, B0); PG8_BAR; PG8_SCHED;
            PG8_STAGE_B(PG8_SB(1, 1), b3 + hstepB);
            PG8_WAIT_V(6); PG8_BAR; PG8_MMA(1, 1, At, B1); PG8_BAR;
            }
        }
        if constexpr (F8) { asm volatile("s_nop 15\n\ts_nop 15" ::: "memory"); PG8_SCHED; }
        if constexpr (ALIGN_EPI) { if (wr == 0) PG8_BAR; }
        if constexpr (I8) {
#pragma unroll
            for (int a = 0; a < 2; ++a)
#pragma unroll
                for (int b = 0; b < 2; ++b)
#pragma unroll
                    for (int m = 0; m < 4; ++m)
#pragma unroll
                        for (int n = 0; n < 2; ++n) acc[a][b][m][n] = __builtin_convertvector(__builtin_bit_cast(v4i_t, acc[a][b][m][n]), f32x4); }
        E(acc, cur, wr, wc, fr, fq);
        if (!has_next) break;
#pragma unroll
        for (int a = 0; a < 2; ++a)
#pragma unroll
            for (int b = 0; b < 2; ++b)
#pragma unroll
                for (int m = 0; m < 4; ++m)
#pragma unroll
                    for (int n = 0; n < 2; ++n) acc[a][b][m][n] = (f32x4){0.f, 0.f, 0.f, 0.f};
        cur = nxt; cA = nA; cB = nB; ++ui;
        if constexpr (GATHER) { _Pragma("unroll") for (int _h = 0; _h < 2; ++_h) _Pragma("unroll") for (int _i = 0; _i < 2; ++_i) gAc[_h][_i] = gAn[_h][_i]; }
        if constexpr (ALIGN_EPI) { if (wr == 1) PG8_BAR; }
    }
    PG8_WAIT_V(0);
    if constexpr (!ALIGN_EPI) { if (wr == 0) PG8_BAR; }
    PG8_BAR;
#undef PG8_SA
#undef PG8_SB
#undef PG8_GLDS
#undef PG8_STAGE_A
#undef PG8_STAGE_B
#undef PG8_LDA
#undef PG8_LDB
#undef PG8_MMA
#undef PG8_WAIT_V
#undef PG8_WAIT_L
#undef PG8_BAR
#undef PG8_SCHED
#undef PG8_GOFF
}
}

#define XB_TMO      128
#define XB_XCNT(j)  (256  + 64 * (j))
#define XB_XSUB(j)  (1280 + 64 * (j))
#define XB_XGEN(j)  (2304 + 64 * (j))
#define XB_TOP      3328
#define XB_TOPGEN   3392
#define XCD_BAR_WORDS 3456
#define XB_SPIN_CAP (1u << 18)
__device__ __forceinline__ unsigned xb_ld(unsigned* p)              { return __hip_atomic_load(p, __ATOMIC_RELAXED, __HIP_MEMORY_SCOPE_AGENT); }
__device__ __forceinline__ unsigned xb_add(unsigned* p, unsigned v) { return __hip_atomic_fetch_add(p, v, __ATOMIC_RELAXED, __HIP_MEMORY_SCOPE_AGENT); }
__device__ __forceinline__ unsigned xb_xcc_id() { return (unsigned)__builtin_amdgcn_s_getreg((3 << 11) | 20) & 0xFu; }
#define XB_SPIN(cond, bar) do { unsigned _sp = 0; while (cond) { __builtin_amdgcn_s_sleep(1); \
    if ((++_sp & 255u) == 0u) { if (xb_ld(&(bar)[XB_TMO])) break; if (_sp > XB_SPIN_CAP) { atomicAdd(&(bar)[XB_TMO], 1u); break; } } } } while (0)
struct XcdBarrier { unsigned* bar; unsigned x; volatile LAS unsigned* st; };
__device__ __forceinline__ XcdBarrier xcd_barrier_post(unsigned* bar, volatile LAS unsigned* st) {
    XcdBarrier b; b.bar = bar; b.x = xb_xcc_id(); b.st = st;
    if (threadIdx.x == 0) (void)xb_add(&bar[XB_XCNT(b.x)], 1u);
    return b;
}
__device__ __forceinline__ void xcd_barrier_complete(unsigned* bar, unsigned x, unsigned& nloc, unsigned& nx) {
    const unsigned G = gridDim.x * gridDim.y * gridDim.z;
    unsigned sum, cnt, mine, sp = 0u;
    for (;;) {
        sum = 0u; cnt = 0u; mine = 0u;
#pragma unroll
        for (unsigned j = 0; j < 16; ++j) { const unsigned c = xb_ld(&bar[XB_XCNT(j)]); sum += c; cnt += (c > 0u) ? 1u : 0u; mine = (j == x) ? c : mine; }
        if (sum == G) break;
        __builtin_amdgcn_s_sleep(1);
        if ((++sp & 255u) == 0u) { if (xb_ld(&bar[XB_TMO])) break; if (sp > XB_SPIN_CAP) { atomicAdd(&bar[XB_TMO], 1u); break; } }
    }
    nloc = mine > 0u ? mine : 1u; nx = cnt > 0u ? cnt : 1u;
}
__device__ __forceinline__ void xcd_barrier(const XcdBarrier& b) {
    asm volatile("s_waitcnt vmcnt(0)" ::: "memory");
    __syncthreads();
    if (threadIdx.x == 0) {
        unsigned* bar = b.bar;
        __builtin_amdgcn_s_waitcnt(0);
        unsigned nloc = b.st[0], nx = b.st[1];
        if (nloc == 0u) { xcd_barrier_complete(bar, b.x, nloc, nx); b.st[0] = nloc; b.st[1] = nx; }
        const unsigned old = xb_add(&bar[XB_XSUB(b.x)], 1u);
        const unsigned gen = old / nloc;
        if (old + 1u == (gen + 1u) * nloc) {
            __builtin_amdgcn_fence(__ATOMIC_RELEASE, "agent");
            asm volatile("s_waitcnt vmcnt(0)" ::: "memory");
            const unsigned og = xb_add(&bar[XB_TOP], 1u);
            const unsigned tg = og / nx;
            if (og + 1u == (tg + 1u) * nx) xb_add(&bar[XB_TOPGEN], 1u);
            else XB_SPIN(xb_ld(&bar[XB_TOPGEN]) == tg, bar);
            __builtin_amdgcn_fence(__ATOMIC_ACQUIRE, "agent");
            xb_add(&bar[XB_XGEN(b.x)], 1u);
            asm volatile("s_waitcnt vmcnt(0)" ::: "memory");
        } else {
            XB_SPIN(xb_ld(&bar[XB_XGEN(b.x)]) == gen, bar);
            __builtin_amdgcn_fence(__ATOMIC_ACQUIRE, "agent");
            asm volatile("s_waitcnt vmcnt(0)" ::: "memory");
        }
    }
    __syncthreads();
}

struct Frame {
    LAS unsigned char* lds;
    int tid, lane, wave, vcu, G;
    float* out; unsigned char* ws;
};
struct Args { const float* in[30]; float* out; unsigned char* ws; int ph_lo, ph_hi, li, pad; };
template <int CTRL> __device__ __forceinline__ float dpp_mov(float v) { return __builtin_bit_cast(float, __builtin_amdgcn_update_dpp(0, __builtin_bit_cast(int, v), CTRL, 0xf, 0xf, true)); }
__device__ __forceinline__ float sum8(float v) { v += dpp_mov<0xB1>(v); v += dpp_mov<0x4E>(v); v += dpp_mov<0x141>(v); return v; }
__device__ __forceinline__ float sum16(float v) { v = sum8(v); v += dpp_mov<0x140>(v); return v; }
__device__ __forceinline__ float wave_sum(float v) {
    v = sum16(v);
    const int iv = __builtin_bit_cast(int, v);
    return (__builtin_bit_cast(float, __builtin_amdgcn_readlane(iv, 0)) + __builtin_bit_cast(float, __builtin_amdgcn_readlane(iv, 16))) +
           (__builtin_bit_cast(float, __builtin_amdgcn_readlane(iv, 32)) + __builtin_bit_cast(float, __builtin_amdgcn_readlane(iv, 48)));
}

__device__ __forceinline__ float wave_max(float v) {
    v = fmaxf(v, dpp_mov<0xB1>(v)); v = fmaxf(v, dpp_mov<0x4E>(v)); v = fmaxf(v, dpp_mov<0x141>(v)); v = fmaxf(v, dpp_mov<0x140>(v));
    const int iv = __builtin_bit_cast(int, v);
    return fmaxf(fmaxf(__builtin_bit_cast(float, __builtin_amdgcn_readlane(iv, 0)), __builtin_bit_cast(float, __builtin_amdgcn_readlane(iv, 16))),
                 fmaxf(__builtin_bit_cast(float, __builtin_amdgcn_readlane(iv, 32)), __builtin_bit_cast(float, __builtin_amdgcn_readlane(iv, 48))));
}
__device__ __forceinline__ float reduce8(const float (&a)[8], int lane) {
    const bool b0 = lane & 1, b1 = lane & 2, b2 = lane & 4;
    float b[4], c[2];
#pragma unroll
    for (int m = 0; m < 4; ++m) { const float keep = b0 ? a[2 * m + 1] : a[2 * m], send = b0 ? a[2 * m] : a[2 * m + 1]; b[m] = keep + dpp_mov<0xB1>(send); }
#pragma unroll
    for (int m = 0; m < 2; ++m) { const float keep = b1 ? b[2 * m + 1] : b[2 * m], send = b1 ? b[2 * m] : b[2 * m + 1]; c[m] = keep + dpp_mov<0x4E>(send); }
    float d;
    { const float keep = b2 ? c[1] : c[0], send = b2 ? c[0] : c[1]; d = keep + dpp_mov<0x124>(send); }
    d += dpp_mov<0x128>(d);
    { const unsigned u = __builtin_bit_cast(unsigned, d); const auto r = __builtin_amdgcn_permlane16_swap(u, u, false, false); d = __builtin_bit_cast(float, (unsigned)r[0]) + __builtin_bit_cast(float, (unsigned)r[1]); }
    { const unsigned u = __builtin_bit_cast(unsigned, d); const auto r = __builtin_amdgcn_permlane32_swap(u, u, false, false); d = __builtin_bit_cast(float, (unsigned)r[0]) + __builtin_bit_cast(float, (unsigned)r[1]); }
    return d;
}

__device__ __forceinline__ void tr_item(const float* W, int ldw, int k0, int srccol0, bf16* WT, int K, int dstrow0, LAS float* scr, int lane) {
    (void)scr;
    const int kr = lane >> 3, nq = lane & 7;
    const float* src = W + (size_t)(k0 + 8 * kr) * ldw + srccol0 + 4 * nq;
    f32x4 x[8];
#pragma unroll
    for (int b = 0; b < 8; ++b) x[b] = *(const GAS f32x4*)(src + (size_t)b * ldw);
    bf16* dst = WT + (size_t)(dstrow0 + 4 * nq) * K + k0 + 8 * kr;
#pragma unroll
    for (int q = 0; q < 4; ++q) { v4u o; o.x = pk2(x[0][q], x[1][q]); o.y = pk2(x[2][q], x[3][q]); o.z = pk2(x[4][q], x[5][q]); o.w = pk2(x[6][q], x[7][q]);
        *(GAS v4u*)(dst + (size_t)q * K) = o; }
}
__device__ __forceinline__ void tr_item_f8(const float* W, int ldw, int k0, int srccol0, unsigned char* WT, int K, int dstrow0, int lane, float sc) {
    const int kr = lane >> 3, nq = lane & 7;
    const float* src = W + (size_t)(k0 + 4 * kr) * ldw + srccol0 + 4 * nq;
    f32x4 x[4][4];
#pragma unroll
    for (int a = 0; a < 4; ++a)
#pragma unroll
        for (int b = 0; b < 4; ++b) x[a][b] = *(const GAS f32x4*)(src + (size_t)(32 * a + b) * ldw);
    unsigned char* dst = WT + (size_t)(dstrow0 + 4 * nq) * K + k0 + 4 * kr;
#pragma unroll
    for (int a = 0; a < 4; ++a)
#pragma unroll
        for (int q = 0; q < 4; ++q)
            *(GAS unsigned*)(dst + (size_t)q * K + 32 * a) = f8x4(x[a][0][q] * sc, x[a][1][q] * sc, x[a][2][q] * sc, x[a][3][q] * sc);
}
__device__ __forceinline__ void tr_item_i8(const float* W, int ldw, int k0, int srccol0, unsigned char* WT, int K, int dstrow0, int lane) {
    const int kr = lane >> 3, nq = lane & 7;
    const float* src = W + (size_t)(k0 + 4 * kr) * ldw + srccol0 + 4 * nq;
    f32x4 x[4][4];
#pragma unroll
    for (int a = 0; a < 4; ++a)
#pragma unroll
        for (int b = 0; b < 4; ++b) x[a][b] = *(const GAS f32x4*)(src + (size_t)(32 * a + b) * ldw);
    unsigned char* dst = WT + (size_t)(dstrow0 + 4 * nq) * K + k0 + 4 * kr;
#pragma unroll
    for (int a = 0; a < 4; ++a)
#pragma unroll
        for (int q = 0; q < 4; ++q)
            *(GAS unsigned*)(dst + (size_t)q * K + 32 * a) = q8x4(x[a][0][q] * I8_WINV, x[a][1][q] * I8_WINV, x[a][2][q] * I8_WINV, x[a][3][q] * I8_WINV);
}
__device__ __forceinline__ void conv_mixer_item(Frame& F, const Args& A_, int l, unsigned char* dst, int r, LAS float* scr) {
    constexpr int I_IN = 8 * (NPROJ / 32), I_P = 8 * 32, I_O = 16 * 32;
    if (r < I_IN) { const int kb = r / (NPROJ / 32), nb = r % (NPROJ / 32); tr_item_i8(A_.in[2] + (size_t)l * D * INC, INC, kb * 128, nb * 32 + (nb >= 104 ? 8 : 0), dst + MW_IN, D, nb * 32, F.lane); return; } r -= I_IN;
    if (r < I_P) { const int kb = r / 32, nb = r % 32; tr_item(A_.in[14] + (size_t)l * 512 * D, D, kb * 64, nb * 32, (bf16*)(dst + MW_PA), 512, nb * 32, scr, F.lane); return; } r -= I_P;
    if (r < I_P) { const int kb = r / 32, nb = r % 32; tr_item(A_.in[19] + (size_t)l * 512 * D, D, kb * 64, nb * 32, (bf16*)(dst + MW_PB), 512, nb * 32, scr, F.lane); return; } r -= I_P;
    { const int kb = r / 32, nb = r % 32; tr_item(A_.in[20] + (size_t)l * D * D, D, kb * 64, nb * 32, (bf16*)(dst + MW_OUT), D, nb * 32, scr, F.lane); }
}
constexpr int MIXER_ITEMS = 8 * (NPROJ / 32) + 2 * 8 * 32 + 16 * 32;
constexpr int FFN_ITEMS = 3 * 16 * (FF / 32);
__device__ __forceinline__ void conv_ffn_item(Frame& F, const float* wg, const float* wu, const float* wd, bf16* gu, bf16* dn, int r, LAS float* scr) {
    constexpr int I_G = 16 * (FF / 32);
    if (r < I_G) { const int kb = r / (FF / 32), nb = r % (FF / 32), n0 = nb * 32; tr_item(wg, FF, kb * 64, n0, gu, D, (n0 / 128) * 256 + (n0 % 128), scr, F.lane); return; } r -= I_G;
    if (r < I_G) { const int kb = r / (FF / 32), nb = r % (FF / 32), n0 = nb * 32; tr_item(wu, FF, kb * 64, n0, gu, D, (n0 / 128) * 256 + 128 + (n0 % 128), scr, F.lane); return; } r -= I_G;
    { const int kb = r / 32, nb = r % 32; tr_item(wd, D, kb * 64, nb * 32, dn, FF, nb * 32, scr, F.lane); }
}

constexpr int FFN_ITEMS8 = 3 * 8 * (FF / 32);
template <bool GUF8 = false>
__device__ __forceinline__ void conv_ffn_item_f8(Frame& F, const float* wg, const float* wu, const float* wd, unsigned char* gu, unsigned char* dn, int r) {
    constexpr int I_G = 8 * (FF / 32);
    static_assert((FF / 128) * (D / 32) == I_G, "down items");
    if (r < I_G) { const int kb = r / (FF / 32), nb = r % (FF / 32), n0 = nb * 32; if constexpr (GUF8) tr_item_f8(wg, FF, kb * 128, n0, gu, D, (n0 / 128) * 256 + (n0 % 128), F.lane, F8_SW); else tr_item_i8(wg, FF, kb * 128, n0, gu, D, (n0 / 128) * 256 + (n0 % 128), F.lane); return; } r -= I_G;
    if (r < I_G) { const int kb = r / (FF / 32), nb = r % (FF / 32), n0 = nb * 32; if constexpr (GUF8) tr_item_f8(wu, FF, kb * 128, n0, gu, D, (n0 / 128) * 256 + 128 + (n0 % 128), F.lane, F8_SW); else tr_item_i8(wu, FF, kb * 128, n0, gu, D, (n0 / 128) * 256 + 128 + (n0 % 128), F.lane); return; } r -= I_G;
    { const int kb = r / 32, nb = r % 32; tr_item_f8(wd, D, kb * 128, nb * 32, dn, FF, nb * 32, F.lane, F8_SW); }
}

template <int MODE>
__device__ __forceinline__ void norm_phase(Frame& F, const float* xin, const float* gain, const float* w8src, int w8ld) {
    bf16* XN = (bf16*)(F.ws + WS_XN);
    f32x4 gv[4];
#pragma unroll
    for (int j = 0; j < 4; ++j) { gv[j] = *(const f32x4*)(gain + 4 * F.lane + 256 * j); }
    float w8[4][4][8];
    if constexpr (MODE == 0 || MODE == 2) {
#pragma unroll
        for (int j = 0; j < 4; ++j)
#pragma unroll
            for (int q = 0; q < 4; ++q) { const float* s = w8src + (size_t)(4 * F.lane + 256 * j + q) * w8ld; const f32x4 a = *(const f32x4*)s, b = *(const f32x4*)(s + 4);
                w8[j][q][0] = a[0]; w8[j][q][1] = a[1]; w8[j][q][2] = a[2]; w8[j][q][3] = a[3]; w8[j][q][4] = b[0]; w8[j][q][5] = b[1]; w8[j][q][6] = b[2]; w8[j][q][7] = b[3]; }
    }
    LAS int* cnt = (LAS int*)(F.lds);
    for (int p = F.vcu; p < M / 256; p += F.G) {
        if constexpr (MODE == 2) { if (F.tid < 16) cnt[F.tid] = 0; __syncthreads(); }
        f32x4 nx[4][4];
        const int rot = (p * 13) & 31;
#pragma unroll
        for (int r = 0; r < 4; ++r) { const GAS f32x4* xr = (const GAS f32x4*)(xin + (size_t)(p * 256 + ((r + rot) & 31) * 8 + F.wave) * D) + F.lane;
#pragma unroll
            for (int j = 0; j < 4; ++j) nx[r][j] = __builtin_nontemporal_load(&xr[64 * j]); }
#pragma unroll 4
        for (int i = 0; i < 32; ++i) {
            const int m = p * 256 + ((i + rot) & 31) * 8 + F.wave;
            f32x4 v[4]; float s = 0.f;
            if constexpr (MODE == 3) {
                const GAS v2u* tr = (const GAS v2u*)(XN + (size_t)m * D) + F.lane; const GAS v2u* t0 = (const GAS v2u*)((const bf16*)(F.ws + WS_TMP0) + (size_t)m * D) + F.lane;
#pragma unroll
                for (int j = 0; j < 4; ++j) { const v2u t2 = __builtin_nontemporal_load(&tr[64 * j]), t3 = __builtin_nontemporal_load(&t0[64 * j]);
                    nx[i & 3][j] += (f32x4){bf_lo(t2.x), bf_hi(t2.x), bf_lo(t2.y), bf_hi(t2.y)} + (f32x4){bf_lo(t3.x), bf_hi(t3.x), bf_lo(t3.y), bf_hi(t3.y)}; } }
#pragma unroll
            for (int j = 0; j < 4; ++j) { v[j] = nx[i & 3][j]; s += (v[j].x * v[j].x + v[j].y * v[j].y) + (v[j].z * v[j].z + v[j].w * v[j].w); }
            if (i + 4 < 32) { const GAS f32x4* xr = (const GAS f32x4*)(xin + (size_t)(p * 256 + ((i + 4 + rot) & 31) * 8 + F.wave) * D) + F.lane;
#pragma unroll
                for (int j = 0; j < 4; ++j) nx[i & 3][j] = __builtin_nontemporal_load(&xr[64 * j]); }
            const float rstd = 1.0f / sqrtf(wave_sum(s) * (1.f / D) + 1e-6f);
#pragma unroll
            for (int j = 0; j < 4; ++j) v[j] = v[j] * rstd * gv[j];
            if constexpr (MODE == 3) { GAS f32x4* o = (GAS f32x4*)(F.out + (size_t)m * D) + F.lane;
#pragma unroll
                for (int j = 0; j < 4; ++j) __builtin_nontemporal_store(v[j], &o[64 * j]);
            } else if constexpr (MODE == 2) { GAS unsigned* o4 = (GAS unsigned*)((unsigned char*)XN + (size_t)m * D) + F.lane;
#pragma unroll
                for (int j = 0; j < 4; ++j) o4[64 * j] = f8x4(v[j].x * F8_SX, v[j].y * F8_SX, v[j].z * F8_SX, v[j].w * F8_SX);
            } else if constexpr (MODE == 0 || MODE == 1) {
                float am = 0.f;
#pragma unroll
                for (int j = 0; j < 4; ++j) am = fmaxf(fmaxf(am, fmaxf(fabsf(v[j].x), fabsf(v[j].y))), fmaxf(fabsf(v[j].z), fabsf(v[j].w)));
                am = fmaxf(wave_max(am), 1e-20f);
                const float qi = 127.f * __builtin_amdgcn_rcpf(am);
                if (F.lane == 0) ((float*)(F.ws + WS_RS))[m] = am * (1.f / 127.f);
                GAS unsigned* o4 = (GAS unsigned*)((unsigned char*)XN + (size_t)m * D) + F.lane;
#pragma unroll
                for (int j = 0; j < 4; ++j) o4[64 * j] = q8x4(v[j].x * qi, v[j].y * qi, v[j].z * qi, v[j].w * qi);
            } else { GAS v2u* o8 = (GAS v2u*)(XN + (size_t)m * D) + F.lane;
#pragma unroll
                for (int j = 0; j < 4; ++j) { v2u w; w.x = pk2(v[j].x, v[j].y); w.y = pk2(v[j].z, v[j].w); o8[64 * j] = w; } }
            if constexpr (MODE == 0 || MODE == 2) {
                f32x2 pa2[4];
#pragma unroll
                for (int e2 = 0; e2 < 4; ++e2) pa2[e2] = (f32x2){0.f, 0.f};
#pragma unroll
                for (int j = 0; j < 4; ++j)
#pragma unroll
                    for (int q = 0; q < 4; ++q) { const float vv = v[j][q]; const f32x2 v2 = {vv, vv};
#pragma unroll
                        for (int e2 = 0; e2 < 4; ++e2) pa2[e2] += v2 * (f32x2){w8[j][q][2 * e2], w8[j][q][2 * e2 + 1]}; }
                const float pa[8] = {pa2[0][0], pa2[0][1], pa2[1][0], pa2[1][1], pa2[2][0], pa2[2][1], pa2[3][0], pa2[3][1]};
                const float tot = reduce8(pa, F.lane);
                if constexpr (MODE == 0) { if (F.lane < 8) ((float*)(F.ws + WS_AB))[(size_t)m * 8 + F.lane] = tot; }
                else {
                    float pr[8];
#pragma unroll
                    for (int e = 0; e < 8; ++e) pr[e] = __builtin_bit_cast(float, __builtin_amdgcn_readlane(__builtin_bit_cast(int, tot), e));
                    float b1 = pr[0]; int e1 = 0;
#pragma unroll
                    for (int e = 1; e < 8; ++e) if (pr[e] > b1) { b1 = pr[e]; e1 = e; }
                    float b2 = -3.0e38f; int e2 = 0;
#pragma unroll
                    for (int e = 0; e < 8; ++e) if (e != e1 && pr[e] > b2) { b2 = pr[e]; e2 = e; }
                    const float g1 = 1.0f / (1.0f + __expf(b2 - b1));
                    if (F.lane == 0) { ((int*)(F.ws + WS_RE))[m] = e1 | (e2 << 4); ((float*)(F.ws + WS_RG))[m] = g1; __hip_atomic_fetch_add(&cnt[e1], 1, __ATOMIC_RELAXED, __HIP_MEMORY_SCOPE_WORKGROUP); __hip_atomic_fetch_add(&cnt[8 + e2], 1, __ATOMIC_RELAXED, __HIP_MEMORY_SCOPE_WORKGROUP); }
                }
            }
        }
        if constexpr (MODE == 2) { __syncthreads(); if (F.tid < 16) ((int*)(F.ws + WS_WGCNT))[p * 16 + F.tid] = cnt[F.tid]; __syncthreads(); }
    }
}

__device__ __forceinline__ void route_scatter(Frame& F) {
    LAS int* sh = (LAS int*)F.lds;
    const int* wgcnt = (const int*)(F.ws + WS_WGCNT);
    int* list = (int*)(F.ws + WS_LIST); float* gatel = (float*)(F.ws + WS_GATEL); int* grp = (int*)(F.ws + WS_GRP); float* rsl = (float*)(F.ws + WS_RSL); const float* rsv = (const float*)(F.ws + WS_RS);
    const int* re = (const int*)(F.ws + WS_RE); const float* rg = (const float*)(F.ws + WS_RG);
    for (int p = F.vcu; p < M / 256; p += F.G) {
        __syncthreads();
        { const int g = F.tid & 15, part = F.tid >> 4; int tot = 0, pre = 0;
#pragma unroll
          for (int j = 0; j < 8; ++j) { const int q = part * 8 + j; const int c = wgcnt[q * 16 + g]; pre += (q < p) ? c : 0; tot += c; }
          sh[128 + part * 16 + g] = tot; sh[128 + 512 + part * 16 + g] = pre; }
        __syncthreads();
        if (F.tid < 16) { int tot = 0, pre = 0; for (int q = 0; q < 32; ++q) { tot += sh[128 + q * 16 + F.tid]; pre += sh[128 + 512 + q * 16 + F.tid]; } sh[F.tid] = tot; sh[16 + F.tid] = pre; }
        __syncthreads();
        if (F.tid == 0) { int b = 0; for (int g = 0; g < 16; ++g) { sh[32 + g] = b; b += (sh[g] + 255) & ~255; } sh[48] = b; }
        __syncthreads();
        if (p == 0) {
            if (F.tid <= 16) grp[F.tid] = sh[32 + F.tid];
            if (F.tid < 16) grp[17 + F.tid] = sh[F.tid];
            for (int g = 0; g < 16; ++g) { const int lo = sh[32 + g] + sh[g], hi = sh[32 + g + 1]; for (int q = lo + F.tid; q < hi; q += NWAVES * 64) { list[q] = -1; gatel[q] = 0.f; rsl[q] = 0.f; } }
        }
        int e1 = 0, e2 = 0; float g1 = 0.f; int r1 = 0, r2 = 0;
        if (F.tid < 256) {
            const int m = p * 256 + F.tid; const int ee = re[m]; e1 = ee & 15; e2 = ee >> 4; g1 = rg[m];
#pragma unroll
            for (int e = 0; e < 8; ++e) {
                const unsigned long long m1 = __ballot(e1 == e), m2 = __ballot(e2 == e); const unsigned long long lt = (1ull << F.lane) - 1ull;
                if (e1 == e) r1 = __popcll(m1 & lt); if (e2 == e) r2 = __popcll(m2 & lt);
                if (F.lane == 0) { sh[64 + F.wave * 16 + e] = __popcll(m1); sh[64 + F.wave * 16 + 8 + e] = __popcll(m2); }
            }
        }
        __syncthreads();
        if (F.tid < 256) {
            const int m = p * 256 + F.tid; int o1 = sh[32 + e1] + sh[16 + e1] + r1, o2 = sh[32 + 8 + e2] + sh[16 + 8 + e2] + r2;
            for (int w = 0; w < F.wave; ++w) { o1 += sh[64 + w * 16 + e1]; o2 += sh[64 + w * 16 + 8 + e2]; }
            const float sm = 0.f; (void)rsv;
            list[o1] = m; gatel[o1] = g1; rsl[o1] = sm; list[o2] = m; gatel[o2] = 1.0f - g1; rsl[o2] = sm;
        }
    }
}

constexpr int CH = 16, NCH = T / CH;
constexpr int RW_BYTES = 60736;
static_assert(2 * RW_BYTES <= RING_BYTES, "rwkv lds");
constexpr int XA_PITCH = 528;

typedef short bf16x4 __attribute__((ext_vector_type(4)));
#define MFMA32(a, b, c) __builtin_amdgcn_mfma_f32_16x16x32_bf16(a, b, c, 0, 0, 0)
#define MFMA16(a, b, c) __builtin_amdgcn_mfma_f32_16x16x16bf16_1k(a, b, c, 0, 0, 0)
__device__ __forceinline__ unsigned cvt2(float a, float b) { const f32x2 v = {a, b}; const bf16v2_t r = __builtin_convertvector(v, bf16v2_t); return __builtin_bit_cast(unsigned, r); }
__device__ __forceinline__ bf16x4 pack4(float a, float b, float c, float d) { v2u w; w.x = cvt2(a, b); w.y = cvt2(c, d); return __builtin_bit_cast(bf16x4, w); }
__device__ __forceinline__ bf16x8 pack8(const f32x4 a, const f32x4 b) { v4u w; w.x = cvt2(a[0], a[1]); w.y = cvt2(a[2], a[3]); w.z = cvt2(b[0], b[1]); w.w = cvt2(b[2], b[3]); return __builtin_bit_cast(bf16x8, w); }
#define WAVE_LDS_FENCE() asm volatile("s_waitcnt lgkmcnt(0)" ::: "memory")
constexpr int G2_KI = 0, G2_QI = 17408, G2_KT = 34816, G2_VT = 53248, G2_GR = 71680, G2_BE = 71936, G2_GC = 72192, G2_NM = 72448, G2_TI = 76544, G2_O = 79104, G2_CW = G2_O + 64 * 528, G2_BYTES = G2_CW + 4 * 384 * 4;
constexpr int G2_IP = 272, G2_TP = 144, G2_TIP = 40, G2_OP = 132;
static_assert(G2_BYTES <= RING_BYTES, "gdn lds");
constexpr int GB = 64, NGB = T / GB;

__device__ __forceinline__ void gdn_unit2(Frame& F, const Args& A_, int layer, int u) {
    const int b = u >> 2, h = u & 3, tid = F.tid, lane = F.lane, w = F.wave, c = lane & 15, g = lane >> 4;
    LAS unsigned char* L = F.lds;
    LAS float* GR = (LAS float*)(L + G2_GR); LAS float* BE = (LAS float*)(L + G2_BE); LAS float* GC = (LAS float*)(L + G2_GC); LAS float* NM = (LAS float*)(L + G2_NM); LAS float* Om = (LAS float*)(L + G2_O);
    const bf16* PROJ = (const bf16*)(F.ws + WS_PROJ);
    bf16* OUT = (bf16*)(F.ws + WS_XN);
    const float* AB = (const float*)(F.ws + WS_AB);
    const int part = g, cg = c;
    const int colbase = (part == 0 ? C_GQ : (part == 1 ? C_GK : C_GV)) + h * 128 + 8 * cg;
    LAS float* CW = (LAS float*)(L + G2_CW);
    for (int idx = tid; idx < 4 * 384; idx += NWAVES * 64) { const int j = idx / 384, cc = idx % 384; CW[idx] = A_.in[15][(size_t)layer * 4 * 1536 + j * 1536 + (cc >> 7) * 512 + h * 128 + (cc & 127)]; }
    const int cwoff = (part < 3 ? part : 0) * 128 + 8 * cg;
    __syncthreads();
    const float nexpa = -__expf(A_.in[16][layer * 4 + h]), dtb = A_.in[17][layer * 4 + h];
    const int d0 = (8 * cg) & 31, pc0 = (8 * cg & ~31) + 8 * ((d0 >> 2) & 3) + 4 * (d0 >> 4);
    const int ptok = tid >> 3, pch = (tid & 7) * 16;
    f32x4 S[8];
#pragma unroll
    for (int m = 0; m < 8; ++m) S[m] = (f32x4){0.f, 0.f, 0.f, 0.f};
    v4u pre[11]; v4u zpre[2]; float abpre[2];
    auto prefetch = [&](int bt) {
        const int tb = bt * GB;
#pragma unroll
        for (int i = 0; i < 11; ++i) { const int tok = tb + 8 * w - 3 + i; pre[i] = (v4u){0u, 0u, 0u, 0u};
            if (part < 3 && tok >= 0) pre[i] = *(const GAS v4u*)(PROJ + (size_t)(b * T + tok) * NPROJ + colbase); }
        abpre[0] = 0.f; abpre[1] = 0.f;
        if (part == 3 && cg < 8) { const float* ab = AB + (size_t)(b * T + tb + 8 * w + cg) * 8; abpre[0] = ab[h]; abpre[1] = ab[4 + h]; }
    };
    prefetch(0);
    for (int bt = 0; bt < NGB; ++bt) {
        const int tb = bt * GB;
        if (!(PADF & 4)) {
            unsigned ktp[8][4];
            float xr[4][8];
#pragma unroll
            for (int i = 0; i < 3; ++i) { xr[i][0] = bf_lo(pre[i].x); xr[i][1] = bf_hi(pre[i].x); xr[i][2] = bf_lo(pre[i].y); xr[i][3] = bf_hi(pre[i].y); xr[i][4] = bf_lo(pre[i].z); xr[i][5] = bf_hi(pre[i].z); xr[i][6] = bf_lo(pre[i].w); xr[i][7] = bf_hi(pre[i].w); }
            float yprev[8];
#pragma unroll
            for (int tk = 0; tk < 8; ++tk) {
                const v4u pw = pre[tk + 3];
                xr[3][0] = bf_lo(pw.x); xr[3][1] = bf_hi(pw.x); xr[3][2] = bf_lo(pw.y); xr[3][3] = bf_hi(pw.y); xr[3][4] = bf_lo(pw.z); xr[3][5] = bf_hi(pw.z); xr[3][6] = bf_lo(pw.w); xr[3][7] = bf_hi(pw.w);
                float y[8]; float ss = 0.f;
#pragma unroll
                for (int e = 0; e < 8; ++e) y[e] = 0.f;
#pragma unroll
                for (int j = 0; j < 4; ++j) { const f32x4 wa = *(const LAS f32x4*)(CW + j * 384 + cwoff), wb = *(const LAS f32x4*)(CW + j * 384 + cwoff + 4);
#pragma unroll
                    for (int e = 0; e < 4; ++e) { y[e] += wa[e] * xr[j][e]; y[4 + e] += wb[e] * xr[j][4 + e]; } }
#pragma unroll
                for (int e = 0; e < 8; ++e) { const float a = y[e]; y[e] = a * sigmoidf_(a); ss += y[e] * y[e]; }
                ss = sum16(ss);
                const float sc = part == 2 ? 1.0f : (__builtin_amdgcn_rsqf(ss + 1e-6f)) * (part == 0 ? 0.08838834764831845f : 1.0f);
#pragma unroll
                for (int e = 0; e < 8; ++e) y[e] *= sc;
                const int trow = 8 * w + tk;
                if (part < 2) { LAS unsigned char* img = L + (part == 0 ? G2_QI : G2_KI) + trow * G2_IP;
                    v2u a0; a0.x = pg8::cvt_pk_bf16(y[0], y[1]); a0.y = pg8::cvt_pk_bf16(y[2], y[3]); v2u a1; a1.x = pg8::cvt_pk_bf16(y[4], y[5]); a1.y = pg8::cvt_pk_bf16(y[6], y[7]);
                    *(LAS v2u*)(img + pc0 * 2) = a0; *(LAS v2u*)(img + (pc0 + 8) * 2) = a1; }
                if (tk & 1) {
#pragma unroll
                    for (int e = 0; e < 8; ++e) ktp[e][tk >> 1] = pg8::cvt_pk_bf16(yprev[e], y[e]); }
#pragma unroll
                for (int e = 0; e < 8; ++e) yprev[e] = y[e];
#pragma unroll
                for (int e = 0; e < 8; ++e) { xr[0][e] = xr[1][e]; xr[1][e] = xr[2][e]; xr[2][e] = xr[3][e]; }
            }
            if (part == 1 || part == 2) { LAS unsigned char* timg = L + (part == 1 ? G2_KT : G2_VT);
#pragma unroll
                for (int e = 0; e < 8; ++e) { v4u o; o.x = ktp[e][0]; o.y = ktp[e][1]; o.z = ktp[e][2]; o.w = ktp[e][3]; *(LAS v4u*)(timg + (8 * cg + e) * G2_TP + (8 * w) * 2) = o; } }
            if (part == 3 && cg < 8) { GR[8 * w + cg] = nexpa * softplusf_(abpre[0] + dtb); BE[8 * w + cg] = sigmoidf_(abpre[1]); }
        }
        __syncthreads();
        if (bt + 1 < NGB) prefetch(bt + 1);
        { const bf16* zp = PROJ + (size_t)(b * T + tb + ptok) * NPROJ + C_Z + h * 128 + pch; zpre[0] = *(const GAS v4u*)zp; zpre[1] = *(const GAS v4u*)(zp + 8); }
        if (w < 4 && !(PADF & 8)) {
            const int i = w;
            float gv = GR[16 * i + c];
#pragma unroll
            for (int o = 1; o < 16; o <<= 1) { const float t_ = __shfl_up(gv, o, 16); if (c >= o) gv += t_; }
            if (g == 0) GC[16 * i + c] = gv;
            f32x4 acc = (f32x4){0.f, 0.f, 0.f, 0.f};
            const LAS unsigned char* rowK = L + G2_KI + (16 * i + c) * G2_IP + g * 16;
#pragma unroll
            for (int s = 0; s < 4; ++s) { const bf16x8 f = *(const LAS bf16x8*)(rowK + 64 * s); acc = MFMA32(f, f, acc); }
            WAVE_LDS_FENCE();
            const f32x4 gct = *(const LAS f32x4*)(GC + 16 * i + 4 * g), bet = *(const LAS f32x4*)(BE + 16 * i + 4 * g);
#pragma unroll
            for (int r = 0; r < 4; ++r) { const int t_ = 4 * g + r; NM[i * 256 + t_ * 16 + c] = (c < t_) ? -bet[r] * acc[r] * __expf(fminf(gct[r] - gv, 0.f)) : 0.f; }
            WAVE_LDS_FENCE();
            float Tc[16];
#pragma unroll
            for (int t_ = 0; t_ < 16; ++t_) { float a = (t_ == c) ? 1.f : 0.f;
#pragma unroll
                for (int q4 = 0; q4 * 4 < t_; ++q4) { const f32x4 n4 = *(const LAS f32x4*)(NM + i * 256 + t_ * 16 + 4 * q4);
#pragma unroll
                    for (int e = 0; e < 4; ++e) if (4 * q4 + e < t_) a += n4[e] * Tc[4 * q4 + e]; }
                Tc[t_] = a; }
            if (g == 0) {
#pragma unroll
                for (int t_ = 0; t_ < 16; ++t_) *(LAS bf16*)(L + G2_TI + i * (16 * G2_TIP) + t_ * G2_TIP + c * 2) = (bf16)f2bf(Tc[t_]); }
        }
        __syncthreads();
#pragma unroll 1
        for (int i = (PADF & 16) ? 4 : 0; i < 4; ++i) {
            const LAS unsigned char* rowK = L + G2_KI + (16 * i + c) * G2_IP + g * 16; const LAS unsigned char* rowQ = L + G2_QI + (16 * i + c) * G2_IP + g * 16;
            bf16x8 kf[4], qf[4];
#pragma unroll
            for (int s = 0; s < 4; ++s) { kf[s] = *(const LAS bf16x8*)(rowK + 64 * s); qf[s] = *(const LAS bf16x8*)(rowQ + 64 * s); }
            const float gcc = GC[16 * i + c], gl = GC[16 * i + 15];
            const f32x4 gcr = *(const LAS f32x4*)(GC + 16 * i + 4 * g), ber = *(const LAS f32x4*)(BE + 16 * i + 4 * g);
            const v2u vw = *(const LAS v2u*)(L + G2_VT + (16 * w + c) * G2_TP + (16 * i + 4 * g) * 2);
            const bf16x4 tf = *(const LAS bf16x4*)(L + G2_TI + i * (16 * G2_TIP) + c * G2_TIP + g * 8);
            f32x4 dq = (f32x4){0.f, 0.f, 0.f, 0.f};
#pragma unroll
            for (int s = 0; s < 4; ++s) dq = MFMA32(kf[s], qf[s], dq);
            bf16x8 Sb[4];
#pragma unroll
            for (int s = 0; s < 4; ++s) Sb[s] = pack8(S[2 * s], S[2 * s + 1]);
            f32x4 y = (f32x4){0.f, 0.f, 0.f, 0.f}, qs = y;
#pragma unroll
            for (int s = 0; s < 4; ++s) y = MFMA32(kf[s], Sb[s], y);
#pragma unroll
            for (int s = 0; s < 4; ++s) qs = MFMA32(qf[s], Sb[s], qs);
            float qa[4], egr[4], xv[4];
            const float vv[4] = {bf_lo(vw.x), bf_hi(vw.x), bf_lo(vw.y), bf_hi(vw.y)};
#pragma unroll
            for (int r = 0; r < 4; ++r) { qa[r] = (4 * g + r <= c) ? dq[r] * __expf(fminf(gcc - gcr[r], 0.f)) : 0.f; egr[r] = __expf(gcr[r]); xv[r] = ber[r] * (vv[r] - egr[r] * y[r]); qs[r] *= egr[r]; }
            const f32x4 vn = MFMA16(tf, pack4(xv[0], xv[1], xv[2], xv[3]), ((f32x4){0.f, 0.f, 0.f, 0.f}));
            const f32x4 o = MFMA16(pack4(qa[0], qa[1], qa[2], qa[3]), pack4(vn[0], vn[1], vn[2], vn[3]), qs);
#pragma unroll
            for (int r = 0; r < 4; ++r) Om[(16 * i + 4 * g + r) * G2_OP + 16 * w + c] = o[r];
            const float egl = __expf(gl);
            const bf16x4 vsb = pack4(vn[0] * __expf(gl - gcr[0]), vn[1] * __expf(gl - gcr[1]), vn[2] * __expf(gl - gcr[2]), vn[3] * __expf(gl - gcr[3]));
#pragma unroll
            for (int m = 0; m < 8; ++m) { const bf16x4 kt = *(const LAS bf16x4*)(L + G2_KT + (16 * m + c) * G2_TP + (16 * i + 4 * g) * 2); S[m] = MFMA16(kt, vsb, S[m] * egl); }
        }
        __syncthreads();
        if (!(PADF & 32)) {
            f32x4 o4[4]; float ss = 0.f;
#pragma unroll
            for (int q = 0; q < 4; ++q) { o4[q] = *(const LAS f32x4*)(Om + ptok * G2_OP + pch + 4 * q); ss += (o4[q][0] * o4[q][0] + o4[q][1] * o4[q][1]) + (o4[q][2] * o4[q][2] + o4[q][3] * o4[q][3]); }
            ss = sum8(ss);
            const float rs = __builtin_amdgcn_rsqf(ss * (1.f / 128.f) + 1e-6f);
            const float* gp = A_.in[18] + layer * 128 + pch;
            const unsigned zz[8] = {zpre[0].x, zpre[0].y, zpre[0].z, zpre[0].w, zpre[1].x, zpre[1].y, zpre[1].z, zpre[1].w};
            unsigned ow[8];
#pragma unroll
            for (int q = 0; q < 4; ++q) { const f32x4 gq = *(const f32x4*)(gp + 4 * q);
                const float za = bf_lo(zz[2 * q]), zb = bf_hi(zz[2 * q]), zc = bf_lo(zz[2 * q + 1]), zd = bf_hi(zz[2 * q + 1]);
                ow[2 * q] = pk2(o4[q][0] * rs * gq[0] * za * sigmoidf_(za), o4[q][1] * rs * gq[1] * zb * sigmoidf_(zb));
                ow[2 * q + 1] = pk2(o4[q][2] * rs * gq[2] * zc * sigmoidf_(zc), o4[q][3] * rs * gq[3] * zd * sigmoidf_(zd)); }
            bf16* op = OUT + (size_t)(b * T + tb + ptok) * D + 512 + h * 128 + pch;
            *(GAS v4u*)op = (v4u){ow[0], ow[1], ow[2], ow[3]}; *(GAS v4u*)(op + 8) = (v4u){ow[4], ow[5], ow[6], ow[7]};
        }
    }
    __syncthreads();
}

constexpr int R2_AI = 0, R2_BI = 2304, R2_KI = 4608, R2_RI = 6912, R2_VI = 9216, R2_W15 = 16896;
constexpr int R2_IP = 144, R2_TP = 40;
constexpr int R3_XA = 0, R3_R = 8448, R3_KM = 12544, R3_V = 16640, R3_LW = 20736, R3_AV = 24832, R3_G = 28928, R3_O = 33024, R3_BON = 37120, R3_MU = 37184, R3_IMG = 38976;
static_assert(R3_IMG + R2_W15 + 256 <= RW_BYTES && R3_R + 32768 <= RW_BYTES, "rwkv lds map");
__device__ __forceinline__ float fast_tanh(float x) { const float e = __expf(2.0f * x); return 1.0f - 2.0f * __builtin_amdgcn_rcpf(e + 1.0f); }
__device__ __forceinline__ float fast_softplus(float x) { return x > 20.f ? x : __logf(1.0f + __expf(x)); }
__device__ __forceinline__ bf16x4 pack4v(const f32x4 v) { return pack4(v[0], v[1], v[2], v[3]); }

__device__ __forceinline__ void rwkv_pair2(Frame& F, const Args& A_, int layer, int pairidx) {
    const int half = F.wave >> 2, wq = F.wave & 3, ht = F.tid & 255, lane = F.lane, c = lane & 15, g = lane >> 4;
    const int h = 2 * (pairidx & 3) + half, b = pairidx >> 2;
    LAS unsigned char* L = F.lds + half * RW_BYTES;
    LAS float* Rm = (LAS float*)(L + R3_R); LAS float* KM = (LAS float*)(L + R3_KM); LAS float* Vm = (LAS float*)(L + R3_V); LAS float* LW = (LAS float*)(L + R3_LW);
    LAS float* AV = (LAS float*)(L + R3_AV); LAS float* Gm = (LAS float*)(L + R3_G);
    LAS float* Om = (LAS float*)(L + R3_O); LAS float* BON = (LAS float*)(L + R3_BON); LAS float* MU = (LAS float*)(L + R3_MU);
    LAS unsigned char* IM = L + R3_IMG;
    const bf16* PROJ = (const bf16*)(F.ws + WS_PROJ);
    bf16* OUT = (bf16*)(F.ws + WS_XN);
    const int jc = 16 * wq + c, kg = g, hj = h * 64 + jc;
    bf16x8 bd[2], bi[2], bg[4];
    {
        const float* Wd = A_.in[5] + (size_t)layer * 64 * 512 + h * 64; const float* Wi = A_.in[7] + (size_t)layer * 64 * 512 + h * 64; const float* Wg = A_.in[8] + (size_t)layer * 128 * 512 + h * 64;
        LAS bf16* WT = (LAS bf16*)(L + R3_R);
#pragma unroll 1
        for (int idx = ht; idx < 4096; idx += 256) { const int k = idx >> 6, j = idx & 63; WT[j * 64 + k] = (bf16)f2bf(Wd[(size_t)k * 512 + j]); WT[4096 + j * 64 + k] = (bf16)f2bf(Wi[(size_t)k * 512 + j]); }
#pragma unroll 1
        for (int idx = ht; idx < 8192; idx += 256) { const int k = idx >> 6, j = idx & 63; WT[8192 + j * 128 + k] = (bf16)f2bf(Wg[(size_t)k * 512 + j]); }
        __syncthreads();
#pragma unroll
        for (int s = 0; s < 2; ++s) { bd[s] = *(const LAS bf16x8*)(WT + jc * 64 + 32 * s + 8 * kg); bi[s] = *(const LAS bf16x8*)(WT + 4096 + jc * 64 + 32 * s + 8 * kg); }
#pragma unroll
        for (int s = 0; s < 4; ++s) bg[s] = *(const LAS bf16x8*)(WT + 8192 + jc * 128 + 32 * s + 8 * kg);
        __syncthreads();
    }
    const float w0c = A_.in[4][layer * 512 + hj], a0c = A_.in[6][layer * 512 + hj];
    const int tid = F.tid;
    const int atok = tid >> 5, apc = tid & 31;
    int bun[2], btok[2], bpc[2]; bool bval[2];
#pragma unroll
    for (int j = 0; j < 2; ++j) { const int idx = tid + 512 * j; bval[j] = idx < 768; const int ii = bval[j] ? idx : 0; bun[j] = ii / 384; const int rem = ii - 384 * bun[j]; btok[j] = rem / 24; bpc[j] = rem - 24 * btok[j]; }
    f32x4 amu[2], bmu[2][2];
    { const float* mup = A_.in[3] + layer * 1792;
      amu[0] = *(const f32x4*)(mup + C_WL + 8 * apc); amu[1] = *(const f32x4*)(mup + C_WL + 8 * apc + 4);
#pragma unroll
      for (int j = 0; j < 2; ++j) { const int hh = 2 * (pairidx & 3) + bun[j]; const int col = (bpc[j] < 8 ? C_R : (bpc[j] < 16 ? C_K : C_V)) + hh * 64 + 8 * (bpc[j] & 7);
          bmu[j][0] = *(const f32x4*)(mup + col); bmu[j][1] = *(const f32x4*)(mup + col + 4); } }
    const bool a_th = apc < 8, a_id = apc >= 8 && apc < 16;
    constexpr size_t CHB = (size_t)CH * NPROJ * 2;
    const size_t aoff = ((size_t)(b * T + atok) * NPROJ + C_WL + 8 * apc) * 2;
    size_t boff[2]; unsigned bdst[2];
#pragma unroll
    for (int j = 0; j < 2; ++j) { const int hh = 2 * (pairidx & 3) + bun[j]; const int col = (bpc[j] < 8 ? C_R : (bpc[j] < 16 ? C_K : C_V)) + hh * 64 + 8 * (bpc[j] & 7);
        boff[j] = ((size_t)(b * T + btok[j]) * NPROJ + col) * 2;
        bdst[j] = (unsigned)(bun[j] * RW_BYTES + (bpc[j] < 8 ? R3_R : (bpc[j] < 16 ? R3_KM : R3_V)) + (btok[j] * 64 + 8 * (bpc[j] & 7)) * 4); }
    const unsigned adst = (unsigned)(R3_XA + atok * XA_PITCH + apc * 16);
    const int tt = ht >> 4, jq = (ht & 15) * 4;
    const f32x4 kkv = *(const f32x4*)(A_.in[9] + layer * 512 + h * 64 + jq), kav = *(const f32x4*)(A_.in[10] + layer * 512 + h * 64 + jq), rkv = *(const f32x4*)(A_.in[11] + layer * 512 + h * 64 + jq);
    const f32x4 lgv = *(const f32x4*)(A_.in[12] + layer * 512 + h * 64 + jq), lbv = *(const f32x4*)(A_.in[13] + layer * 512 + h * 64 + jq);
    const int pimg = (jq & ~31) + 8 * (((jq & 31) >> 2) & 3) + 4 * ((jq & 31) >> 4);
    bf16x4 ltri;
#pragma unroll
    for (int j = 0; j < 4; ++j) ltri[j] = (4 * g + j <= c) ? (short)0x3F80 : (short)0;
    f32x4 P[4];
#pragma unroll
    for (int m = 0; m < 4; ++m) P[m] = (f32x4){0.f, 0.f, 0.f, 0.f};
    struct PF { v4u acur, aprv, bcur[2], bprv[2]; };
    PF pf0, pf1;
    auto prefetch = [&](int ch, PF& q_) {
        const char* base = (const char*)PROJ + (size_t)ch * CHB;
        { const bool first = (ch == 0 && atok == 0); const char* p = base + aoff; q_.acur = *(const GAS v4u*)p; q_.aprv = *(const GAS v4u*)(first ? p : p - NPROJ * 2); }
#pragma unroll
        for (int j = 0; j < 2; ++j) { const bool first = (ch == 0 && btok[j] == 0); const char* p = base + boff[j]; q_.bcur[j] = *(const GAS v4u*)p; q_.bprv[j] = *(const GAS v4u*)(first ? p : p - NPROJ * 2); }
    };
    prefetch(0, pf0); prefetch(1, pf1);
    auto do_chunk = [&](const int ch, PF& q_) __attribute__((always_inline)) {
        const int t0 = ch * CH;
        v4u acur = q_.acur, aprv = q_.aprv, bcur[2] = {q_.bcur[0], q_.bcur[1]}, bprv[2] = {q_.bprv[0], q_.bprv[1]};
        if (ch == 0) {
            if (atok == 0) aprv = (v4u){0u, 0u, 0u, 0u};
#pragma unroll
            for (int j = 0; j < 2; ++j) if (btok[j] == 0) bprv[j] = (v4u){0u, 0u, 0u, 0u};
        }
        if (!(PADF & 64)) {
#define RW_UNPACK(W_, X_) const float X_[8] = {bf_lo((W_)[0]), bf_hi((W_)[0]), bf_lo((W_)[1]), bf_hi((W_)[1]), bf_lo((W_)[2]), bf_hi((W_)[2]), bf_lo((W_)[3]), bf_hi((W_)[3])}
            { RW_UNPACK(acur, xc); RW_UNPACK(aprv, xp);
              const float be = a_th ? 2.f : 1.f, ga = a_th ? -1.f : 0.f;
              float y[8];
#pragma unroll
              for (int e = 0; e < 8; ++e) { const float val = xc[e] + (xp[e] - xc[e]) * (e < 4 ? amu[0][e] : amu[1][e - 4]); const float sg = __builtin_amdgcn_rcpf(1.0f + __expf(-be * val)); y[e] = a_id ? val : be * sg + ga; }
              v4u o; o.x = pk2(y[0], y[1]); o.y = pk2(y[2], y[3]); o.z = pk2(y[4], y[5]); o.w = pk2(y[6], y[7]);
              *(LAS v4u*)(F.lds + adst) = o; }
#pragma unroll
            for (int j = 0; j < 2; ++j) if (bval[j]) { RW_UNPACK(bcur[j], xc); RW_UNPACK(bprv[j], xp);
                float val[8];
#pragma unroll
                for (int e = 0; e < 8; ++e) val[e] = xc[e] + (xp[e] - xc[e]) * (e < 4 ? bmu[j][0][e] : bmu[j][1][e - 4]);
                LAS float* dst = (LAS float*)(F.lds + bdst[j]);
                *(LAS f32x4*)dst = (f32x4){val[0], val[1], val[2], val[3]}; *(LAS f32x4*)(dst + 4) = (f32x4){val[4], val[5], val[6], val[7]}; }
#undef RW_UNPACK
        }
        if (ch + 2 < NCH) prefetch(ch + 2, q_);
        __syncthreads();
        if (!(PADF & 128)) {
            f32x4 ad = (f32x4){0.f, 0.f, 0.f, 0.f}, aa = ad, ag = ad;
            const LAS unsigned char* xa = F.lds + R3_XA + c * XA_PITCH + kg * 16;
#pragma unroll
            for (int s = 0; s < 2; ++s) ad = MFMA32(*(const LAS bf16x8*)(xa + s * 64), bd[s], ad);
#pragma unroll
            for (int s = 0; s < 2; ++s) aa = MFMA32(*(const LAS bf16x8*)(xa + 128 + s * 64), bi[s], aa);
#pragma unroll
            for (int s = 0; s < 4; ++s) ag = MFMA32(*(const LAS bf16x8*)(xa + 256 + s * 64), bg[s], ag);
            f32x4 lwv;
#pragma unroll
            for (int r = 0; r < 4; ++r) { const int t = 4 * kg + r;
                lwv[r] = -0.60653065971f * sigmoidf_(w0c + ad[r]);
                AV[t * 64 + jc] = sigmoidf_(a0c + aa[r]); Gm[t * 64 + jc] = ag[r]; }
            { const bf16x4 hi = pack4v(lwv); const v2u hw = __builtin_bit_cast(v2u, hi);
              const f32x4 lo = lwv - (f32x4){bf_lo(hw.x), bf_hi(hw.x), bf_lo(hw.y), bf_hi(hw.y)};
              f32x4 cs = MFMA16(ltri, hi, ((f32x4){0.f, 0.f, 0.f, 0.f})); cs = MFMA16(ltri, pack4v(lo), cs);
#pragma unroll
              for (int r = 0; r < 4; ++r) LW[(4 * kg + r) * 64 + jc] = cs[r]; }
        }
        __syncthreads();
        if (!(PADF & 256)) {
            const f32x4 k4 = *(const LAS f32x4*)(KM + tt * 64 + jq), a4 = *(const LAS f32x4*)(AV + tt * 64 + jq), r4 = *(const LAS f32x4*)(Rm + tt * 64 + jq), v4 = *(const LAS f32x4*)(Vm + tt * 64 + jq);
            const f32x4 cl = *(const LAS f32x4*)(LW + tt * 64 + jq);
            f32x4 clp = *(const LAS f32x4*)(LW + (tt > 0 ? tt - 1 : 0) * 64 + jq); if (tt == 0) clp = (f32x4){0.f, 0.f, 0.f, 0.f};
            const f32x4 kr = k4 * kkv; float ss = (kr[0] * kr[0] + kr[1] * kr[1]) + (kr[2] * kr[2] + kr[3] * kr[3]);
            ss = sum16(ss);
            const float inv = __builtin_amdgcn_rsqf(ss + 1e-6f);
            const f32x4 kk = kr * inv; const f32x4 km = k4 * (1.0f + (a4 - 1.0f) * kav);
            float bo = (r4[0] * km[0] * rkv[0] + r4[1] * km[1] * rkv[1]) + (r4[2] * km[2] * rkv[2] + r4[3] * km[3] * rkv[3]);
            bo = sum16(bo);
            if ((ht & 15) == 0) BON[tt] = bo;
            f32x4 wt, wi, wp;
#pragma unroll
            for (int e = 0; e < 4; ++e) { wt[e] = __expf(cl[e]); wi[e] = __expf(-cl[e]); wp[e] = __expf(clp[e]); }
            const f32x4 at = -kk * wp, bt = kk * a4 * wi, kt = km * wi, rt = r4 * wt;
            LAS unsigned char* irow = IM + tt * R2_IP + pimg * 2;
            { v2u w; w.x = pk2(at[0], at[1]); w.y = pk2(at[2], at[3]); *(LAS v2u*)(irow + R2_AI) = w; }
            { v2u w; w.x = pk2(bt[0], bt[1]); w.y = pk2(bt[2], bt[3]); *(LAS v2u*)(irow + R2_BI) = w; }
            { v2u w; w.x = pk2(kt[0], kt[1]); w.y = pk2(kt[2], kt[3]); *(LAS v2u*)(irow + R2_KI) = w; }
            { v2u w; w.x = pk2(rt[0], rt[1]); w.y = pk2(rt[2], rt[3]); *(LAS v2u*)(irow + R2_RI) = w; }
            { v2u w; w.x = pk2(v4[0], v4[1]); w.y = pk2(v4[2], v4[3]); *(LAS v2u*)(IM + R2_VI + tt * R2_IP + jq * 2) = w; }
            if (tt == 15) *(LAS f32x4*)(IM + R2_W15 + jq * 4) = wt;
        }
        __syncthreads();
        if (!(PADF & 512)) {
            bf16x8 af[2], bf_[2], kf[2], rf[2];
#pragma unroll
            for (int s = 0; s < 2; ++s) { const LAS unsigned char* p = IM + c * R2_IP + 64 * s + 16 * g;
                af[s] = *(const LAS bf16x8*)(p + R2_AI); bf_[s] = *(const LAS bf16x8*)(p + R2_BI); kf[s] = *(const LAS bf16x8*)(p + R2_KI); rf[s] = *(const LAS bf16x8*)(p + R2_RI); }
            const unsigned trb = (unsigned)(size_t)IM + (unsigned)((4 * g + ((lane >> 2) & 3)) * R2_IP + 16 * (lane & 3));
            const unsigned trv = (unsigned)(size_t)IM + (unsigned)(R2_VI + (4 * g + ((lane >> 2) & 3)) * R2_IP + 8 * (lane & 3) + 32 * wq);
            bf16x4 vt, btm[4], ktm[4];
            asm volatile("ds_read_b64_tr_b16 %0, %9\n\tds_read_b64_tr_b16 %1, %10 offset:%11\n\tds_read_b64_tr_b16 %2, %10 offset:%12\n\tds_read_b64_tr_b16 %3, %10 offset:%13\n\tds_read_b64_tr_b16 %4, %10 offset:%14\n\t"
                         "ds_read_b64_tr_b16 %5, %10 offset:%15\n\tds_read_b64_tr_b16 %6, %10 offset:%16\n\tds_read_b64_tr_b16 %7, %10 offset:%17\n\tds_read_b64_tr_b16 %8, %10 offset:%18\n\ts_waitcnt lgkmcnt(0)"
                         : "=&v"(vt), "=&v"(btm[0]), "=&v"(btm[1]), "=&v"(btm[2]), "=&v"(btm[3]), "=&v"(ktm[0]), "=&v"(ktm[1]), "=&v"(ktm[2]), "=&v"(ktm[3])
                         : "v"(trv), "v"(trb), "i"(R2_BI + 0), "i"(R2_BI + 8), "i"(R2_BI + 64), "i"(R2_BI + 72), "i"(R2_KI + 0), "i"(R2_KI + 8), "i"(R2_KI + 64), "i"(R2_KI + 72) : "memory");
            __builtin_amdgcn_sched_barrier(0);
            const f32x4 zero = (f32x4){0.f, 0.f, 0.f, 0.f};
            f32x4 X0 = zero, Y0 = zero, Dka = zero, Dbr = zero, Dkr = zero;
#pragma unroll
            for (int s = 0; s < 2; ++s) { X0 = MFMA32(af[s], bf_[s], X0); Y0 = MFMA32(bf_[s], af[s], Y0); Dka = MFMA32(kf[s], af[s], Dka); Dbr = MFMA32(bf_[s], rf[s], Dbr); Dkr = MFMA32(kf[s], rf[s], Dkr); }
            f32x4 idn;
#pragma unroll
            for (int r = 0; r < 4; ++r) { const int row = 4 * g + r; idn[r] = (row == c) ? 1.f : 0.f;
                X0[r] = (c < row) ? X0[r] : 0.f;
                Y0[r] = (row < c) ? Y0[r] : 0.f;
                Dka[r] = (row < c) ? Dka[r] : 0.f;
                Dbr[r] = (row <= c) ? Dbr[r] : 0.f; Dkr[r] = (row <= c) ? Dkr[r] : 0.f; }
            const bf16x4 x0b = pack4v(X0), y0b = pack4v(Y0);
            const f32x4 X1 = MFMA16(y0b, x0b, zero), Y1 = MFMA16(x0b, y0b, zero);
            const bf16x4 x1b = pack4v(X1), y1b = pack4v(Y1);
            const f32x4 X2 = MFMA16(y1b, x1b, zero), Y2 = MFMA16(x1b, y1b, zero);
            const bf16x4 x2b = pack4v(X2), y2b = pack4v(Y2);
            const f32x4 X3 = MFMA16(y2b, x2b, zero);
            f32x4 U = Y0 + idn;
            U = MFMA16(pack4v(X1 + idn), pack4v(U), zero);
            U = MFMA16(pack4v(X2 + idn), pack4v(U), zero);
            U = MFMA16(pack4v(X3 + idn), pack4v(U), zero);
            bf16x8 Pb[2];
#pragma unroll
            for (int s = 0; s < 2; ++s) Pb[s] = pack8(P[2 * s], P[2 * s + 1]);
            f32x4 X = zero, O = zero;
#pragma unroll
            for (int s = 0; s < 2; ++s) { X = MFMA32(af[s], Pb[s], X); O = MFMA32(rf[s], Pb[s], O); }
            X = MFMA16(pack4v(Dka), vt, X);
            const f32x4 Z = MFMA16(pack4v(U), pack4v(X), zero);
            const bf16x4 zb = pack4v(Z);
            O = MFMA16(pack4v(Dbr), zb, O);
            O = MFMA16(pack4v(Dkr), vt, O);
#pragma unroll
            for (int r = 0; r < 4; ++r) Om[(4 * g + r) * 64 + 16 * wq + c] = O[r];
#pragma unroll
            for (int m = 0; m < 4; ++m) {
                const f32x4 w15 = *(const LAS f32x4*)(IM + R2_W15 + (16 * m + 4 * g) * 4);
                f32x4 pm = MFMA16(btm[m], zb, P[m]); pm = MFMA16(ktm[m], vt, pm); P[m] = pm * w15; }
        }
        __syncthreads();
        if (!(PADF & 1024)) {
            const f32x4 o4 = *(const LAS f32x4*)(Om + tt * 64 + jq);
            float s1 = sum16((o4[0] + o4[1]) + (o4[2] + o4[3]));
            const float mean = s1 * (1.f / 64.f); const f32x4 d4 = o4 - mean;
            float s2 = sum16((d4[0] * d4[0] + d4[1] * d4[1]) + (d4[2] * d4[2] + d4[3] * d4[3]));
            const float rs = __builtin_amdgcn_rsqf(s2 * (1.f / 64.f) + 64e-5f);
            f32x4 v4;
            { const v2u vw = *(const LAS v2u*)(IM + R2_VI + tt * R2_IP + jq * 2); v4 = (f32x4){bf_lo(vw.x), bf_hi(vw.x), bf_lo(vw.y), bf_hi(vw.y)}; }
            const f32x4 g4 = *(const LAS f32x4*)(Gm + tt * 64 + jq);
            const f32x4 y = ((d4 * rs) * lgv + lbv + v4 * BON[tt]) * g4;
            v2u w; w.x = pk2(y[0], y[1]); w.y = pk2(y[2], y[3]);
            *(GAS v2u*)(OUT + (size_t)(b * T + t0 + tt) * D + h * 64 + jq) = w;
        }
    };
    for (int ch = 0; ch < NCH; ch += 2) { do_chunk(ch, pf0); do_chunk(ch + 1, pf1); }
    __syncthreads();
}

constexpr int NPHASE = 19;
#ifndef PH_ONLY
#define PH_ONLY -1
#endif
#define PROBE_SCAN 0
#ifndef SCAN_SEL
#define SCAN_SEL 0
#endif
#define PH_ON(k) (PH_ONLY < 0 || PH_ONLY == (k))

template <int LAYER>
__device__ __forceinline__ void layer_phases(Frame& F, const Args& A_, const XcdBarrier& bar, const int lo, const int hi) {
#define IN(k) (PH_ON(k) && lo <= (k) && (k) < hi)
#define SEAM(k) do { if (lo <= (k) && (k) + 1 < hi) xcd_barrier(bar); } while (0)
    bf16* XN = (bf16*)(F.ws + WS_XN); bf16* PROJ = (bf16*)(F.ws + WS_PROJ);
    const int gw = F.vcu * NWAVES + F.wave, NGW = F.G * NWAVES;
    constexpr int pb = 1 + LAYER * 8;
    unsigned char* wmix = LAYER == 0 ? F.ws + WS_WS : F.ws + WS_W1;
    const float* xres = LAYER == 0 ? A_.in[0] : F.out;
    if (IN(pb)) {
        pg8::Gemm g{XN, (const bf16*)(wmix + MW_IN), D, D, D, nullptr}; pg8::StaticOrder S; S.init(M / 256, NPROJ / 256, F.G, (int)blockIdx.x);
        pg8::EpiBf16PlainS E{PROJ, NPROJ, (const float*)(F.ws + WS_RS), I8_WS};
        pg8::gemm_phase<pg8::EpiBf16PlainS, pg8::StaticOrder, true, true, false, 2>(F.lds, g, S, E);
    }
    SEAM(pb);
    if (IN(pb + 1)) {
        { const int job = F.vcu; if (job < 128) { if (SCAN_SEL != 2 && !(PADF & 2)) gdn_unit2(F, A_, LAYER, job); } else if (job < 256) { if (SCAN_SEL != 1 && !(PADF & 1)) rwkv_pair2(F, A_, LAYER, job - 128); } }
        if (F.vcu < 128 && !PADF) {
            __syncthreads();
            LAS float* scr = (LAS float*)(F.lds + F.wave * 16384);
            const int cw = F.vcu * NWAVES + F.wave, NCW = 128 * NWAVES;
            if constexpr (LAYER == 0) {
                for (int it = cw; it < MIXER_ITEMS; it += NCW) conv_mixer_item(F, A_, 1, F.ws + WS_W1, it, scr);
                for (int it = cw; it < FFN_ITEMS8; it += NCW)
                    conv_ffn_item_f8(F, A_.in[22], A_.in[23], A_.in[24], F.ws + WS_WS + FW_GU, F.ws + WS_WS + FW_DN, it);
                for (int it = cw; it < NE_EARLY * FFN_ITEMS8; it += NCW) { const int e = it / FFN_ITEMS8, r = it % FFN_ITEMS8;
                    conv_ffn_item_f8<true>(F, A_.in[26] + (size_t)e * D * FF, A_.in[27] + (size_t)e * D * FF, A_.in[28] + (size_t)e * FF * D,
                                     F.ws + WS_WS + EW_GU + (size_t)e * NGU * D, F.ws + WS_WS + EW_DN + (size_t)e * D * FF, r); }
            } else {
                for (int it = cw + NE_EARLY * FFN_ITEMS8; it < NE * FFN_ITEMS8; it += NCW) { const int e = it / FFN_ITEMS8, r = it % FFN_ITEMS8;
                    conv_ffn_item_f8<true>(F, A_.in[26] + (size_t)e * D * FF, A_.in[27] + (size_t)e * D * FF, A_.in[28] + (size_t)e * FF * D,
                                     F.ws + WS_WS + EW_GU + (size_t)e * NGU * D, F.ws + WS_WS + EW_DN + (size_t)e * D * FF, r); }
            }
        }
    }
    SEAM(pb + 1);
    if (IN(pb + 2)) {
        pg8::StaticOrder S; S.init(M / 256, D / 256, F.G, (int)blockIdx.x);
        { pg8::Gemm g{XN, (const bf16*)(wmix + MW_PA), D, 512, 512, nullptr}; pg8::EpiMerge<true> E{PROJ, PROJ + C_GA, NPROJ};
          pg8::gemm_phase<pg8::EpiMerge<true>, pg8::StaticOrder, true, true, false>(F.lds, g, S, E); }
        { pg8::Gemm g{XN + 512, (const bf16*)(wmix + MW_PB), D, 512, 512, nullptr}; pg8::EpiMerge<false> E{PROJ, PROJ + C_GB, NPROJ};
          pg8::gemm_phase<pg8::EpiMerge<false>, pg8::StaticOrder, true, true, false>(F.lds, g, S, E); }
    }
    SEAM(pb + 2);
    if (IN(pb + 3)) {
        pg8::Gemm g{PROJ, (const bf16*)(wmix + MW_OUT), NPROJ, D, D, nullptr}; pg8::StaticOrder S; S.init(M / 256, D / 256, F.G, (int)blockIdx.x);
        pg8::EpiResid E{xres, F.out, D};
        pg8::gemm_phase<pg8::EpiResid, pg8::StaticOrder, true, true, false>(F.lds, g, S, E);
    }
    SEAM(pb + 3);
    if constexpr (LAYER == 0) {
        if (IN(5)) norm_phase<1>(F, F.out, A_.in[21], nullptr, 0);
        SEAM(5);
        if (IN(6)) {
            pg8::Gemm g{XN, (const bf16*)(F.ws + WS_WS + FW_GU), D, D, D, nullptr}; pg8::StaticOrder S; S.init(M / 256, NGU / 256, F.G, (int)blockIdx.x);
            pg8::EpiSwigluI8<true> E{(unsigned char*)PROJ, FF, (const float*)(F.ws + WS_RS), I8_WS, F8_SH};
            pg8::gemm_phase<pg8::EpiSwigluI8<true>, pg8::StaticOrder, true, true, false, 2>(F.lds, g, S, E);
        }
        SEAM(6);
        if (IN(7)) {
            pg8::Gemm g{PROJ, (const bf16*)(F.ws + WS_WS + FW_DN), FF, FF, FF, nullptr}; pg8::StaticOrder S; S.init(M / 256, D / 256, F.G, (int)blockIdx.x);
            pg8::EpiResidS E{F.out, F.out, D, 1.0f / (F8_SH * F8_SW)};
            pg8::gemm_phase<pg8::EpiResidS, pg8::StaticOrder, true, true, false, 1>(F.lds, g, S, E);
        }
        SEAM(7);
        if (IN(8)) norm_phase<0>(F, F.out, A_.in[1] + D, A_.in[2] + (size_t)D * INC + SRC_AB, INC);
        SEAM(8);
    } else {
        if (IN(13)) {
            norm_phase<2>(F, F.out, A_.in[21] + D, A_.in[25], 8);
        }
        SEAM(13);
        if (IN(14)) route_scatter(F);
        SEAM(14);
        const int* grp = (const int*)(F.ws + WS_GRP);
        if (IN(15)) {
            const int np = grp[16] / 256;
            pg8::Gemm g{XN, (const bf16*)(F.ws + WS_WS + EW_GU), D, D, D, (const int*)(F.ws + WS_LIST)}; pg8::MoeOrder S; S.init(grp, 0, np, NGU / 256, F.G, (int)blockIdx.x);
            pg8::EpiSwigluF8 E{(unsigned char*)PROJ, FF, 1.0f / (F8_SX * F8_SW), F8_SH};
            pg8::gemm_phase<pg8::EpiSwigluF8, pg8::MoeOrder, true, true, true, 1>(F.lds, g, S, E);
        }
        SEAM(15);
        if (IN(16)) {
            const int np = grp[16] / 256;
            pg8::Gemm g{PROJ, (const bf16*)(F.ws + WS_WS + EW_DN), FF, FF, FF, nullptr}; pg8::MoeOrder S; S.init(grp, 0, np, D / 256, F.G, (int)blockIdx.x);
            pg8::EpiMoeDown E{(bf16*)(F.ws + WS_TMP0), (const int*)(F.ws + WS_LIST), (const float*)(F.ws + WS_GATEL), XN, grp[8], 1.0f / (F8_SH * F8_SW)};
            pg8::gemm_phase<pg8::EpiMoeDown, pg8::MoeOrder, true, true, false, 1>(F.lds, g, S, E);
        }
        SEAM(16);
        if (IN(18)) norm_phase<3>(F, F.out, A_.in[29], nullptr, 0);
    }
}

__global__ void __launch_bounds__(NWAVES * 64, 2) trunk_fwd(Args A_) {
    extern __shared__ __attribute__((aligned(16))) unsigned char lds[];
    Frame F;
    F.lds = (LAS unsigned char*)lds;
    F.tid = threadIdx.x; F.lane = F.tid & 63; F.wave = __builtin_amdgcn_readfirstlane(F.tid >> 6);
    F.G = gridDim.x; { const int bx = blockIdx.x; F.vcu = (F.G % 8 == 0) ? (bx % 8) * (F.G / 8) + bx / 8 : bx; }
    F.out = A_.out; F.ws = A_.ws;
    unsigned* ctl = (unsigned*)(F.ws + WS_CTL);
    for (int u = F.tid; u < (LDS_BYTES - LDSCTL_OFF) / 4; u += NWAVES * 64) ((LAS unsigned*)(F.lds + LDSCTL_OFF))[u] = 0u;
    __syncthreads();
    XcdBarrier bar; bar.bar = ctl + CW_BAR + A_.li * XCD_BAR_WORDS; bar.x = 0; bar.st = nullptr;
    if (!MK_PER_PHASE) bar = xcd_barrier_post(ctl + CW_BAR + A_.li * XCD_BAR_WORDS, (volatile LAS unsigned*)(F.lds + MISC_OFF) + 8);
    const int lo = A_.ph_lo, hi = A_.ph_hi;
    if (IN(0)) {
        const int gw = F.vcu * NWAVES + F.wave, NGW = F.G * NWAVES;
        LAS float* scr = (LAS float*)(F.lds + F.wave * 16384);
        for (int it = gw; it < MIXER_ITEMS; it += NGW) conv_mixer_item(F, A_, 0, F.ws + WS_WS, it, scr);
        __syncthreads();
        norm_phase<0>(F, A_.in[0], A_.in[1], A_.in[2] + SRC_AB, INC);
    }
    SEAM(0);
    layer_phases<0>(F, A_, bar, lo, hi);
    layer_phases<1>(F, A_, bar, lo, hi);
#undef IN
#undef SEAM
}

extern "C" void kernel_launch(void* const* d_in, const int* in_sizes, int n_in, void* d_out, int out_size, void* d_ws, size_t ws_size, hipStream_t stream) {
    static int grid = 0;
    if (grid == 0) {
        if (n_in != 30 || in_sizes[0] != M * D || out_size != M * D || ws_size < WS_END) { fprintf(stderr, "kernel_launch: unexpected shapes / workspace (n_in %d, ws %zu, need %zu)\n", n_in, ws_size, (size_t)WS_END); grid = -1; return; }
        int dev = 0, cus = 0, per_cu = 0;
        if (hipGetDevice(&dev) != hipSuccess || hipDeviceGetAttribute(&cus, hipDeviceAttributeMultiprocessorCount, dev) != hipSuccess) { grid = -1; return; }
        if (hipFuncSetAttribute((const void*)trunk_fwd, hipFuncAttributeMaxDynamicSharedMemorySize, LDS_BYTES) != hipSuccess) { grid = -1; return; }
        if (hipOccupancyMaxActiveBlocksPerMultiprocessor(&per_cu, (const void*)trunk_fwd, NWAVES * 64, LDS_BYTES) != hipSuccess || per_cu < 1) { fprintf(stderr, "kernel_launch: occupancy query says %d\n", per_cu); }
        (void)hipGetLastError();
        grid = cus;
    }
    if (grid < 0) return;
    if (hipMemsetAsync((char*)d_ws + WS_CTL, 0, CTL_ZERO_BYTES, stream) != hipSuccess) return;
    Args a{};
    for (int i = 0; i < 30; ++i) a.in[i] = (const float*)d_in[i];
    a.out = (float*)d_out; a.ws = (unsigned char*)d_ws;
#if MK_PER_PHASE
    for (int p = 0; p < NPHASE; ++p) { a.ph_lo = p; a.ph_hi = p + 1; a.li = 0; hipLaunchKernelGGL(trunk_fwd, dim3(grid), dim3(NWAVES * 64), LDS_BYTES, stream, a); }
#elif PROBE_DUP >= 0
    a.ph_lo = 0; a.ph_hi = PROBE_DUP; a.li = 0; a.pad = 0; hipLaunchKernelGGL(trunk_fwd, dim3(grid), dim3(NWAVES * 64), LDS_BYTES, stream, a);
    a.ph_lo = PROBE_DUP; a.ph_hi = PROBE_DUP + 1; a.li = 1; a.pad = PROBE_SCAN; hipLaunchKernelGGL(trunk_fwd, dim3(grid), dim3(NWAVES * 64), LDS_BYTES, stream, a);
    a.ph_lo = PROBE_DUP; a.ph_hi = NPHASE; a.li = 2; a.pad = 0; hipLaunchKernelGGL(trunk_fwd, dim3(grid), dim3(NWAVES * 64), LDS_BYTES, stream, a);
#else
    a.ph_lo = 0; a.ph_hi = NPHASE; a.li = 0;
    hipLaunchKernelGGL(trunk_fwd, dim3(grid), dim3(NWAVES * 64), LDS_BYTES, stream, a);
#endif
}
```
